# Optimizing an MI355X kernel written in HIP

```python
import math
import jax, jax.numpy as jnp
from jax import lax
import numpy as np

D_MODEL = 4096
BATCH = 2
SEQ = 4096
DEPTH = 2

CHUNK = 64
Q_BLOCK = 128
EPS = 1e-6
ROPE_THETA = 10000.0

MLA_HEADS = 16
MLA_Q_RANK = 1024
MLA_KV_RANK = 512
MLA_NOPE = 128
MLA_ROPE = 64
MLA_V = 128
SB_HEADS = 16
SB_DIM = 128
DIFF_HEADS = 16
DIFF_DIM = 128
FFN_DIM = 11008
CONV_W = 3

N_EVEN = (DEPTH + 1) // 2
N_ODD = DEPTH // 2
IN_AB = MLA_Q_RANK + MLA_KV_RANK + MLA_ROPE + 3 * SB_HEADS * SB_DIM
OUT_AB = MLA_HEADS * MLA_V + SB_HEADS * SB_DIM
IN_C = 6 * DIFF_HEADS * DIFF_DIM
OUT_C = DIFF_HEADS * 2 * DIFF_DIM

kernel_name = "hybrid_mla_stickbreak_diffattn_convffn"


def rms_norm(x, g):
    xf = x.astype(jnp.float32)
    y = xf * lax.rsqrt(jnp.mean(xf * xf, axis=-1, keepdims=True) + EPS)
    return (y * g.astype(jnp.float32)).astype(x.dtype)


def rope(x, pos):
    half = x.shape[-1] // 2
    inv = ROPE_THETA ** (-jnp.arange(half, dtype=jnp.float32) / half)
    ang = pos.astype(jnp.float32)[:, None] * inv[None, :]
    cos, sin = jnp.cos(ang), jnp.sin(ang)
    x1 = x[..., :half].astype(jnp.float32)
    x2 = x[..., half:].astype(jnp.float32)
    out = jnp.concatenate([x1 * cos - x2 * sin, x2 * cos + x1 * sin], axis=-1)
    return out.astype(x.dtype)


def to_blocks(a):
    b, h, s, d = a.shape
    return jnp.moveaxis(a.reshape(b, h, s // Q_BLOCK, Q_BLOCK, d), 2, 0)


def from_blocks(a):
    nb, b, h, qb, d = a.shape
    return jnp.moveaxis(a, 0, 2).reshape(b, h, nb * qb, d)


def chunk_mask(t_pos, s_pos):
    return (s_pos[None, :] // CHUNK) <= (t_pos[:, None] // CHUNK)


def alibi_slopes(n):
    return jnp.asarray([2.0 ** (-8.0 * (h + 1) / n) for h in range(n)], dtype=jnp.float32)


def mla_attention(q_nope, q_rope, k_nope, k_rope, v):
    seq = k_nope.shape[2]
    s_pos = jnp.arange(seq)
    scale = 1.0 / math.sqrt(MLA_NOPE + MLA_ROPE)

    def block(args):
        blk, qn, qr = args
        t_pos = blk * Q_BLOCK + jnp.arange(Q_BLOCK)
        s = (jnp.einsum('bhqd,bhkd->bhqk', qn, k_nope).astype(jnp.float32)
             + jnp.einsum('bhqr,bkr->bhqk', qr, k_rope).astype(jnp.float32)) * scale
        s = jnp.where(chunk_mask(t_pos, s_pos)[None, None], s, -1e30)
        p = jax.nn.softmax(s, axis=-1)
        return jnp.einsum('bhqk,bhkd->bhqd', p.astype(v.dtype), v)

    nb = seq // Q_BLOCK
    out = lax.map(block, (jnp.arange(nb), to_blocks(q_nope), to_blocks(q_rope)))
    return from_blocks(out)


def stick_breaking_attention(q, k, v):
    seq = k.shape[2]
    s_pos = jnp.arange(seq)
    scale = 1.0 / math.sqrt(SB_DIM)

    def block(args):
        blk, qb = args
        t_pos = blk * Q_BLOCK + jnp.arange(Q_BLOCK)
        strict = (s_pos[None, :] < t_pos[:, None])[None, None]
        z = jnp.einsum('bhqd,bhkd->bhqk', qb, k).astype(jnp.float32) * scale
        log_keep = jnp.where(strict, jax.nn.log_sigmoid(-z), 0.0)
        after = lax.cumsum(log_keep, axis=3, reverse=True) - log_keep
        log_a = jax.nn.log_sigmoid(z) + after
        a = jnp.where(strict, jnp.exp(log_a), 0.0)
        return jnp.einsum('bhqk,bhkd->bhqd', a.astype(v.dtype), v)

    nb = seq // Q_BLOCK
    out = lax.map(block, (jnp.arange(nb), to_blocks(q)))
    return from_blocks(out)


def differential_attention(q1, q2, k1, k2, v, lam):
    seq = k1.shape[2]
    s_pos = jnp.arange(seq)
    scale = 1.0 / math.sqrt(DIFF_DIM)
    slopes = alibi_slopes(DIFF_HEADS)

    def block(args):
        blk, qa, qb = args
        t_pos = blk * Q_BLOCK + jnp.arange(Q_BLOCK)
        dist = jnp.abs(t_pos[:, None] - s_pos[None, :]).astype(jnp.float32)
        bias = -slopes[:, None, None] * dist
        mask = chunk_mask(t_pos, s_pos)[None, None]
        s1 = jnp.einsum('bhqd,bhkd->bhqk', qa, k1).astype(jnp.float32) * scale + bias[None]
        s2 = jnp.einsum('bhqd,bhkd->bhqk', qb, k2).astype(jnp.float32) * scale + bias[None]
        p1 = jax.nn.softmax(jnp.where(mask, s1, -1e30), axis=-1)
        p2 = jax.nn.softmax(jnp.where(mask, s2, -1e30), axis=-1)
        a = p1 - lam * p2
        return jnp.einsum('bhqk,bhkd->bhqd', a.astype(v.dtype), v)

    nb = seq // Q_BLOCK
    out = lax.map(block, (jnp.arange(nb), to_blocks(q1), to_blocks(q2)))
    return from_blocks(out)


def mla_sb_mixer(x, w_in, q_norm, w_uq, kv_norm, w_ukv, w_out):
    b, s, _ = x.shape
    pos = jnp.arange(s)
    proj = x @ w_in
    o1 = MLA_Q_RANK
    o2 = o1 + MLA_KV_RANK
    o3 = o2 + MLA_ROPE
    c_q, c_kv, k_r, sb = proj[..., :o1], proj[..., o1:o2], proj[..., o2:o3], proj[..., o3:]

    q = (rms_norm(c_q, q_norm) @ w_uq).reshape(b, s, MLA_HEADS, MLA_NOPE + MLA_ROPE)
    q = jnp.transpose(q, (0, 2, 1, 3))
    q_nope, q_rope = q[..., :MLA_NOPE], rope(q[..., MLA_NOPE:], pos)
    kv = (rms_norm(c_kv, kv_norm) @ w_ukv).reshape(b, s, MLA_HEADS, MLA_NOPE + MLA_V)
    kv = jnp.transpose(kv, (0, 2, 1, 3))
    k_nope, v_a = kv[..., :MLA_NOPE], kv[..., MLA_NOPE:]
    k_rope = rope(k_r, pos)
    o_a = mla_attention(q_nope, q_rope, k_nope, k_rope, v_a)

    sb = jnp.transpose(sb.reshape(b, s, 3, SB_HEADS, SB_DIM), (2, 0, 3, 1, 4))
    o_b = stick_breaking_attention(sb[0], sb[1], sb[2])

    o = jnp.concatenate([o_a, o_b], axis=1)
    o = jnp.transpose(o, (0, 2, 1, 3)).reshape(b, s, OUT_AB)
    return o @ w_out


def diff_mixer(x, w_in, lq1, lk1, lq2, lk2, subln, w_out, layer_idx):
    b, s, _ = x.shape
    lambda_init = 0.8 - 0.6 * math.exp(-0.3 * layer_idx)
    proj = x @ w_in
    qk_w = DIFF_HEADS * 2 * DIFF_DIM
    q = jnp.transpose(proj[..., :qk_w].reshape(b, s, DIFF_HEADS, 2, DIFF_DIM), (3, 0, 2, 1, 4))
    k = jnp.transpose(proj[..., qk_w:2 * qk_w].reshape(b, s, DIFF_HEADS, 2, DIFF_DIM), (3, 0, 2, 1, 4))
    v = jnp.transpose(proj[..., 2 * qk_w:].reshape(b, s, DIFF_HEADS, 2 * DIFF_DIM), (0, 2, 1, 3))
    lam = (jnp.exp(jnp.sum(lq1.astype(jnp.float32) * lk1.astype(jnp.float32)))
           - jnp.exp(jnp.sum(lq2.astype(jnp.float32) * lk2.astype(jnp.float32)))
           + lambda_init)
    o = differential_attention(q[0], q[1], k[0], k[1], v, lam)
    o = rms_norm(o, subln) * (1.0 - lambda_init)
    o = jnp.transpose(o, (0, 2, 1, 3)).reshape(b, s, OUT_C)
    return o @ w_out


def conv_ffn(x, w_up, conv_w, conv_b, w_down):
    s = x.shape[1]
    h = x @ w_up
    hp = jnp.pad(h, ((0, 0), (CONV_W - 1, 0), (0, 0)))
    h = sum(hp[:, j:j + s] * conv_w[j] for j in range(CONV_W)) + conv_b
    g, u = h[..., :FFN_DIM], h[..., FFN_DIM:]
    return (jax.nn.silu(g) * u) @ w_down


def setup_inputs(seed: int = 0) -> dict:
    key = jax.random.key(seed)
    ks = jax.random.split(key, 24)
    f32 = jnp.float32

    def nrm(k, shape, fan_in):
        return jax.random.normal(k, shape, f32) * (fan_in ** -0.5)

    def gain(k, shape):
        return 1.0 + 0.02 * jax.random.normal(k, shape, f32)

    return {
        "x": jax.random.normal(ks[0], (BATCH, SEQ, D_MODEL), f32),
        "norm_mix": gain(ks[1], (DEPTH, D_MODEL)),
        "norm_ffn": gain(ks[2], (DEPTH, D_MODEL)),
        "norm_final": gain(ks[3], (D_MODEL,)),
        "ab_w_in": nrm(ks[4], (N_EVEN, D_MODEL, IN_AB), D_MODEL),
        "ab_q_norm": gain(ks[5], (N_EVEN, MLA_Q_RANK)),
        "ab_w_uq": nrm(ks[6], (N_EVEN, MLA_Q_RANK, MLA_HEADS * (MLA_NOPE + MLA_ROPE)), MLA_Q_RANK),
        "ab_kv_norm": gain(ks[7], (N_EVEN, MLA_KV_RANK)),
        "ab_w_ukv": nrm(ks[8], (N_EVEN, MLA_KV_RANK, MLA_HEADS * (MLA_NOPE + MLA_V)), MLA_KV_RANK),
        "ab_w_out": nrm(ks[9], (N_EVEN, OUT_AB, D_MODEL), OUT_AB),
        "c_w_in": nrm(ks[10], (N_ODD, D_MODEL, IN_C), D_MODEL),
        "c_lambda_q1": 0.1 * jax.random.normal(ks[11], (N_ODD, DIFF_DIM), f32),
        "c_lambda_k1": 0.1 * jax.random.normal(ks[12], (N_ODD, DIFF_DIM), f32),
        "c_lambda_q2": 0.1 * jax.random.normal(ks[13], (N_ODD, DIFF_DIM), f32),
        "c_lambda_k2": 0.1 * jax.random.normal(ks[14], (N_ODD, DIFF_DIM), f32),
        "c_subln": gain(ks[15], (N_ODD, 2 * DIFF_DIM)),
        "c_w_out": nrm(ks[16], (N_ODD, OUT_C, D_MODEL), OUT_C),
        "ffn_w_up": nrm(ks[17], (DEPTH, D_MODEL, 2 * FFN_DIM), D_MODEL),
        "ffn_conv_w": nrm(ks[18], (DEPTH, CONV_W, 2 * FFN_DIM), CONV_W),
        "ffn_conv_b": 0.02 * jax.random.normal(ks[19], (DEPTH, 2 * FFN_DIM), f32),
        "ffn_w_down": nrm(ks[20], (DEPTH, FFN_DIM, D_MODEL), FFN_DIM),
    }


def reference(x, norm_mix, norm_ffn, norm_final, ab_w_in, ab_q_norm, ab_w_uq, ab_kv_norm,
              ab_w_ukv, ab_w_out, c_w_in, c_lambda_q1, c_lambda_k1, c_lambda_q2, c_lambda_k2,
              c_subln, c_w_out, ffn_w_up, ffn_conv_w, ffn_conv_b, ffn_w_down):
    h = x
    for i in range(DEPTH):
        j = i // 2
        hn = rms_norm(h, norm_mix[i])
        if i % 2 == 0:
            h = h + mla_sb_mixer(hn, ab_w_in[j], ab_q_norm[j], ab_w_uq[j], ab_kv_norm[j],
                                 ab_w_ukv[j], ab_w_out[j])
        else:
            h = h + diff_mixer(hn, c_w_in[j], c_lambda_q1[j], c_lambda_k1[j], c_lambda_q2[j],
                               c_lambda_k2[j], c_subln[j], c_w_out[j], i)
        hn = rms_norm(h, norm_ffn[i])
        h = h + conv_ffn(hn, ffn_w_up[i], ffn_conv_w[i], ffn_conv_b[i], ffn_w_down[i])
    return rms_norm(h, norm_final)
```

```cpp
#include <hip/hip_runtime.h>
#include <cstdio>
#include <cstdint>
#include <cmath>
namespace pg8 {
#define PG8_LAS __attribute__((address_space(3)))
typedef unsigned short bf16_t;
typedef short bf16x8 __attribute__((ext_vector_type(8)));
typedef float f32x4 __attribute__((ext_vector_type(4)));
typedef unsigned u32x4 __attribute__((ext_vector_type(4)));
constexpr int BM = 256, BK = 64, HALF = 128, HTB = HALF * BK * 2  , STAGE_BYTES = 8 * HTB, NXCD = 8, WGM = 8;

__host__ __device__ __forceinline__ int lds_byte(int r, int c) { const int st = (r >> 4) * 2 + (c >> 5), rr = r & 15, cc = c & 31, ob = rr * 64 + cc * 2; return st * 1024 + (ob ^ (((ob >> 9) & 1) << 5)); }
__host__ __device__ __forceinline__ void stage_rc(int b, int& R, int& C) { const int st = b / 1024, sb = b % 1024, swz = sb ^ (((sb >> 9) & 1) << 5); R = (st >> 1) * 16 + swz / 64; C = (st & 1) * 32 + (swz % 64) / 2; }
__host__ __device__ __forceinline__ int perm32(int rho) { const int n = rho >> 4, i = rho & 15; return 8 * (i >> 2) + 4 * n + (i & 3); }

struct Unit { int pm, pn; };
struct Gemm { const bf16_t* A; const bf16_t* Bt; int M, N, K; };

struct StaticOrder {
    int nM, nN, nwg, G, c;
    __host__ __device__ void init(int M, int N, int G_, int c_) { nM = M / BM; nN = N / BM; nwg = nM * nN; G = G_; c = c_; }
    __host__ __device__ bool next(int i, Unit& u) const {
        const long L = (long)i * G + c; if (L >= nwg) return false;
        int wgid = (int)L; { const int q = nwg / NXCD, r = nwg % NXCD, xcd = wgid % NXCD, off = wgid / NXCD; wgid = (xcd < r ? xcd * (q + 1) : r * (q + 1) + (xcd - r) * q) + off; }
        const int nig = WGM * nN, gid = wgid / nig, fm = gid * WGM, gsz = (nM - fm) < WGM ? (nM - fm) : WGM;
        u.pm = fm + ((wgid % nig) % gsz); u.pn = (wgid % nig) / gsz; return true;
    }
    __device__ __forceinline__ void a_ready(const Unit&) const {}
    __device__ __forceinline__ void done(const Unit&) const {}
};
__device__ __forceinline__ unsigned cvt_pk_bf16(float lo, float hi) { unsigned r; asm volatile("v_cvt_pk_bf16_f32 %0, %1, %2" : "=v"(r) : "v"(lo), "v"(hi)); return r; }
typedef float f32x2 __attribute__((ext_vector_type(2)));
constexpr float RMS_EPS = 1e-6f;
__device__ __forceinline__ unsigned f2bf1(float f) { unsigned u = __builtin_bit_cast(unsigned, f); return (u + 0x7fffu + ((u >> 16) & 1u)) >> 16; }
__device__ __forceinline__ void store8(bf16_t* p, const f32x4& v0, const f32x4& v1) {
    u32x4 w; w.x = cvt_pk_bf16(v0[0], v0[1]); w.y = cvt_pk_bf16(v0[2], v0[3]); w.z = cvt_pk_bf16(v1[0], v1[1]); w.w = cvt_pk_bf16(v1[2], v1[3]); *(u32x4*)p = w; }
__device__ __forceinline__ float sq8(const f32x4& v0, const f32x4& v1) { return ((v0[0] * v0[0] + v0[1] * v0[1]) + (v0[2] * v0[2] + v0[3] * v0[3])) + ((v1[0] * v1[0] + v1[1] * v1[1]) + (v1[2] * v1[2] + v1[3] * v1[3])); }
typedef unsigned long long u64_t;
__device__ __forceinline__ void atomic_add_fix(u64_t* p, float v) { (void)__hip_atomic_fetch_add(p, (u64_t)(v * 4294967296.f), __ATOMIC_RELAXED, __HIP_MEMORY_SCOPE_AGENT); }
__device__ __forceinline__ float rstd_fix(const u64_t* ss, int row, float invn) { return rsqrtf((float)ss[row] * (invn * 2.3283064365386963e-10f) + RMS_EPS); }
__device__ __forceinline__ void store8_t(bf16_t* p, const f32x4& v0, const f32x4& v1) {
#pragma unroll
    for (int j = 0; j < 4; ++j) { p[(size_t)j * 4096] = (bf16_t)f2bf1(v0[j]); p[(size_t)(j + 4) * 4096] = (bf16_t)f2bf1(v1[j]); } }
__device__ __forceinline__ void rope8(f32x4& v0, f32x4& v1, const f32x4& c, const f32x4& s) {
    const f32x4 a = v0, b = v1;
    v0[0] = a[0] * c[0] - a[1] * s[0]; v0[1] = a[1] * c[0] + a[0] * s[0]; v0[2] = a[2] * c[1] - a[3] * s[1]; v0[3] = a[3] * c[1] + a[2] * s[1];
    v1[0] = b[0] * c[2] - b[1] * s[2]; v1[1] = b[1] * c[2] + b[0] * s[2]; v1[2] = b[2] * c[3] - b[3] * s[3]; v1[3] = b[3] * c[3] + b[2] * s[3]; }

struct EpiABIn {
    static constexpr bool PERM = true, AFTER_DRAIN = false;
    const u64_t* ss0; bf16_t *CQ, *CKV, *KR, *SBQ, *SBK, *SBVT; u64_t *ssq, *sskv; const float *rc, *rs;
    __device__ __forceinline__ void operator()(const f32x4 (&acc)[2][2][4][2], const Unit& u, int wr, int wc, int fr, int fq) const {
        const int pn = u.pn;
#pragma unroll
        for (int ai = 0; ai < 2; ++ai)
#pragma unroll
            for (int m = 0; m < 4; ++m) {
                const int row = u.pm * BM + ai * HALF + wr * 64 + m * 16 + fr;
                const float sc = rstd_fix(ss0, row, 1.f / 4096.f);
                if (pn < 6) {
                    bf16_t* dst = pn < 4 ? CQ + (size_t)row * 1024 + pn * 256 : CKV + (size_t)row * 512 + (pn - 4) * 256;
                    float part = 0.f;
#pragma unroll
                    for (int bj = 0; bj < 2; ++bj) { const f32x4 v0 = acc[ai][bj][m][0] * sc, v1 = acc[ai][bj][m][1] * sc; part += sq8(v0, v1); store8(dst + bj * HALF + wc * 32 + 8 * fq, v0, v1); }
                    part += __shfl_xor(part, 16); part += __shfl_xor(part, 32);
                    if (fq == 0) atomic_add_fix((pn < 4 ? ssq : sskv) + row, part);
                } else if (pn == 6) {
                    if (wc < 2) { f32x4 v0 = acc[ai][0][m][0] * sc, v1 = acc[ai][0][m][1] * sc; const int pos = row & 4095, i0 = 16 * wc + 4 * fq;
                        rope8(v0, v1, *(const f32x4*)(rc + pos * 32 + i0), *(const f32x4*)(rs + pos * 32 + i0)); store8(KR + (size_t)row * 64 + wc * 32 + 8 * fq, v0, v1); }
                } else {
                    const int t = (pn - 7) >> 3, ct = ((pn - 7) & 7) * 256;
                    if (t < 2) { bf16_t* dst = (t == 0 ? SBQ : SBK) + (size_t)row * 2048 + ct; const float sq = t == 0 ? sc * 0.08838834764831845f : sc;
#pragma unroll
                        for (int bj = 0; bj < 2; ++bj) store8(dst + bj * HALF + wc * 32 + 8 * fq, acc[ai][bj][m][0] * sq, acc[ai][bj][m][1] * sq);
                    } else { const int b = row >> 12, s = row & 4095;
#pragma unroll
                        for (int bj = 0; bj < 2; ++bj) { const int col = ct + bj * HALF + wc * 32 + 8 * fq; store8_t(SBVT + ((size_t)(b * 2048 + col)) * 4096 + s, acc[ai][bj][m][0] * sc, acc[ai][bj][m][1] * sc); }
                    }
                }
            }
    }
};
struct EpiUQ {
    static constexpr bool PERM = true, AFTER_DRAIN = false;
    const u64_t* ssq; bf16_t* QA; const float *rc, *rs;
    __device__ __forceinline__ void operator()(const f32x4 (&acc)[2][2][4][2], const Unit& u, int wr, int wc, int fr, int fq) const {
#pragma unroll
        for (int ai = 0; ai < 2; ++ai)
#pragma unroll
            for (int m = 0; m < 4; ++m) {
                const int row = u.pm * BM + ai * HALF + wr * 64 + m * 16 + fr;
                const float sc = rstd_fix(ssq, row, 1.f / 1024.f) * (0.07216878364870322f * 1.4426950408889634f);
#pragma unroll
                for (int bj = 0; bj < 2; ++bj) { const int cb = u.pn * BM + bj * HALF + wc * 32, hd = cb % 192;
                    f32x4 v0 = acc[ai][bj][m][0] * sc, v1 = acc[ai][bj][m][1] * sc;
                    if (hd >= 128) { const int pos = row & 4095, i0 = (hd - 128) / 2 + 4 * fq; rope8(v0, v1, *(const f32x4*)(rc + pos * 32 + i0), *(const f32x4*)(rs + pos * 32 + i0)); }
                    store8(QA + (size_t)row * 3072 + cb + 8 * fq, v0, v1); }
            }
    }
};
struct EpiUKV {
    static constexpr bool PERM = true, AFTER_DRAIN = false;
    const u64_t* sskv; bf16_t *KN, *VAT;
    __device__ __forceinline__ void operator()(const f32x4 (&acc)[2][2][4][2], const Unit& u, int wr, int wc, int fr, int fq) const {
#pragma unroll
        for (int ai = 0; ai < 2; ++ai)
#pragma unroll
            for (int m = 0; m < 4; ++m) {
                const int row = u.pm * BM + ai * HALF + wr * 64 + m * 16 + fr;
                const float sc = rstd_fix(sskv, row, 1.f / 512.f);
                if (u.pn < 8) {
#pragma unroll
                    for (int bj = 0; bj < 2; ++bj) store8(KN + (size_t)row * 2048 + u.pn * BM + bj * HALF + wc * 32 + 8 * fq, acc[ai][bj][m][0] * sc, acc[ai][bj][m][1] * sc);
                } else { const int b = row >> 12, s = row & 4095;
#pragma unroll
                    for (int bj = 0; bj < 2; ++bj) { const int col = (u.pn - 8) * BM + bj * HALF + wc * 32 + 8 * fq; store8_t(VAT + ((size_t)(b * 2048 + col)) * 4096 + s, acc[ai][bj][m][0] * sc, acc[ai][bj][m][1] * sc); }
                }
            }
    }
};
struct EpiResid {
    static constexpr bool PERM = true, AFTER_DRAIN = false;
    const float* resid; float* Hout; bf16_t* HB; u64_t* ssn;
    __device__ __forceinline__ void operator()(const f32x4 (&acc)[2][2][4][2], const Unit& u, int wr, int wc, int fr, int fq) const {
#pragma unroll
        for (int ai = 0; ai < 2; ++ai)
#pragma unroll
            for (int m = 0; m < 4; ++m) {
                const int row = u.pm * BM + ai * HALF + wr * 64 + m * 16 + fr; float part = 0.f;
#pragma unroll
                for (int bj = 0; bj < 2; ++bj) { const size_t off = (size_t)row * 4096 + u.pn * BM + bj * HALF + wc * 32 + 8 * fq;
                    const f32x4 h0 = *(const f32x4*)(resid + off) + acc[ai][bj][m][0], h1 = *(const f32x4*)(resid + off + 4) + acc[ai][bj][m][1];
                    *(f32x4*)(Hout + off) = h0; *(f32x4*)(Hout + off + 4) = h1; if (HB) store8(HB + off, h0, h1); part += sq8(h0, h1); }
                part += __shfl_xor(part, 16); part += __shfl_xor(part, 32);
                if (fq == 0 && ssn) atomic_add_fix(ssn + row, part);
            }
    }
};
struct EpiUp {
    static constexpr bool PERM = true, AFTER_DRAIN = false;
    const u64_t* ss; bf16_t* UP;
    __device__ __forceinline__ void operator()(const f32x4 (&acc)[2][2][4][2], const Unit& u, int wr, int wc, int fr, int fq) const {
#pragma unroll
        for (int ai = 0; ai < 2; ++ai)
#pragma unroll
            for (int m = 0; m < 4; ++m) {
                const int row = u.pm * BM + ai * HALF + wr * 64 + m * 16 + fr;
                const float sc = rstd_fix(ss, row, 1.f / 4096.f);
#pragma unroll
                for (int bj = 0; bj < 2; ++bj) store8(UP + (size_t)row * 22016 + u.pn * BM + bj * HALF + wc * 32 + 8 * fq, acc[ai][bj][m][0] * sc, acc[ai][bj][m][1] * sc);
            }
    }
};
struct EpiCIn {
    static constexpr bool PERM = true, AFTER_DRAIN = false;
    const u64_t* ss; bf16_t *CQ1, *CK1, *CVT; unsigned* kmax;
    __device__ __forceinline__ void operator()(const f32x4 (&acc)[2][2][4][2], const Unit& u, int wr, int wc, int fr, int fq) const {
        float kmx[2] = {0.f, 0.f};
#pragma unroll
        for (int ai = 0; ai < 2; ++ai)
#pragma unroll
            for (int m = 0; m < 4; ++m) {
                const int row = u.pm * BM + ai * HALF + wr * 64 + m * 16 + fr;
                const float sc = rstd_fix(ss, row, 1.f / 4096.f);
                if (u.pn < 32) { bf16_t* dst = (u.pn < 16 ? CQ1 : CK1) + (size_t)row * 4096 + (u.pn & 15) * BM; const float sq = u.pn < 16 ? sc * (0.08838834764831845f * 1.4426950408889634f) : sc;
#pragma unroll
                    for (int bj = 0; bj < 2; ++bj) { const f32x4 v0 = acc[ai][bj][m][0] * sq, v1 = acc[ai][bj][m][1] * sq; store8(dst + bj * HALF + wc * 32 + 8 * fq, v0, v1);
                        if (u.pn >= 16) { float part = sq8(v0, v1); part += __shfl_xor(part, 16); part += __shfl_xor(part, 32); kmx[bj] = fmaxf(kmx[bj], part); } }
                } else { const int b = row >> 12, s = row & 4095;
#pragma unroll
                    for (int bj = 0; bj < 2; ++bj) { const int col = (u.pn - 32) * BM + bj * HALF + wc * 32 + 8 * fq; store8_t(CVT + ((size_t)(b * 4096 + col)) * 4096 + s, acc[ai][bj][m][0] * sc, acc[ai][bj][m][1] * sc); }
                }
            }
        if (u.pn >= 16 && u.pn < 32) {
#pragma unroll
            for (int bj = 0; bj < 2; ++bj) { float v = kmx[bj]; v = fmaxf(v, __shfl_xor(v, 1)); v = fmaxf(v, __shfl_xor(v, 2)); v = fmaxf(v, __shfl_xor(v, 4)); v = fmaxf(v, __shfl_xor(v, 8));
                if (fr == 0 && fq == 0) (void)__hip_atomic_fetch_max(kmax + (((u.pm >> 4) * 32 + (u.pn - 16) * 2 + bj) * 4 + wc), __builtin_bit_cast(unsigned, v), __ATOMIC_RELAXED, __HIP_MEMORY_SCOPE_AGENT); } }
    }
};

template <class Epi, class Sched, bool ALIGN_EPI = false, bool SP2 = false>
__device__ __forceinline__ void gemm_phase(PG8_LAS unsigned char* lds, const Gemm g, const Sched& S, const Epi& E) {
    const int tid = threadIdx.x, wid = __builtin_amdgcn_readfirstlane(tid >> 6), lane = tid & 63, wr = wid >> 2, wc = wid & 3, fr = lane & 15, fq = lane >> 4;
    const int K = g.K, nt = K / BK;
    unsigned voffA[2], voffB[2];
#pragma unroll
    for (int i = 0; i < 2; ++i) { int R, C; stage_rc(tid * 16 + i * 8192, R, C); const int Rb = Epi::PERM ? ((R & ~31) + perm32(R & 31)) : R;
        voffA[i] = (unsigned)(R * K + C) * 2u; voffB[i] = (unsigned)(Rb * K + C) * 2u; }
    const size_t kstep = (size_t)(BK * 2);
    const size_t hstep = (size_t)HALF * K * 2;
    const size_t tstep = 2 * hstep;
    const unsigned ldsw = (unsigned)wid * 1024u;
    const int aoff = lds_byte(wr * 64 + fr, fq * 8), boff = lds_byte(wc * 32 + fr, fq * 8);
#define PG8_SA(b, h) (((b) * 2 + (h)) * HTB)
#define PG8_SB(b, h) ((4 + (b) * 2 + (h)) * HTB)
#define PG8_STAGE(bufoff, gbase, voff) do { _Pragma("unroll") for (int _i = 0; _i < 2; ++_i) \
        __builtin_amdgcn_global_load_lds((const unsigned*)((const char*)(gbase) + (voff)[_i]), (PG8_LAS unsigned*)(lds + (bufoff) + ldsw + _i * 8192), 16, 0, 0); } while (0)
#define PG8_LDA(dst, b, h) do { _Pragma("unroll") for (int m = 0; m < 4; ++m) _Pragma("unroll") for (int k = 0; k < 2; ++k) dst[m][k] = *(const PG8_LAS bf16x8*)(lds + PG8_SA(b, h) + aoff + m * 2048 + k * 1024); } while (0)
#define PG8_LDB(dst, b, h) do { _Pragma("unroll") for (int n = 0; n < 2; ++n) _Pragma("unroll") for (int k = 0; k < 2; ++k) dst[n][k] = *(const PG8_LAS bf16x8*)(lds + PG8_SB(b, h) + boff + n * 2048 + k * 1024); } while (0)
#define PG8_MMA(ai, bj, At, Bt) do { __builtin_amdgcn_s_setprio(1); _Pragma("unroll") for (int m = 0; m < 4; ++m) _Pragma("unroll") for (int n = 0; n < 2; ++n) _Pragma("unroll") for (int k = 0; k < 2; ++k) \
        acc[ai][bj][m][n] = __builtin_amdgcn_mfma_f32_16x16x32_bf16(Bt[n][k], At[m][k], acc[ai][bj][m][n], 0, 0, 0); __builtin_amdgcn_s_setprio(0); } while (0)
#define PG8_WAIT_V(n) asm volatile("s_waitcnt vmcnt(" #n ")" ::: "memory")
#define PG8_WAIT_L(n) asm volatile("s_waitcnt lgkmcnt(" #n ")" ::: "memory")
#define PG8_BAR __builtin_amdgcn_s_barrier()
#define PG8_SCHED __builtin_amdgcn_sched_barrier(0)
    Unit cur, nxt; int ui = 0;
    if (!S.next(0, cur)) return;
    f32x4 acc[2][2][4][2];
#pragma unroll
    for (int a = 0; a < 2; ++a)
#pragma unroll
        for (int b = 0; b < 2; ++b)
#pragma unroll
            for (int m = 0; m < 4; ++m)
#pragma unroll
                for (int n = 0; n < 2; ++n) acc[a][b][m][n] = (f32x4){0.f, 0.f, 0.f, 0.f};
    bf16x8 At[4][2], B0[2][2], B1[2][2];
    const char* cA = (const char*)g.A + (size_t)cur.pm * tstep; const char* cB = (const char*)g.Bt + (size_t)cur.pn * tstep;
    S.a_ready(cur);
    if constexpr (SP2) {
        PG8_STAGE(PG8_SB(0, 0), cB, voffB); PG8_STAGE(PG8_SB(0, 1), cB + hstep, voffB); PG8_STAGE(PG8_SA(0, 0), cA, voffA); PG8_STAGE(PG8_SA(0, 1), cA + hstep, voffA);
        if (wr == 1) PG8_BAR;
        PG8_WAIT_V(2); PG8_BAR;
        PG8_STAGE(PG8_SB(1, 0), cB + kstep, voffB); PG8_STAGE(PG8_SA(1, 0), cA + kstep, voffA); PG8_STAGE(PG8_SB(1, 1), cB + hstep + kstep, voffB);
        PG8_WAIT_V(6); PG8_BAR;
    } else {
        PG8_STAGE(PG8_SB(0, 0), cB, voffB); PG8_STAGE(PG8_SA(0, 0), cA, voffA); PG8_STAGE(PG8_SB(0, 1), cB + hstep, voffB); PG8_STAGE(PG8_SA(0, 1), cA + hstep, voffA);
        if (wr == 1) PG8_BAR;
        PG8_WAIT_V(4); PG8_BAR;
        PG8_STAGE(PG8_SB(1, 0), cB + kstep, voffB); PG8_STAGE(PG8_SA(1, 0), cA + kstep, voffA); PG8_STAGE(PG8_SB(1, 1), cB + hstep + kstep, voffB);
        PG8_WAIT_V(6); PG8_BAR;
    }
    for (;;) {
        const bool has_next = S.next(ui + 1, nxt);
        const char* nA = has_next ? (const char*)g.A + (size_t)nxt.pm * tstep : cA; const char* nB = has_next ? (const char*)g.Bt + (size_t)nxt.pn * tstep : cB;
        for (int t = 0; t < nt; t += 2) {
            const bool last = (t == nt - 2);
            const char* a1 = cA + (size_t)(t + 1) * kstep;
            const char* a2 = last ? nA : cA + (size_t)(t + 2) * kstep; const char* b2 = last ? nB : cB + (size_t)(t + 2) * kstep;
            const char* a3 = a2 + kstep; const char* b3 = b2 + kstep;
            if (last && has_next) S.a_ready(nxt);
            if constexpr (SP2) {
            PG8_LDB(B0, 0, 0); PG8_LDB(B1, 0, 1); PG8_SCHED; PG8_LDA(At, 0, 0); PG8_STAGE(PG8_SA(1, 1), a1 + hstep, voffA);
            PG8_WAIT_V(8); PG8_WAIT_L(0); PG8_BAR; PG8_MMA(0, 0, At, B0); PG8_MMA(0, 1, At, B1); PG8_BAR; PG8_SCHED;
            PG8_LDA(At, 0, 1); PG8_STAGE(PG8_SB(0, 0), b2, voffB); PG8_STAGE(PG8_SB(0, 1), b2 + hstep, voffB); PG8_STAGE(PG8_SA(0, 0), a2, voffA);
            PG8_WAIT_V(8); PG8_WAIT_L(0); PG8_BAR; PG8_MMA(1, 0, At, B0); PG8_MMA(1, 1, At, B1); PG8_BAR; PG8_SCHED;
            PG8_LDB(B0, 1, 0); PG8_LDB(B1, 1, 1); PG8_SCHED; PG8_LDA(At, 1, 0); PG8_STAGE(PG8_SA(0, 1), a2 + hstep, voffA);
            PG8_WAIT_V(8); PG8_WAIT_L(0); PG8_BAR; PG8_MMA(0, 0, At, B0); PG8_MMA(0, 1, At, B1); PG8_BAR; PG8_SCHED;
            PG8_LDA(At, 1, 1); PG8_STAGE(PG8_SB(1, 0), b3, voffB); PG8_STAGE(PG8_SB(1, 1), b3 + hstep, voffB); PG8_STAGE(PG8_SA(1, 0), a3, voffA);
            PG8_WAIT_V(8); PG8_WAIT_L(0); PG8_BAR; PG8_MMA(1, 0, At, B0); PG8_MMA(1, 1, At, B1); PG8_BAR; PG8_SCHED;
            } else {
            PG8_LDB(B0, 0, 0); PG8_SCHED; PG8_LDA(At, 0, 0); PG8_STAGE(PG8_SA(1, 1), a1 + hstep, voffA);
            PG8_WAIT_L(8); PG8_BAR; PG8_WAIT_L(0); PG8_MMA(0, 0, At, B0); PG8_BAR; PG8_SCHED;
            PG8_LDB(B1, 0, 1); PG8_STAGE(PG8_SB(0, 0), b2, voffB);
            PG8_BAR; PG8_WAIT_L(0); PG8_MMA(0, 1, At, B1); PG8_BAR;
            PG8_LDA(At, 0, 1); PG8_STAGE(PG8_SA(0, 0), a2, voffA);
            PG8_BAR; PG8_WAIT_L(0); PG8_MMA(1, 0, At, B0); PG8_BAR; PG8_SCHED;
            PG8_STAGE(PG8_SB(0, 1), b2 + hstep, voffB);
            PG8_WAIT_V(6); PG8_BAR; PG8_MMA(1, 1, At, B1); PG8_BAR;
            PG8_LDB(B0, 1, 0); PG8_SCHED; PG8_LDA(At, 1, 0); PG8_STAGE(PG8_SA(0, 1), a2 + hstep, voffA);
            PG8_WAIT_L(8); PG8_BAR; PG8_WAIT_L(0); PG8_MMA(0, 0, At, B0); PG8_BAR; PG8_SCHED;
            PG8_LDB(B1, 1, 1); PG8_STAGE(PG8_SB(1, 0), b3, voffB);
            PG8_BAR; PG8_WAIT_L(0); PG8_MMA(0, 1, At, B1); PG8_BAR;
            PG8_LDA(At, 1, 1); PG8_STAGE(PG8_SA(1, 0), a3, voffA);
            PG8_BAR; PG8_WAIT_L(0); PG8_MMA(1, 0, At, B0); PG8_BAR; PG8_SCHED;
            PG8_STAGE(PG8_SB(1, 1), b3 + hstep, voffB);
            PG8_WAIT_V(6); PG8_BAR; PG8_MMA(1, 1, At, B1); PG8_BAR;
            }
        }
        if constexpr (ALIGN_EPI) { if (wr == 0) PG8_BAR; }
        if constexpr (!Epi::AFTER_DRAIN) { E(acc, cur, wr, wc, fr, fq); S.done(cur); }
        if (!has_next) break;
#pragma unroll
        for (int a = 0; a < 2; ++a)
#pragma unroll
            for (int b = 0; b < 2; ++b)
#pragma unroll
                for (int m = 0; m < 4; ++m)
#pragma unroll
                    for (int n = 0; n < 2; ++n) acc[a][b][m][n] = (f32x4){0.f, 0.f, 0.f, 0.f};
        cur = nxt; cA = nA; cB = nB; ++ui;
        if constexpr (ALIGN_EPI) { if (wr == 1) PG8_BAR; }
    }
    PG8_WAIT_V(0);
    if constexpr (!ALIGN_EPI) { if (wr == 0) PG8_BAR; }
    PG8_BAR;
    if constexpr (Epi::AFTER_DRAIN) { E.fused(acc, cur, wr, wc, fr, fq, lds, wid, lane); S.done(cur); }
#undef PG8_SA
#undef PG8_SB
#undef PG8_STAGE
#undef PG8_LDA
#undef PG8_LDB
#undef PG8_MMA
#undef PG8_WAIT_V
#undef PG8_WAIT_L
#undef PG8_BAR
#undef PG8_SCHED
}
}

constexpr int NWAVES = 8;
constexpr int SEQ = 4096, DM = 4096, M = 8192, FF = 11008, FF2 = 22016, NAB = 7936;
constexpr float EPS = 1e-6f;
constexpr float LAMBDA_INIT = 0.35550906f;
#ifndef MK_ONE_LAUNCH
#define MK_ONE_LAUNCH 1
#endif
constexpr int N_PHASES = 15;

constexpr size_t MiB = 1u << 20;
constexpr size_t WS_CTL = 0, CTL_ZERO_BYTES = 1 * MiB;
constexpr size_t WS_SS = 262144;
constexpr size_t WS_ROPE = 1 * MiB;
constexpr size_t WS_WABIN = 2 * MiB, WS_WUQ = 64 * MiB, WS_WUKV = 70 * MiB, WS_WABOUT = 74 * MiB, WS_WCIN = 106 * MiB, WS_WCOUT = 202 * MiB;
constexpr size_t WS_WUP0 = 234 * MiB, WS_WUP1 = 406 * MiB, WS_WDN0 = 578 * MiB, WS_WDN1 = 664 * MiB;
constexpr size_t WS_HB = 752 * MiB, WS_H = 816 * MiB, WS_CQ = 944 * MiB, WS_CKV = 960 * MiB, WS_KR = 968 * MiB, WS_SBQ = 970 * MiB, WS_SBK = 1002 * MiB, WS_SBVT = 1034 * MiB;
constexpr size_t WS_QA = 1066 * MiB, WS_KN = 1114 * MiB, WS_VAT = 1146 * MiB, WS_O = 1178 * MiB, WS_UP = 1242 * MiB, WS_ACT = 1586 * MiB;
constexpr size_t WS_CQ1 = 1758 * MiB, WS_CK1 = 1822 * MiB, WS_CVT = 1886 * MiB, WS_DS = 1950 * MiB, WS_DS1 = 2078 * MiB, WS_END = 2206 * MiB;
static_assert(WS_WABIN + (size_t)NAB * 4096 * 2 <= WS_WUQ && WS_WUP0 + (size_t)FF2 * 4096 * 2 <= WS_WUP1 && WS_WDN1 + (size_t)4096 * FF * 2 <= WS_HB && WS_UP + (size_t)M * FF2 * 2 <= WS_ACT && WS_ACT + (size_t)M * FF * 2 <= WS_CQ1, "d_ws map");
constexpr int CW_KMAX = 2048, CW_QUEUE = 2560;
constexpr int CW_BAR = 4096;

constexpr int RING_OFF = 0, RING_BYTES = 131072;
constexpr int LDSCTL_OFF = 139264, MISC_OFF = LDSCTL_OFF + 320;
constexpr int LDS_BYTES = 147456;

#define GAS __attribute__((address_space(1)))
#define LAS __attribute__((address_space(3)))
typedef unsigned short bf16;
typedef unsigned v4u __attribute__((ext_vector_type(4)));
typedef float f32x4 __attribute__((ext_vector_type(4)));
typedef short bf16x8 __attribute__((ext_vector_type(8)));
typedef GAS unsigned gu32;
#define RLX_AGENT __ATOMIC_RELAXED, __HIP_MEMORY_SCOPE_AGENT
#define LDS_WAIT() asm volatile("s_waitcnt lgkmcnt(0)" ::: "memory")
#define VM_WAIT() asm volatile("s_waitcnt vmcnt(0)" ::: "memory")
__device__ __forceinline__ unsigned f2bf(float f) { unsigned u = __builtin_bit_cast(unsigned, f); return (u + 0x7fffu + ((u >> 16) & 1u)) >> 16; }
__device__ __forceinline__ unsigned pk2(float lo, float hi) { return f2bf(lo) | (f2bf(hi) << 16); }
__device__ __forceinline__ float bf2f(unsigned short b) { return __builtin_bit_cast(float, (unsigned)b << 16); }
__device__ __forceinline__ float bflo(unsigned w) { return __builtin_bit_cast(float, w << 16); }
__device__ __forceinline__ float bfhi(unsigned w) { return __builtin_bit_cast(float, w & 0xffff0000u); }
__device__ __forceinline__ float wave_sum(float v) {
#pragma unroll
    for (int o = 1; o < 64; o <<= 1) v += __shfl_xor(v, o);
    return v;
}
__device__ __forceinline__ float wave_max(float v) {
#pragma unroll
    for (int o = 1; o < 64; o <<= 1) v = fmaxf(v, __shfl_xor(v, o));
    return v;
}
#define XB_TMO      128
#define XB_XCNT(j)  (256  + 64 * (j))
#define XB_XSUB(j)  (1280 + 64 * (j))
#define XB_XGEN(j)  (2304 + 64 * (j))
#define XB_TOP      3328
#define XB_TOPGEN   3392
#define XCD_BAR_WORDS 3456
#define XB_SPIN_CAP (1u << 18)

__device__ __forceinline__ unsigned xb_ld(unsigned* p)              { return __hip_atomic_load(p, __ATOMIC_RELAXED, __HIP_MEMORY_SCOPE_AGENT); }
__device__ __forceinline__ unsigned xb_add(unsigned* p, unsigned v) { return __hip_atomic_fetch_add(p, v, __ATOMIC_RELAXED, __HIP_MEMORY_SCOPE_AGENT); }
__device__ __forceinline__ unsigned xb_xcc_id() { return (unsigned)__builtin_amdgcn_s_getreg((3 << 11) | 20) & 0xFu; }
#define XB_SPIN(cond, bar) do { unsigned _sp = 0; while (cond) { __builtin_amdgcn_s_sleep(1); \
    if ((++_sp & 255u) == 0u) { if (xb_ld(&(bar)[XB_TMO])) break; if (_sp > XB_SPIN_CAP) { atomicAdd(&(bar)[XB_TMO], 1u); break; } } } } while (0)

struct XcdBarrier {
    unsigned* bar; unsigned x;
    volatile LAS unsigned* st;
};

__device__ __forceinline__ XcdBarrier xcd_barrier_post(unsigned* bar, volatile LAS unsigned* st) {
    XcdBarrier b; b.bar = bar; b.x = xb_xcc_id(); b.st = st;
    if (threadIdx.x == 0) (void)xb_add(&bar[XB_XCNT(b.x)], 1u);
    return b;
}
__device__ __forceinline__ void xcd_barrier_complete(unsigned* bar, unsigned x, unsigned& nloc, unsigned& nx) {
    const unsigned G = gridDim.x * gridDim.y * gridDim.z;
    unsigned sum, cnt, mine, sp = 0u;
    for (;;) {
        sum = 0u; cnt = 0u; mine = 0u;
#pragma unroll
        for (unsigned j = 0; j < 16; ++j) { const unsigned c = xb_ld(&bar[XB_XCNT(j)]); sum += c; cnt += (c > 0u) ? 1u : 0u; mine = (j == x) ? c : mine; }
        if (sum == G) break;
        __builtin_amdgcn_s_sleep(1);
        if ((++sp & 255u) == 0u) { if (xb_ld(&bar[XB_TMO])) break; if (sp > XB_SPIN_CAP) { atomicAdd(&bar[XB_TMO], 1u); break; } }
    }
    nloc = mine > 0u ? mine : 1u; nx = cnt > 0u ? cnt : 1u;
}

__device__ __forceinline__ void xcd_barrier(const XcdBarrier& b) {
    asm volatile("s_waitcnt vmcnt(0)" ::: "memory");
    __syncthreads();
    if (threadIdx.x == 0) {
        unsigned* bar = b.bar;
        __builtin_amdgcn_s_waitcnt(0);
        unsigned nloc = b.st[0], nx = b.st[1];
        if (nloc == 0u) { xcd_barrier_complete(bar, b.x, nloc, nx); b.st[0] = nloc; b.st[1] = nx; }
        const unsigned old = xb_add(&bar[XB_XSUB(b.x)], 1u);
        const unsigned gen = old / nloc;
        if (old + 1u == (gen + 1u) * nloc) {
            __builtin_amdgcn_fence(__ATOMIC_RELEASE, "agent");
            asm volatile("s_waitcnt vmcnt(0)" ::: "memory");
            const unsigned og = xb_add(&bar[XB_TOP], 1u);
            const unsigned tg = og / nx;
            if (og + 1u == (tg + 1u) * nx) xb_add(&bar[XB_TOPGEN], 1u);
            else XB_SPIN(xb_ld(&bar[XB_TOPGEN]) == tg, bar);
            __builtin_amdgcn_fence(__ATOMIC_ACQUIRE, "agent");
            xb_add(&bar[XB_XGEN(b.x)], 1u);
            asm volatile("s_waitcnt vmcnt(0)" ::: "memory");
        } else {
            XB_SPIN(xb_ld(&bar[XB_XGEN(b.x)]) == gen, bar);
            __builtin_amdgcn_fence(__ATOMIC_ACQUIRE, "agent");
            asm volatile("s_waitcnt vmcnt(0)" ::: "memory");
        }
    }
    __syncthreads();
}

typedef float f32x16 __attribute__((ext_vector_type(16)));
typedef float f32x2v __attribute__((ext_vector_type(2)));
typedef __bf16 bf16x2v __attribute__((ext_vector_type(2)));
#define MFMA32(a, b, c) __builtin_amdgcn_mfma_f32_32x32x16_bf16((a), (b), (c), 0, 0, 0)
__device__ __forceinline__ int swz23(int m) { return (m & ~12) | ((m & 4) << 1) | ((m & 8) >> 1); }
__device__ __forceinline__ unsigned pkbf(float a, float b) { const f32x2v v = {a, b}; return __builtin_bit_cast(unsigned, __builtin_convertvector(v, bf16x2v)); }
__device__ __forceinline__ bf16x8 pack8(const f32x16& x, int c) { v4u w; w.x = pkbf(x[8 * c], x[8 * c + 1]); w.y = pkbf(x[8 * c + 2], x[8 * c + 3]); w.z = pkbf(x[8 * c + 4], x[8 * c + 5]); w.w = pkbf(x[8 * c + 6], x[8 * c + 7]); return __builtin_bit_cast(bf16x8, w); }
__device__ __forceinline__ float xhalf(float v) { return __shfl_xor(v, 32); }

template <int DQK, int DV> struct AttnTile {
    static constexpr int KS = DQK * 2 + 16, VS = 144, KBYTES = 64 * KS, VBYTES = DV * VS, BUF = KBYTES + VBYTES;
    static constexpr int NK = 64 * (DQK / 8) / 512, NV = DV * 8 / 512;
    v4u rk[NK], rv[NV];
    unsigned gk, gk2, gv;
    __device__ __forceinline__ void init(int k_pitch, int tid) { gk = (unsigned)((tid >> 4) * k_pitch + (tid & 15) * 8) * 2u; gk2 = (unsigned)((tid >> 3) * 64 + (tid & 7) * 8) * 2u; gv = (unsigned)((tid >> 3) * 4096 + (tid & 7) * 8) * 2u; }
    __amdgpu_buffer_rsrc_t r1, r2, rv_;
    __device__ __forceinline__ void bind(const bf16* K1, const bf16* K2, const bf16* VT) {
        r1 = __builtin_amdgcn_make_buffer_rsrc((void*)K1, 0, 0x7fffffff, 0x00020000); r2 = __builtin_amdgcn_make_buffer_rsrc((void*)(DQK == 192 ? K2 : K1), 0, 0x7fffffff, 0x00020000);
        rv_ = __builtin_amdgcn_make_buffer_rsrc((void*)VT, 0, 0x7fffffff, 0x00020000); }
    __device__ __forceinline__ void load(int k_pitch, int kt) {
        const int ko = kt * 64 * k_pitch * 2;
        rk[0] = __builtin_amdgcn_raw_buffer_load_b128(r1, gk, ko, 0); rk[1] = __builtin_amdgcn_raw_buffer_load_b128(r1, gk, ko + k_pitch * 64, 0);
        if (DQK == 192) rk[NK - 1] = __builtin_amdgcn_raw_buffer_load_b128(r2, gk2, kt * 64 * 64 * 2, 0);
#pragma unroll
        for (int i = 0; i < NV; ++i) rv[i] = __builtin_amdgcn_raw_buffer_load_b128(rv_, gv, kt * 128 + i * (64 * 4096 * 2), 0);
    }
    __device__ __forceinline__ void store(LAS unsigned char* buf, int tid) const {
#pragma unroll
        for (int i = 0; i < 2; ++i) { const int c = tid + 512 * i, r = c >> 4, cc = c & 15; *(LAS v4u*)(buf + r * KS + cc * 16) = rk[i]; }
        if (DQK == 192) { const int r = tid >> 3, cc = tid & 7; *(LAS v4u*)(buf + r * KS + 256 + cc * 16) = rk[NK - 1]; }
#pragma unroll
        for (int i = 0; i < NV; ++i) { const int c = tid + 512 * i, d = c >> 3, cc = c & 7; *(LAS v4u*)(buf + KBYTES + d * VS + cc * 16) = rv[i]; }
    }
};
template <int DQK> __device__ __forceinline__ void qk_tile(const LAS unsigned char* kb, int KS, const bf16x8 (&qf)[DQK / 16], int lane, f32x16 (&s)[2]) {
    const int h = lane >> 5, kr = swz23(lane & 31);
    f32x16 a0, a1;
#pragma unroll
    for (int i = 0; i < 16; ++i) { a0[i] = 0.f; a1[i] = 0.f; }
    const LAS unsigned char* p0 = kb + kr * KS + h * 16; const LAS unsigned char* p1 = p0 + 32 * KS;
    constexpr int G = DQK / 32;
    bf16x8 f[2][4];
#define QK_LOAD(dst, g) do { dst[0] = *(const LAS bf16x8*)(p0 + (g) * 64); dst[1] = *(const LAS bf16x8*)(p1 + (g) * 64); dst[2] = *(const LAS bf16x8*)(p0 + (g) * 64 + 32); dst[3] = *(const LAS bf16x8*)(p1 + (g) * 64 + 32); } while (0)
    QK_LOAD(f[0], 0);
#pragma unroll
    for (int g = 0; g < G; ++g) {
        if (g + 1 < G) QK_LOAD(f[(g + 1) & 1], g + 1);
        __builtin_amdgcn_sched_barrier(0);
        a0 = MFMA32(f[g & 1][0], qf[2 * g], a0); a1 = MFMA32(f[g & 1][1], qf[2 * g], a1); a0 = MFMA32(f[g & 1][2], qf[2 * g + 1], a0); a1 = MFMA32(f[g & 1][3], qf[2 * g + 1], a1);
        __builtin_amdgcn_sched_barrier(0);
    }
#undef QK_LOAD
    s[0] = a0; s[1] = a1;
}
template <int DV> __device__ __forceinline__ void pv_tile(const LAS unsigned char* vb, const f32x16 (&p)[2], int lane, f32x16 (&o)[DV / 32]) {
    const int h = lane >> 5, dr = swz23(lane & 31);
    bf16x8 pf[4];
#pragma unroll
    for (int g = 0; g < 4; ++g) pf[g] = pack8(p[g >> 1], g & 1);
    const LAS unsigned char* q = vb + dr * 144 + h * 16;
    constexpr int NB = DV / 32;
    bf16x8 f[2][NB];
#define PV_LOAD(dst, g) do { _Pragma("unroll") for (int db = 0; db < NB; ++db) dst[db] = *(const LAS bf16x8*)(q + db * (32 * 144) + (g) * 32); } while (0)
    PV_LOAD(f[0], 0);
#pragma unroll
    for (int g = 0; g < 4; ++g) {
        if (g + 1 < 4) PV_LOAD(f[(g + 1) & 1], g + 1);
        __builtin_amdgcn_sched_barrier(0);
#pragma unroll
        for (int db = 0; db < NB; ++db) o[db] = MFMA32(f[g & 1][db], pf[g], o[db]);
        __builtin_amdgcn_sched_barrier(0);
    }
#undef PV_LOAD
}
__device__ __forceinline__ void store_o8(bf16* p, const f32x16& x, int c, float sc) {
    v4u w; w.x = pkbf(x[8 * c] * sc, x[8 * c + 1] * sc); w.y = pkbf(x[8 * c + 2] * sc, x[8 * c + 3] * sc); w.z = pkbf(x[8 * c + 4] * sc, x[8 * c + 5] * sc); w.w = pkbf(x[8 * c + 6] * sc, x[8 * c + 7] * sc);
    *(GAS v4u*)p = w; }
__device__ __forceinline__ void sb_unit(LAS unsigned char* lds, unsigned char* ws, int bh, int qb, int tid, int wave, int lane) {
    typedef AttnTile<128, 128> T;
    const int b = bh >> 4, hd = bh & 15, q0 = qb * 256, h = lane >> 5, t = q0 + 32 * wave + (lane & 31);
    const bf16* Q = (const bf16*)(ws + WS_SBQ) + (size_t)b * SEQ * 2048 + hd * 128;
    const bf16* K1 = (const bf16*)(ws + WS_SBK) + (size_t)b * SEQ * 2048 + hd * 128;
    const bf16* VT = (const bf16*)(ws + WS_SBVT) + (size_t)bh * 128 * 4096;
    volatile LAS unsigned* flags = (volatile LAS unsigned*)(lds + 2 * T::BUF);
    bf16x8 qf[8];
#pragma unroll
    for (int kk = 0; kk < 8; ++kk) qf[kk] = __builtin_bit_cast(bf16x8, *(const GAS v4u*)(Q + (size_t)t * 2048 + 16 * kk + 8 * h));
    f32x16 o[4];
#pragma unroll
    for (int db = 0; db < 4; ++db)
#pragma unroll
        for (int i = 0; i < 16; ++i) o[db][i] = 0.f;
    float carry = 0.f; bool mydone = false;
    const int kt_hi = (q0 >> 6) + 3, ktw = (q0 >> 6) + (wave >> 1);
    const float scale = 0.08838834764831845f, L2E = 1.4426950408889634f, LN2 = 0.6931471805599453f;
    T tile; tile.init(2048, tid); tile.bind(K1, K1, VT); tile.load(2048, kt_hi); tile.store(lds, tid); __syncthreads();
    int it = 0;
#pragma unroll 1
    for (int kt = kt_hi; kt >= 0; --kt, ++it) {
        const LAS unsigned char* kb = lds + (it & 1) * T::BUF;
        if (kt > 0) tile.load(2048, kt - 1);
        if (kt <= ktw && !mydone) {
            f32x16 s[2]; qk_tile<128>(kb, T::KS, qf, lane, s);
            float tot[2][2];
#pragma unroll
            for (int blk = 0; blk < 2; ++blk)
#pragma unroll
                for (int c = 0; c < 2; ++c) { float run = 0.f;
#pragma unroll
                    for (int j = 7; j >= 0; --j) { const int i = 8 * c + j, key = kt * 64 + 32 * blk + 16 * c + 8 * h + j; const bool valid = key < t;
                        const float z = s[blk][i];
                        const float sp = fmaxf(z, 0.f) + LN2 * __builtin_amdgcn_logf(1.f + __builtin_amdgcn_exp2f(-fabsf(z) * L2E));
                        const float lk = valid ? -sp : 0.f;
                        s[blk][i] = valid ? (z + lk + run) : -INFINITY;
                        run += lk; }
                    tot[blk][c] = run; }
            float par[2][2], off[2][2];
#pragma unroll
            for (int blk = 0; blk < 2; ++blk)
#pragma unroll
                for (int c = 0; c < 2; ++c) par[blk][c] = xhalf(tot[blk][c]);
            float acc = carry;
            off[1][1] = acc + (h == 0 ? par[1][1] : 0.f); acc += tot[1][1] + par[1][1];
            off[1][0] = acc + (h == 0 ? par[1][0] : 0.f); acc += tot[1][0] + par[1][0];
            off[0][1] = acc + (h == 0 ? par[0][1] : 0.f); acc += tot[0][1] + par[0][1];
            off[0][0] = acc + (h == 0 ? par[0][0] : 0.f); acc += tot[0][0] + par[0][0];
            carry = acc;
#pragma unroll
            for (int blk = 0; blk < 2; ++blk)
#pragma unroll
                for (int i = 0; i < 16; ++i) s[blk][i] = __builtin_amdgcn_exp2f((s[blk][i] + off[blk][i >> 3]) * L2E);
            pv_tile<128>(kb + T::KBYTES, s, lane, o);
            mydone = __all(carry < -110.f);
        }
        if (kt > 0) tile.store(lds + ((it + 1) & 1) * T::BUF, tid);
        if (lane == 0) flags[(it & 1) * 8 + wave] = mydone ? 1u : 0u;
        __syncthreads();
        unsigned alld = 1u;
#pragma unroll
        for (int w = 0; w < 8; ++w) alld &= flags[(it & 1) * 8 + w];
        if (alld) break;
    }
    __syncthreads();
    bf16* orow = (bf16*)(ws + WS_O) + (size_t)(b * SEQ + t) * 4096 + 2048 + hd * 128 + 8 * h;
#pragma unroll
    for (int db = 0; db < 4; ++db) { store_o8(orow + 32 * db, o[db], 0, 1.f); store_o8(orow + 32 * db + 16, o[db], 1, 1.f); }
}
template <int DQK, int DV> struct DmaTile {
    static constexpr int KB = 64 * 256, KRB = (DQK == 192) ? 64 * 128 : 0, VB = DV * 128, BUF = KB + KRB + VB, NVW = DV / 64;
    __amdgpu_buffer_rsrc_t r1, r2, rv;
    unsigned gk0, gk1, gk2, gvE, gvO; int kpb;
    __device__ __forceinline__ void init(const bf16* K1, int k_pitch, const bf16* K2, const bf16* VT, int wave, int lane) {
        r1 = __builtin_amdgcn_make_buffer_rsrc((void*)K1, 0, 0x7fffffff, 0x00020000); r2 = __builtin_amdgcn_make_buffer_rsrc((void*)(DQK == 192 ? K2 : K1), 0, 0x7fffffff, 0x00020000);
        rv = __builtin_amdgcn_make_buffer_rsrc((void*)VT, 0, 0x7fffffff, 0x00020000); kpb = k_pitch * 2;
        { const int p = lane & 15, ra = 8 * wave + (lane >> 4), rb = ra + 4; gk0 = (unsigned)(ra * kpb + ((p ^ (ra & 15)) << 4)); gk1 = (unsigned)(rb * kpb + ((p ^ (rb & 15)) << 4)); }
        { const int p = lane & 7, r = 8 * wave + (lane >> 3); gk2 = (unsigned)(r * 128 + ((p ^ ((r >> 1) & 7)) << 4)); }
        { const int p = lane & 7, l3 = lane >> 3, d0 = 8 * wave * NVW + l3; gvE = (unsigned)(d0 * 8192 + ((p ^ (l3 >> 1)) << 4)); gvO = (unsigned)((d0 + 8) * 8192 + ((p ^ (4 + (l3 >> 1))) << 4)); }
    }
    __device__ __forceinline__ void issue(LAS unsigned char* buf, int kt, int wave) const {
        __builtin_amdgcn_raw_ptr_buffer_load_lds(r1, (LAS void*)(buf + wave * 2048), 16, gk0, kt * 64 * kpb, 0, 0);
        __builtin_amdgcn_raw_ptr_buffer_load_lds(r1, (LAS void*)(buf + wave * 2048 + 1024), 16, gk1, kt * 64 * kpb, 0, 0);
        if (DQK == 192) __builtin_amdgcn_raw_ptr_buffer_load_lds(r2, (LAS void*)(buf + KB + wave * 1024), 16, gk2, kt * 64 * 128, 0, 0);
#pragma unroll
        for (int i = 0; i < NVW; ++i) __builtin_amdgcn_raw_ptr_buffer_load_lds(rv, (LAS void*)(buf + KB + KRB + (wave * NVW + i) * 1024), 16, (i & 1) ? gvO : gvE, kt * 128 + (i >> 1) * (16 * 8192), 0, 0);
    }
};
template <int DQK> __device__ __forceinline__ void qk_tile2(const LAS unsigned char* kb, const bf16x8 (&qf)[DQK / 16], int lane_, f32x16 (&s)[2]) {
    int lane = lane_; asm volatile("" : "+v"(lane));
    const int h = lane >> 5, r = swz23(lane & 31), y = h ^ (r & 15), yr = h ^ ((r >> 1) & 7);
    const LAS unsigned char* p0 = kb + r * 256; const LAS unsigned char* pr = kb + 64 * 256 + r * 128;
    f32x16 a0, a1;
#pragma unroll
    for (int i = 0; i < 16; ++i) { a0[i] = 0.f; a1[i] = 0.f; }
    bf16x8 f[2][2];
#define QK2_LOAD(dst, kk) do { if ((kk) < 8) { const LAS unsigned char* q_ = p0 + ((y ^ (2 * (kk))) << 4); dst[0] = *(const LAS bf16x8*)q_; dst[1] = *(const LAS bf16x8*)(q_ + 32 * 256); } \
                               else { const LAS unsigned char* q_ = pr + ((yr ^ (2 * ((kk) - 8))) << 4); dst[0] = *(const LAS bf16x8*)q_; dst[1] = *(const LAS bf16x8*)(q_ + 32 * 128); } } while (0)
    QK2_LOAD(f[0], 0);
#pragma unroll
    for (int kk = 0; kk < DQK / 16; ++kk) {
        if (kk + 1 < DQK / 16) QK2_LOAD(f[(kk + 1) & 1], kk + 1);
        __builtin_amdgcn_sched_barrier(0);
        a0 = MFMA32(f[kk & 1][0], qf[kk], a0); a1 = MFMA32(f[kk & 1][1], qf[kk], a1);
        __builtin_amdgcn_sched_barrier(0);
    }
#undef QK2_LOAD
    s[0] = a0; s[1] = a1;
}
__device__ __forceinline__ float xmax_half(float v) {
    const unsigned u = __builtin_bit_cast(unsigned, v); const auto r = __builtin_amdgcn_permlane32_swap(u, u, false, false);
    return fmaxf(__builtin_bit_cast(float, r[0]), __builtin_bit_cast(float, r[1])); }
template <int DV> __device__ __forceinline__ void pv_tile2p(const LAS unsigned char* vb, const bf16x8 (&pf)[4], int lane_, f32x16 (&o)[DV / 32]) {
    int lane = lane_; asm volatile("" : "+v"(lane));
    const int h = lane >> 5, dr = swz23(lane & 31), yv = h ^ ((dr >> 1) & 7);
    const LAS unsigned char* q = vb + dr * 128;
    constexpr int NB = DV / 32, W = (DV == 256) ? 2 : 4, SPG = NB / W, NS = 4 * SPG;
    bf16x8 f[2][W];
#define PV2_LOAD(dst, st) do { const int g_ = (st) / SPG, b0_ = W * ((st) % SPG); const LAS unsigned char* q_ = q + ((yv ^ (2 * g_)) << 4) + b0_ * 4096; \
        _Pragma("unroll") for (int j = 0; j < W; ++j) dst[j] = *(const LAS bf16x8*)(q_ + j * 4096); } while (0)
    PV2_LOAD(f[0], 0);
#pragma unroll
    for (int st = 0; st < NS; ++st) {
        if (st + 1 < NS) PV2_LOAD(f[(st + 1) & 1], st + 1);
        __builtin_amdgcn_sched_barrier(0);
#pragma unroll
        for (int j = 0; j < W; ++j) o[W * (st % SPG) + j] = MFMA32(f[st & 1][j], pf[st / SPG], o[W * (st % SPG) + j]);
        __builtin_amdgcn_sched_barrier(0);
    }
#undef PV2_LOAD
}
template <int DV, bool ALIBI> __device__ __forceinline__ float softmax_step(f32x16 (&s)[2], bool past, float tb, float slope_l2, float& mrow, float& lrow, f32x16 (&o)[DV / 32], bf16x8 (&pf)[4]) {
    if (ALIBI) {
        if (past) {
#pragma unroll
            for (int blk = 0; blk < 2; ++blk)
#pragma unroll
                for (int i = 0; i < 16; ++i) s[blk][i] = fmaf(-slope_l2, tb - (float)(32 * blk + 16 * (i >> 3) + (i & 7)), s[blk][i]);
        } else {
#pragma unroll
            for (int blk = 0; blk < 2; ++blk)
#pragma unroll
                for (int i = 0; i < 16; ++i) s[blk][i] = fmaf(-slope_l2, fabsf(tb - (float)(32 * blk + 16 * (i >> 3) + (i & 7))), s[blk][i]); } }
    float mx = fmaxf(fmaxf(s[0][0], s[0][1]), s[1][0]);
#pragma unroll
    for (int i = 2; i < 16; i += 2) mx = fmaxf(fmaxf(mx, s[0][i]), s[0][i + 1]);
#pragma unroll
    for (int i = 1; i < 15; i += 2) mx = fmaxf(fmaxf(mx, s[1][i]), s[1][i + 1]);
    mx = fmaxf(mx, s[1][15]);
    mx = xmax_half(mx);
    const float mnew = fmaxf(mrow, mx), alpha = __builtin_amdgcn_exp2f(mrow - mnew); mrow = mnew;
    const f32x2v mn2 = {mnew, mnew}; f32x2v rs2 = {0.f, 0.f};
#pragma unroll
    for (int blk = 0; blk < 2; ++blk)
#pragma unroll
        for (int i = 0; i < 16; i += 2) { f32x2v x = {s[blk][i], s[blk][i + 1]}; x = x - mn2; x[0] = __builtin_amdgcn_exp2f(x[0]); x[1] = __builtin_amdgcn_exp2f(x[1]); rs2 = rs2 + x; s[blk][i] = x[0]; s[blk][i + 1] = x[1]; }
    lrow = lrow * alpha + (rs2[0] + rs2[1]);
#pragma unroll
    for (int db = 0; db < DV / 32; ++db) o[db] = o[db] * alpha;
#pragma unroll
    for (int g = 0; g < 4; ++g) pf[g] = pack8(s[g >> 1], g & 1);
    return alpha;
}
template <int DQK, int DV, bool ALIBI>
__device__ __forceinline__ void attn4_softmax_unit(LAS unsigned char* lds, const bf16* Q, int q_pitch, const bf16* K1, int k_pitch, const bf16* K2, const bf16* VT, float slope_l2, int q0,
                                                   int wave, int lane, f32x16 (&o)[DV / 32], float& l_out) {
    typedef DmaTile<DQK, DV> T;
    const int h = lane >> 5, t = q0 + 32 * wave + (lane & 31);
    bf16x8 qf[DQK / 16];
#pragma unroll
    for (int kk = 0; kk < DQK / 16; ++kk) qf[kk] = __builtin_bit_cast(bf16x8, *(const GAS v4u*)(Q + (size_t)t * q_pitch + 16 * kk + 8 * h));
#pragma unroll
    for (int db = 0; db < DV / 32; ++db)
#pragma unroll
        for (int i = 0; i < 16; ++i) o[db][i] = 0.f;
    float mrow = -INFINITY, lrow = 0.f;
    const int ntiles = (q0 >> 6) + 4, ktw = (q0 >> 6) + (wave >> 1);
    bf16x8 pf[4];
#pragma unroll
    for (int g = 0; g < 4; ++g) pf[g] = (bf16x8){0, 0, 0, 0, 0, 0, 0, 0};
    T tile; tile.init(K1, k_pitch, K2, VT, wave, lane); tile.issue(lds, 0, wave);
    asm volatile("s_waitcnt vmcnt(0) lgkmcnt(0)\n\ts_barrier" ::: "memory");
    int bi = 0;
#pragma unroll 1
    for (int kt = 0; kt < ntiles; ++kt) {
        const int bn = bi == 2 ? 0 : bi + 1, bp = bi == 0 ? 2 : bi - 1;
        const LAS unsigned char* kb = lds + bi * T::BUF;
        if (kt + 1 < ntiles) tile.issue(lds + bn * T::BUF, kt + 1, wave);
        const float tb = (float)(t - kt * 64 - 8 * h);
        const bool isB = wave >= 4;
        if (isB && kt >= 1 && kt - 1 <= ktw) pv_tile2p<DV>(lds + bp * T::BUF + T::KB + T::KRB, pf, lane, o);
        if (kt <= ktw) { f32x16 s[2]; qk_tile2<DQK>(kb, qf, lane, s); softmax_step<DV, ALIBI>(s, kt < ktw, tb, slope_l2, mrow, lrow, o, pf); }
        if (!isB && kt <= ktw) pv_tile2p<DV>(kb + T::KB + T::KRB, pf, lane, o);
        asm volatile("s_waitcnt vmcnt(0) lgkmcnt(0)\n\ts_barrier" ::: "memory");
        bi = bn;
    }
    if (wave >= 4 && ntiles - 1 <= ktw) pv_tile2p<DV>(lds + (bi == 0 ? 2 : bi - 1) * T::BUF + T::KB + T::KRB, pf, lane, o);
    asm volatile("s_waitcnt lgkmcnt(0)\n\ts_barrier" ::: "memory");
    l_out = lrow + xhalf(lrow);
}
constexpr int PC_FLG = 136192;
template <bool ALIBI> __device__ __forceinline__ float softmax_step_p(f32x16 (&s)[2], bool past, float tb, float slope_l2, float& mrow, float& lrow, bf16x8 (&pf)[4]) {
    if (ALIBI) {
        if (past) {
#pragma unroll
            for (int blk = 0; blk < 2; ++blk)
#pragma unroll
                for (int i = 0; i < 16; ++i) s[blk][i] = fmaf(-slope_l2, tb - (float)(32 * blk + 16 * (i >> 3) + (i & 7)), s[blk][i]);
        } else {
#pragma unroll
            for (int blk = 0; blk < 2; ++blk)
#pragma unroll
                for (int i = 0; i < 16; ++i) s[blk][i] = fmaf(-slope_l2, fabsf(tb - (float)(32 * blk + 16 * (i >> 3) + (i & 7))), s[blk][i]); } }
    float mx = fmaxf(fmaxf(s[0][0], s[0][1]), s[1][0]);
#pragma unroll
    for (int i = 2; i < 16; i += 2) mx = fmaxf(fmaxf(mx, s[0][i]), s[0][i + 1]);
#pragma unroll
    for (int i = 1; i < 15; i += 2) mx = fmaxf(fmaxf(mx, s[1][i]), s[1][i + 1]);
    mx = fmaxf(mx, s[1][15]);
    mx = xmax_half(mx);
    const float mnew = fmaxf(mrow, mx), alpha = __builtin_amdgcn_exp2f(mrow - mnew); mrow = mnew;
    const f32x2v mn2 = {mnew, mnew}; f32x2v rs2 = {0.f, 0.f};
#pragma unroll
    for (int blk = 0; blk < 2; ++blk)
#pragma unroll
        for (int i = 0; i < 16; i += 2) { f32x2v x = {s[blk][i], s[blk][i + 1]}; x = x - mn2; x[0] = __builtin_amdgcn_exp2f(x[0]); x[1] = __builtin_amdgcn_exp2f(x[1]); rs2 = rs2 + x; s[blk][i] = x[0]; s[blk][i + 1] = x[1]; }
    lrow = lrow * alpha + (rs2[0] + rs2[1]);
#pragma unroll
    for (int g = 0; g < 4; ++g) pf[g] = pack8(s[g >> 1], g & 1);
    return alpha;
}
__device__ __forceinline__ void pv_tile256_deep(const LAS unsigned char* vb, const bf16x8 (&pf)[4], int lane_, f32x16 (&o)[8]) {
    int lane = lane_; asm volatile("" : "+v"(lane));
    const int h = lane >> 5, dr = swz23(lane & 31), yv = h ^ ((dr >> 1) & 7);
    const LAS unsigned char* q = vb + dr * 128;
    bf16x8 f[3][4];
#define PVD_LOAD(dst, st) do { const int g_ = (st) >> 1, b0_ = 4 * ((st) & 1); const LAS unsigned char* q_ = q + ((yv ^ (2 * g_)) << 4) + b0_ * 4096; \
        _Pragma("unroll") for (int j = 0; j < 4; ++j) dst[j] = *(const LAS bf16x8*)(q_ + j * 4096); } while (0)
    PVD_LOAD(f[0], 0); PVD_LOAD(f[1], 1);
#pragma unroll
    for (int st = 0; st < 8; ++st) {
        if (st + 2 < 8) PVD_LOAD(f[(st + 2) % 3], st + 2);
        __builtin_amdgcn_sched_barrier(0);
#pragma unroll
        for (int j = 0; j < 4; ++j) o[4 * (st & 1) + j] = MFMA32(f[st % 3][j], pf[st >> 1], o[4 * (st & 1) + j]);
        __builtin_amdgcn_sched_barrier(0);
    }
#undef PVD_LOAD
}
__device__ __forceinline__ void qk_tile128_deep(const LAS unsigned char* kb, const bf16x8 (&qf)[8], int lane_, f32x16 (&s)[2]) {
    int lane = lane_; asm volatile("" : "+v"(lane));
    const int h = lane >> 5, r = swz23(lane & 31), y = h ^ (r & 15);
    const LAS unsigned char* p0 = kb + r * 256;
    f32x16 a0, a1;
#pragma unroll
    for (int i = 0; i < 16; ++i) { a0[i] = 0.f; a1[i] = 0.f; }
    bf16x8 f[4][2];
#define QKD_LOAD(dst, kk) do { const LAS unsigned char* q_ = p0 + ((y ^ (2 * (kk))) << 4); dst[0] = *(const LAS bf16x8*)q_; dst[1] = *(const LAS bf16x8*)(q_ + 32 * 256); } while (0)
    QKD_LOAD(f[0], 0); QKD_LOAD(f[1], 1); QKD_LOAD(f[2], 2);
#pragma unroll
    for (int kk = 0; kk < 8; ++kk) {
        if (kk + 3 < 8) QKD_LOAD(f[(kk + 3) & 3], kk + 3);
        __builtin_amdgcn_sched_barrier(0);
        a0 = MFMA32(f[kk & 3][0], qf[kk], a0); a1 = MFMA32(f[kk & 3][1], qf[kk], a1);
        __builtin_amdgcn_sched_barrier(0);
    }
#undef QKD_LOAD
    s[0] = a0; s[1] = a1;
}
constexpr int PE_K = 0, PE_V = 32768, PE_P = 98304, PE_PBLK = 4352, PE_L = 133120, PE_FLG = 135168;
__device__ __forceinline__ void diff_unit_pc4(LAS unsigned char* lds, unsigned char* ws, const float* subln, float lam, const unsigned* kmaxw, int bh, int qb128, int wave, int lane) {
    const int b = bh >> 4, hd = bh & 15, q0 = qb128 * 128, h = lane >> 5, rg = wave & 3; const bool isA = wave < 4;
    const int t = q0 + 32 * rg + (lane & 31);
    const int ntiles = (q0 >> 6) + 2, ktw = (q0 >> 6) + (rg >> 1), kt_hi = ntiles - 1;
    const float slope_l2 = __builtin_amdgcn_exp2f(-0.5f * (float)(hd + 1)) * 1.4426950408889634f;
    const bf16* VT = (const bf16*)(ws + WS_CVT) + (size_t)bh * 256 * 4096;
    const __amdgpu_buffer_rsrc_t rv = __builtin_amdgcn_make_buffer_rsrc((void*)VT, 0, 0x7fffffff, 0x00020000);
    volatile LAS unsigned* flg = (volatile LAS unsigned*)(lds + PE_FLG);
    unsigned gk0, gk1, gvE, gvO;
    { const int p = lane & 15, ra = 8 * wave + (lane >> 4), rb = ra + 4; gk0 = (unsigned)(ra * 8192 + ((p ^ (ra & 15)) << 4)); gk1 = (unsigned)(rb * 8192 + ((p ^ (rb & 15)) << 4)); }
    { const int p = lane & 7, l3 = lane >> 3, d0 = 32 * wave + l3; gvE = (unsigned)(d0 * 8192 + ((p ^ (l3 >> 1)) << 4)); gvO = (unsigned)((d0 + 8) * 8192 + ((p ^ (4 + (l3 >> 1))) << 4)); }
#define PE_ISSUE_K(kt_, ib_) do { LAS unsigned char* d_ = lds + PE_K + ((ib_) & 1) * 16384 + wave * 2048; \
    __builtin_amdgcn_raw_ptr_buffer_load_lds(rk, (LAS void*)d_, 16, gk0, (kt_) * 64 * 8192, 0, 0); __builtin_amdgcn_raw_ptr_buffer_load_lds(rk, (LAS void*)(d_ + 1024), 16, gk1, (kt_) * 64 * 8192, 0, 0); } while (0)
#define PE_ISSUE_V(kt_, ib_) do { LAS unsigned char* d_ = lds + PE_V + ((ib_) & 1) * 32768 + wave * 4096; \
    __builtin_amdgcn_raw_ptr_buffer_load_lds(rv, (LAS void*)d_, 16, gvE, (kt_) * 128, 0, 0); __builtin_amdgcn_raw_ptr_buffer_load_lds(rv, (LAS void*)(d_ + 1024), 16, gvO, (kt_) * 128, 0, 0); \
    __builtin_amdgcn_raw_ptr_buffer_load_lds(rv, (LAS void*)(d_ + 2048), 16, gvE, (kt_) * 128 + 16 * 8192, 0, 0); __builtin_amdgcn_raw_ptr_buffer_load_lds(rv, (LAS void*)(d_ + 3072), 16, gvO, (kt_) * 128 + 16 * 8192, 0, 0); } while (0)
#define PE_BAR() asm volatile("s_waitcnt vmcnt(0) lgkmcnt(0)\n\ts_barrier" ::: "memory")
#define PE_FIN(it_) ((flg[((it_) & 1) * 8 + 4] & flg[((it_) & 1) * 8 + 5] & flg[((it_) & 1) * 8 + 6] & flg[((it_) & 1) * 8 + 7]) != 0u)
#pragma unroll 1
    for (int mp = 0; mp < 2; ++mp) {
        const bf16* K1 = (const bf16*)(ws + WS_CK1) + (size_t)b * SEQ * 4096 + (2 * hd + mp) * 128;
        const __amdgpu_buffer_rsrc_t rk = __builtin_amdgcn_make_buffer_rsrc((void*)K1, 0, 0x7fffffff, 0x00020000);
        if (isA) {
            const bf16* Q = (const bf16*)(ws + WS_CQ1) + (size_t)b * SEQ * 4096 + (2 * hd + mp) * 128;
            const __amdgpu_buffer_rsrc_t rq = __builtin_amdgcn_make_buffer_rsrc((void*)Q, 0, 0x7fffffff, 0x00020000); const int qoff = t * 8192 + h * 16;
            bf16x8 qf[8];
#pragma unroll
            for (int kk = 0; kk < 8; ++kk) qf[kk] = __builtin_bit_cast(bf16x8, __builtin_amdgcn_raw_buffer_load_b128(rq, qoff, 32 * kk, 0));
            float bq;
            { float qn = 0.f;
#pragma unroll
              for (int kk = 0; kk < 8; ++kk) { const v4u w = __builtin_bit_cast(v4u, qf[kk]); qn += bflo(w.x) * bflo(w.x) + bfhi(w.x) * bfhi(w.x) + bflo(w.y) * bflo(w.y) + bfhi(w.y) * bfhi(w.y) + bflo(w.z) * bflo(w.z) + bfhi(w.z) * bfhi(w.z) + bflo(w.w) * bflo(w.w) + bfhi(w.w) * bfhi(w.w); }
              qn += xhalf(qn);
              const unsigned* km = kmaxw + ((b * 32 + 2 * hd + mp) * 4);
              const float k2 = (__builtin_bit_cast(float, km[0]) + __builtin_bit_cast(float, km[1])) + (__builtin_bit_cast(float, km[2]) + __builtin_bit_cast(float, km[3]));
              bq = sqrtf(qn * k2 * 1.03f) + 1.f; }
            float mrow = -INFINITY, lrow = 0.f; bool mydone = false, fin = false;
            __builtin_amdgcn_s_setprio(1);
            PE_ISSUE_K(kt_hi, 0);
            PE_BAR();
#pragma unroll 1
            for (int it = 0, kt = kt_hi; ; ++it, --kt) {
                if (!fin) { if (kt >= 1) PE_ISSUE_K(kt - 1, it + 1); if (kt >= 0) PE_ISSUE_V(kt, it); }
                bool pub = false;
                if (!fin && kt >= 0 && kt <= ktw && !mydone) {
                    f32x16 s[2]; bf16x8 pf[4]; qk_tile128_deep(lds + PE_K + (it & 1) * 16384, qf, lane, s);
                    const float alpha = softmax_step_p<true>(s, kt < ktw, (float)(t - kt * 64 - 8 * h), slope_l2, mrow, lrow, pf);
                    LAS unsigned char* pb = lds + PE_P + ((it & 1) * 4 + rg) * PE_PBLK;
#pragma unroll
                    for (int g = 0; g < 4; ++g) *(LAS bf16x8*)(pb + g * 1024 + lane * 16) = pf[g];
                    *(LAS float*)(pb + 4096 + lane * 4) = alpha;
                    pub = true;
                    mydone = __all(bq - slope_l2 * (float)(t - 64 * kt + 1) - mrow < -150.f);
                }
                if (lane == 0) { flg[(it & 1) * 8 + rg] = pub ? 1u : 0u; flg[(it & 1) * 8 + 4 + rg] = (mydone || kt <= 0) ? 1u : 0u; }
                PE_BAR();
                if (fin) break;
                fin = PE_FIN(it);
            }
            __builtin_amdgcn_s_setprio(0);
            { const float lt = lrow + xhalf(lrow); *(LAS float*)(lds + PE_L + (mp * 4 + rg) * 256 + lane * 4) = lt; }
            PE_BAR();
        } else {
            f32x16 o[8];
#pragma unroll
            for (int db = 0; db < 8; ++db)
#pragma unroll
                for (int i = 0; i < 16; ++i) o[db][i] = 0.f;
            bool fin = false;
            PE_ISSUE_K(kt_hi, 0);
            PE_BAR();
#pragma unroll 1
            for (int it = 0, kt = kt_hi; ; ++it, --kt) {
                if (!fin) { if (kt >= 1) PE_ISSUE_K(kt - 1, it + 1); if (kt >= 0) PE_ISSUE_V(kt, it); }
                if (it >= 1 && flg[((it - 1) & 1) * 8 + rg] != 0u) {
                    const LAS unsigned char* pb = lds + PE_P + (((it - 1) & 1) * 4 + rg) * PE_PBLK; bf16x8 pf[4];
#pragma unroll
                    for (int g = 0; g < 4; ++g) pf[g] = *(const LAS bf16x8*)(pb + g * 1024 + lane * 16);
                    const float alpha = *(const LAS float*)(pb + 4096 + lane * 4);
#pragma unroll
                    for (int db = 0; db < 8; ++db) o[db] = o[db] * alpha;
                    pv_tile256_deep(lds + PE_V + ((it - 1) & 1) * 32768, pf, lane, o);
                }
                PE_BAR();
                if (fin) break;
                fin = PE_FIN(it);
            }
            { const __amdgpu_buffer_rsrc_t rds = __builtin_amdgcn_make_buffer_rsrc((void*)(ws + (mp ? WS_DS1 : WS_DS)), 0, 0x7fffffff, 0x00020000);
              const int dso = (((b * SEQ + t) * 16 + hd) * 256 + 8 * h) * 4;
#pragma unroll
              for (int db = 0; db < 8; ++db)
#pragma unroll
                  for (int c = 0; c < 2; ++c) { f32x4 a, bq;
#pragma unroll
                      for (int e = 0; e < 4; ++e) { a[e] = o[db][8 * c + e]; bq[e] = o[db][8 * c + 4 + e]; }
                      __builtin_amdgcn_raw_buffer_store_b128(__builtin_bit_cast(v4u, a), rds, dso, (32 * db + 16 * c) * 4, 0); __builtin_amdgcn_raw_buffer_store_b128(__builtin_bit_cast(v4u, bq), rds, dso, (32 * db + 16 * c + 4) * 4, 0); } }
            PE_BAR();
        }
    }
    {   const float* S0 = (const float*)(ws + WS_DS); const float* S1 = (const float*)(ws + WS_DS1); bf16* O = (bf16*)(ws + WS_O);
        const f32x4 g4 = *(const GAS f32x4*)(subln + 4 * lane);
#pragma unroll 2
        for (int rr = 0; rr < 16; ++rr) { const int r = 16 * wave + rr; const size_t row = (size_t)b * SEQ + q0 + r;
            const float l0 = *(const LAS float*)(lds + PE_L + (0 * 4 + (r >> 5)) * 256 + (r & 31) * 4), l1 = *(const LAS float*)(lds + PE_L + (1 * 4 + (r >> 5)) * 256 + (r & 31) * 4);
            const f32x4 a = *(const GAS f32x4*)(S0 + (row * 16 + hd) * 256 + 4 * lane), c = *(const GAS f32x4*)(S1 + (row * 16 + hd) * 256 + 4 * lane);
            const float i0 = 1.f / l0, i1 = lam / l1;
            const f32x4 x = a * i0 - c * i1;
            const float ss = wave_sum((x[0] * x[0] + x[1] * x[1]) + (x[2] * x[2] + x[3] * x[3]));
            const float rn = rsqrtf(ss * (1.f / 256.f) + EPS) * (1.f - LAMBDA_INIT);
            const f32x4 y = x * rn * g4;
            *(GAS unsigned long long*)(O + row * 4096 + hd * 256 + 4 * lane) = (unsigned long long)pkbf(y[0], y[1]) | ((unsigned long long)pkbf(y[2], y[3]) << 32); }
    }
    PE_BAR();
#undef PE_ISSUE_K
#undef PE_ISSUE_V
#undef PE_BAR
#undef PE_FIN
}
__device__ __forceinline__ void mla_unit2(LAS unsigned char* lds, unsigned char* ws, int bh, int qb, int wave, int lane) {
    const int b = bh >> 4, hd = bh & 15, q0 = qb * 256;
    const bf16* Q = (const bf16*)(ws + WS_QA) + (size_t)b * SEQ * 3072 + hd * 192;
    const bf16* K1 = (const bf16*)(ws + WS_KN) + (size_t)b * SEQ * 2048 + hd * 128;
    const bf16* K2 = (const bf16*)(ws + WS_KR) + (size_t)b * SEQ * 64;
    const bf16* VT = (const bf16*)(ws + WS_VAT) + (size_t)bh * 128 * 4096;
    f32x16 o[4]; float l;
    attn4_softmax_unit<192, 128, false>(lds, Q, 3072, K1, 2048, K2, VT, 0.f, q0, wave, lane, o, l);
    const float il = 1.f / l; const int t = q0 + 32 * wave + (lane & 31), h = lane >> 5;
    bf16* orow = (bf16*)(ws + WS_O) + (size_t)(b * SEQ + t) * 4096 + hd * 128 + 8 * h;
#pragma unroll
    for (int db = 0; db < 4; ++db) { store_o8(orow + 32 * db, o[db], 0, il); store_o8(orow + 32 * db + 16, o[db], 1, il); }
}

template <int MAP> __device__ __forceinline__ int dst_row(int n) {
    if (MAP == 1) {
        if (n < 1536) return n;
        if (n < 1600) { const int i = n - 1536; return 1536 + (i < 32 ? 2 * i : 2 * (i - 32) + 1); }
        return n + 192; }
    if (MAP == 2) {
        const int h = n / 192, j = n - h * 192; if (j < 128) return n; const int r = j - 128; return h * 192 + 128 + (r < 32 ? 2 * r : 2 * (r - 32) + 1); }
    if (MAP == 3) {
        const int h = n >> 8, j = n & 255; return j < 128 ? h * 128 + j : 2048 + h * 128 + (j - 128); }
    return n;
}
struct TItem { f32x4 v[8]; };
template <int MAP> __device__ __forceinline__ void transpose_load(TItem& it, const float* W, int K, int N, const float* gain, int item, int lane) {
    const int nblk = N / 32, kb = item / nblk, nb = item - kb * nblk, k0 = 64 * kb, n0 = 32 * nb; const int nq = lane & 7, kq = lane >> 3;
#pragma unroll
    for (int i = 0; i < 8; ++i) { const int kk = 8 * i + kq; const f32x4 v = *(const GAS f32x4*)(W + (size_t)(k0 + kk) * N + n0 + 4 * nq); const float g = gain ? gain[k0 + kk] : 1.f; it.v[i] = v * g; }
}
template <int MAP> __device__ __forceinline__ void transpose_finish(const TItem& it, int K, int N, bf16* WT, LAS float* scr, int item, int lane) {
    const int nblk = N / 32, kb = item / nblk, nb = item - kb * nblk, k0 = 64 * kb, n0 = 32 * nb; const int nq = lane & 7, kq = lane >> 3;
#pragma unroll
    for (int i = 0; i < 8; ++i) { const int kk = 8 * i + kq; LAS float* d = scr + kk * 33 + 4 * nq; d[0] = it.v[i][0]; d[1] = it.v[i][1]; d[2] = it.v[i][2]; d[3] = it.v[i][3]; }
    LDS_WAIT(); asm volatile("" ::: "memory");
    const int c = lane & 7;
#pragma unroll
    for (int p = 0; p < 4; ++p) { const int n = (lane >> 3) + 8 * p; const LAS float* s = scr + (8 * c) * 33 + n;
        v4u o; o.x = pkbf(s[0 * 33], s[1 * 33]); o.y = pkbf(s[2 * 33], s[3 * 33]); o.z = pkbf(s[4 * 33], s[5 * 33]); o.w = pkbf(s[6 * 33], s[7 * 33]);
        *(GAS v4u*)(WT + (size_t)dst_row<MAP>(n0 + n) * K + k0 + 8 * c) = o; }
    LDS_WAIT(); asm volatile("" ::: "memory");
}
template <int MAP> __device__ __forceinline__ void transpose_matrix(const float* W, int K, int N, const float* gain, bf16* WT, LAS float* scr, int first, int n_items, int NGW, int lane) {
    if (first >= n_items) return;
    TItem cur, nxt; transpose_load<MAP>(cur, W, K, N, gain, first, lane);
    for (int it = first; it < n_items; it += NGW) {
        const bool more = it + NGW < n_items;
        if (more) transpose_load<MAP>(nxt, W, K, N, gain, it + NGW, lane);
        transpose_finish<MAP>(cur, K, N, WT, scr, it, lane);
        if (more) cur = nxt;
    }
}
struct P {
    const float *x, *norm_mix, *norm_ffn, *norm_final, *ab_w_in, *ab_q_norm, *ab_w_uq, *ab_kv_norm, *ab_w_ukv, *ab_w_out, *c_w_in, *lq1, *lk1, *lq2, *lk2, *subln, *c_w_out, *w_up, *conv_w, *conv_b, *w_down;
    float* out; unsigned char* ws;
};

typedef const __attribute__((address_space(4))) P* KP;
__device__ __forceinline__ KP kargs() { KP k = (KP)__builtin_amdgcn_kernarg_segment_ptr(); asm volatile("" : "+s"(k)); return k; }
__device__ __forceinline__ void p0_prologue(KP pp, LAS unsigned char* lds, int gw, int NGW, int wave, int lane) {
    unsigned char* ws = pp->ws;
    LAS float* scr = (LAS float*)(lds + wave * 8448);
    constexpr int I_ABIN = 64 * 242, I_UQ = 16 * 96, I_UKV = 8 * 128, I_SQ = 64 * 128, I_CIN = 64 * 384, I_UP = 64 * 688, I_DN = 172 * 128;
    constexpr int NITEMS = I_ABIN + I_UQ + I_UKV + 2 * I_SQ + I_CIN + 2 * I_UP + 2 * I_DN;
    (void)NITEMS;
    { int off = gw;
#define TM(MAP_, W_, K_, N_, G_, WT_, NI_) do { transpose_matrix<MAP_>(W_, K_, N_, G_, (bf16*)(ws + WT_), scr, off, NI_, NGW, lane); off = (off + NGW - (NI_) % NGW) % NGW; } while (0)
      TM(0, pp->w_up, 4096, FF2, pp->norm_ffn, WS_WUP0, I_UP);
      TM(0, pp->w_up + (size_t)4096 * FF2, 4096, FF2, pp->norm_ffn + 4096, WS_WUP1, I_UP);
      TM(0, pp->w_down, FF, 4096, nullptr, WS_WDN0, I_DN);
      TM(0, pp->w_down + (size_t)FF * 4096, FF, 4096, nullptr, WS_WDN1, I_DN);
      TM(0, pp->c_w_in, 4096, 12288, pp->norm_mix + 4096, WS_WCIN, I_CIN);
      TM(1, pp->ab_w_in, 4096, 7744, pp->norm_mix, WS_WABIN, I_ABIN);
      TM(0, pp->ab_w_out, 4096, 4096, nullptr, WS_WABOUT, I_SQ);
      TM(0, pp->c_w_out, 4096, 4096, nullptr, WS_WCOUT, I_SQ);
      TM(2, pp->ab_w_uq, 1024, 3072, pp->ab_q_norm, WS_WUQ, I_UQ);
      TM(3, pp->ab_w_ukv, 512, 4096, pp->ab_kv_norm, WS_WUKV, I_UKV);
#undef TM
    }
    { GAS v4u* z = (GAS v4u*)((bf16*)(ws + WS_WABIN) + (size_t)1600 * 4096);
      for (int i = gw * 64 + lane; i < 192 * 4096 / 8; i += NGW * 64) z[i] = (v4u){0u, 0u, 0u, 0u}; }
    { float* rc = (float*)(ws + WS_ROPE); float* rs = rc + 4096 * 32;
      for (int i = gw * 64 + lane; i < 4096 * 32; i += NGW * 64) { const int pos = i >> 5, k = i & 31; const float inv = exp2f(-(float)k * (13.287712379549449f / 32.f)); float s, c; sincosf((float)pos * inv, &s, &c); rc[i] = c; rs[i] = s; } }
    { bf16* HB = (bf16*)(ws + WS_HB); unsigned long long* ss0 = (unsigned long long*)(ws + WS_SS);
      for (int m = gw; m < M; m += NGW) { const GAS f32x4* xr = (const GAS f32x4*)(pp->x + (size_t)m * DM) + lane; GAS unsigned long long* o8 = (GAS unsigned long long*)(HB + (size_t)m * DM) + lane; float s = 0.f;
#pragma unroll
          for (int j = 0; j < 16; ++j) { const f32x4 v = xr[64 * j]; s += (v[0] * v[0] + v[1] * v[1]) + (v[2] * v[2] + v[3] * v[3]); o8[64 * j] = (unsigned long long)pkbf(v[0], v[1]) | ((unsigned long long)pkbf(v[2], v[3]) << 32); }
          s = wave_sum(s); if (lane == 0) ss0[m] = (unsigned long long)(s * 4294967296.f); } }
}

__device__ __forceinline__ void conv_act_phase(const unsigned char* ws_c, unsigned char* ws, const float* cw, const float* cb, int gtid, int nthr) {
    const bf16* UP = (const bf16*)(ws_c + WS_UP); bf16* ACT = (bf16*)(ws + WS_ACT);
    constexpr int NCG = FF / 8, NITEM = (M / 32) * NCG;
    for (int it0 = gtid; it0 < NITEM; it0 += nthr) { const int it = NITEM - 1 - it0, cg = it % NCG, rsg = it / NCG, c0 = cg * 8, r0 = rsg * 32;
        float wg[3][8], wu[3][8], bg[8], bu[8];
#pragma unroll
        for (int j = 0; j < 3; ++j)
#pragma unroll
            for (int e = 0; e < 8; ++e) { wg[j][e] = cw[j * FF2 + c0 + e]; wu[j][e] = cw[j * FF2 + FF + c0 + e]; }
#pragma unroll
        for (int e = 0; e < 8; ++e) { bg[e] = cb[c0 + e]; bu[e] = cb[FF + c0 + e]; }
        float g1[8], g2[8], u1[8], u2[8];
        const bool first = (r0 & 4095) == 0;
        { v4u a = (v4u){0u, 0u, 0u, 0u}, b2 = a, c = a, d = a;
          if (!first) { a = *(const GAS v4u*)(UP + (size_t)(r0 - 1) * FF2 + c0); b2 = *(const GAS v4u*)(UP + (size_t)(r0 - 2) * FF2 + c0); c = *(const GAS v4u*)(UP + (size_t)(r0 - 1) * FF2 + FF + c0); d = *(const GAS v4u*)(UP + (size_t)(r0 - 2) * FF2 + FF + c0); }
          g1[0] = bflo(a.x); g1[1] = bfhi(a.x); g1[2] = bflo(a.y); g1[3] = bfhi(a.y); g1[4] = bflo(a.z); g1[5] = bfhi(a.z); g1[6] = bflo(a.w); g1[7] = bfhi(a.w);
          g2[0] = bflo(b2.x); g2[1] = bfhi(b2.x); g2[2] = bflo(b2.y); g2[3] = bfhi(b2.y); g2[4] = bflo(b2.z); g2[5] = bfhi(b2.z); g2[6] = bflo(b2.w); g2[7] = bfhi(b2.w);
          u1[0] = bflo(c.x); u1[1] = bfhi(c.x); u1[2] = bflo(c.y); u1[3] = bfhi(c.y); u1[4] = bflo(c.z); u1[5] = bfhi(c.z); u1[6] = bflo(c.w); u1[7] = bfhi(c.w);
          u2[0] = bflo(d.x); u2[1] = bfhi(d.x); u2[2] = bflo(d.y); u2[3] = bfhi(d.y); u2[4] = bflo(d.z); u2[5] = bfhi(d.z); u2[6] = bflo(d.w); u2[7] = bfhi(d.w); }
#pragma unroll 4
        for (int r = r0; r < r0 + 32; ++r) {
            const v4u a = *(const GAS v4u*)(UP + (size_t)r * FF2 + c0), c = *(const GAS v4u*)(UP + (size_t)r * FF2 + FF + c0);
            float g0[8], u0[8], o[8];
            g0[0] = bflo(a.x); g0[1] = bfhi(a.x); g0[2] = bflo(a.y); g0[3] = bfhi(a.y); g0[4] = bflo(a.z); g0[5] = bfhi(a.z); g0[6] = bflo(a.w); g0[7] = bfhi(a.w);
            u0[0] = bflo(c.x); u0[1] = bfhi(c.x); u0[2] = bflo(c.y); u0[3] = bfhi(c.y); u0[4] = bflo(c.z); u0[5] = bfhi(c.z); u0[6] = bflo(c.w); u0[7] = bfhi(c.w);
#pragma unroll
            for (int e = 0; e < 8; ++e) { const float gv = wg[0][e] * g2[e] + wg[1][e] * g1[e] + wg[2][e] * g0[e] + bg[e], uv = wu[0][e] * u2[e] + wu[1][e] * u1[e] + wu[2][e] * u0[e] + bu[e];
                o[e] = gv / (1.f + __expf(-gv)) * uv; g2[e] = g1[e]; g1[e] = g0[e]; u2[e] = u1[e]; u1[e] = u0[e]; }
            v4u w; w.x = pkbf(o[0], o[1]); w.y = pkbf(o[2], o[3]); w.z = pkbf(o[4], o[5]); w.w = pkbf(o[6], o[7]);
            *(GAS v4u*)(ACT + (size_t)r * FF + c0) = w; }
    }
}
__device__ __forceinline__ void final_norm_phase(float* out, const float* g, int gw, int NGW, int lane) {
    for (int m = gw; m < M; m += NGW) { GAS f32x4* xr = (GAS f32x4*)(out + (size_t)m * DM) + lane; f32x4 v[16]; float s = 0.f;
#pragma unroll
        for (int j = 0; j < 16; ++j) { v[j] = xr[64 * j]; s += (v[j][0] * v[j][0] + v[j][1] * v[j][1]) + (v[j][2] * v[j][2] + v[j][3] * v[j][3]); }
        const float rn = rsqrtf(wave_sum(s) * (1.f / DM) + EPS);
#pragma unroll
        for (int j = 0; j < 16; ++j) { const f32x4 gg = *((const GAS f32x4*)g + lane + 64 * j); xr[64 * j] = v[j] * rn * gg; } }
}

struct Args { P p; int ph_lo, ph_hi; };
static_assert(sizeof(Args) == 23 * 8 + 8, "Args has no padding");
__global__ void __launch_bounds__(NWAVES * 64, 2) fwd_kernel(Args args) {
    extern __shared__ __attribute__((aligned(16))) unsigned char lds_raw[];
    LAS unsigned char* lds = (LAS unsigned char*)lds_raw;
    volatile LAS unsigned* MISC = (volatile LAS unsigned*)(lds + MISC_OFF);
    const int tid = threadIdx.x, lane = tid & 63, wave = __builtin_amdgcn_readfirstlane(tid >> 6);
    const int G = gridDim.x, gw = blockIdx.x * NWAVES + wave, NGW = G * NWAVES;
    unsigned char* ws = kargs()->ws;
    gu32* ctl = (gu32*)(ws + WS_CTL);
    for (int u = tid; u < (LDS_BYTES - LDSCTL_OFF) / 4; u += NWAVES * 64) ((LAS unsigned*)(lds + LDSCTL_OFF))[u] = 0u;
    __syncthreads();
#if MK_ONE_LAUNCH
    XcdBarrier bar = xcd_barrier_post((unsigned*)(ctl + CW_BAR), MISC + 8);
#define GRID_BAR() xcd_barrier(bar)
#else
    (void)MISC; (void)ctl;
#define GRID_BAR() do { } while (0)
#endif
    const int lo = args.ph_lo, hi = args.ph_hi;
#ifndef PHASE_MASK
#define PHASE_MASK 0x7fff
#endif
#define IN(k) (((PHASE_MASK >> (k)) & 1) && lo <= (k) && (k) < hi)
#ifndef REPEAT_PHASE
#define REPEAT_PHASE -1
#endif
#define REP(k) for (int rep_ = 0; rep_ < ((REPEAT_PHASE == (k)) ? 2 : 1); ++rep_)
#define SEAM(k) do { if (IN(k) && IN((k) + 1)) GRID_BAR(); } while (0)
    pg8::u64_t* SS = (pg8::u64_t*)(ws + WS_SS);
    pg8::u64_t *ss0 = SS, *ss1 = SS + 8192, *ss2 = SS + 2 * 8192, *ss3 = SS + 3 * 8192, *ssq = SS + 5 * 8192, *sskv = SS + 6 * 8192;
    const float* rc = (const float*)(ws + WS_ROPE); const float* rs = rc + 4096 * 32;
    bf16* HB = (bf16*)(ws + WS_HB); float* H = (float*)(ws + WS_H); bf16* OB = (bf16*)(ws + WS_O);

    if (IN(0)) REP(0) { p0_prologue(kargs(), lds, gw, NGW, wave, lane); __syncthreads(); }
    SEAM(0);
    if (IN(1)) REP(1) { pg8::Gemm g{HB, (const bf16*)(ws + WS_WABIN), M, NAB, 4096}; pg8::StaticOrder S; S.init(M, NAB, G, (int)blockIdx.x);
        pg8::EpiABIn E{ss0, (bf16*)(ws + WS_CQ), (bf16*)(ws + WS_CKV), (bf16*)(ws + WS_KR), (bf16*)(ws + WS_SBQ), (bf16*)(ws + WS_SBK), (bf16*)(ws + WS_SBVT), ssq, sskv, rc, rs};
        pg8::gemm_phase<pg8::EpiABIn, pg8::StaticOrder, true, true>(lds + RING_OFF, g, S, E); }
    SEAM(1);
    if (IN(2)) REP(2) {
        { pg8::Gemm g{(const bf16*)(ws + WS_CQ), (const bf16*)(ws + WS_WUQ), M, 3072, 1024}; pg8::StaticOrder S; S.init(M, 3072, G, (int)blockIdx.x);
          pg8::EpiUQ E{ssq, (bf16*)(ws + WS_QA), rc, rs};
          pg8::gemm_phase<pg8::EpiUQ, pg8::StaticOrder, true, true>(lds + RING_OFF, g, S, E); }
        { pg8::Gemm g{(const bf16*)(ws + WS_CKV), (const bf16*)(ws + WS_WUKV), M, 4096, 512}; pg8::StaticOrder S; S.init(M, 4096, G, (int)blockIdx.x);
          pg8::EpiUKV E{sskv, (bf16*)(ws + WS_KN), (bf16*)(ws + WS_VAT)};
          pg8::gemm_phase<pg8::EpiUKV, pg8::StaticOrder, true, true>(lds + RING_OFF, g, S, E); }
    }
    SEAM(2);
    if (IN(3)) REP(3) {
        for (int j = blockIdx.x; j < 256; j += G) { const int bh = j & 31, pr = j >> 5;
#pragma unroll 1
            for (int u = 0; u < 2; ++u) mla_unit2(lds, ws, bh, u ? pr : 15 - pr, wave, lane); }
        for (int j = blockIdx.x; j < 256; j += G) { const int bh = j & 31, pr = j >> 5;
#pragma unroll 1
            for (int u = 0; u < 2; ++u) sb_unit(lds, ws, bh, u ? pr : 15 - pr, tid, wave, lane); }
        __syncthreads(); }
    SEAM(3);
    if (IN(4)) { pg8::Gemm g{OB, (const bf16*)(ws + WS_WABOUT), M, 4096, 4096}; pg8::StaticOrder S; S.init(M, 4096, G, (int)blockIdx.x);
        pg8::EpiResid E{kargs()->x, H, HB, ss1};
        pg8::gemm_phase<pg8::EpiResid, pg8::StaticOrder, true, true>(lds + RING_OFF, g, S, E); }
    SEAM(4);
    if (IN(5)) REP(5) { pg8::Gemm g{HB, (const bf16*)(ws + WS_WUP0), M, FF2, 4096}; pg8::StaticOrder S; S.init(M, FF2, G, (int)blockIdx.x);
        pg8::EpiUp E{ss1, (bf16*)(ws + WS_UP)};
        pg8::gemm_phase<pg8::EpiUp, pg8::StaticOrder, true, true>(lds + RING_OFF, g, S, E); }
    SEAM(5);
    if (IN(6)) REP(6) conv_act_phase(ws, ws, kargs()->conv_w, kargs()->conv_b, blockIdx.x * (NWAVES * 64) + tid, G * NWAVES * 64);
    SEAM(6);
    if (IN(7)) { pg8::Gemm g{(const bf16*)(ws + WS_ACT), (const bf16*)(ws + WS_WDN0), M, 4096, FF}; pg8::StaticOrder S; S.init(M, 4096, G, (int)blockIdx.x);
        pg8::EpiResid E{H, H, HB, ss2};
        pg8::gemm_phase<pg8::EpiResid, pg8::StaticOrder, true, true>(lds + RING_OFF, g, S, E); }
    SEAM(7);
    if (IN(8)) REP(8) { pg8::Gemm g{HB, (const bf16*)(ws + WS_WCIN), M, 12288, 4096}; pg8::StaticOrder S; S.init(M, 12288, G, (int)blockIdx.x);
        pg8::EpiCIn E{ss2, (bf16*)(ws + WS_CQ1), (bf16*)(ws + WS_CK1), (bf16*)(ws + WS_CVT), (unsigned*)(ws + WS_CTL) + CW_KMAX};
        pg8::gemm_phase<pg8::EpiCIn, pg8::StaticOrder, true, true>(lds + RING_OFF, g, S, E); }
    SEAM(8);
    if (IN(9)) REP(9) {
        float d1 = 0.f, d2 = 0.f;
        { KP ka = kargs(); const float *q1 = ka->lq1, *k1 = ka->lk1, *q2 = ka->lq2, *k2 = ka->lk2; for (int j = lane; j < 128; j += 64) { d1 += q1[j] * k1[j]; d2 += q2[j] * k2[j]; } }
        const float* subln = kargs()->subln;
        const float lam = __expf(wave_sum(d1)) - __expf(wave_sum(d2)) + LAMBDA_INIT;
        const unsigned* kmaxw = (const unsigned*)(ws + WS_CTL) + CW_KMAX; volatile LAS unsigned* qslot = (volatile LAS unsigned*)(lds + PC_FLG + 64);
        for (;;) {
            if (tid == 0) qslot[0] = __hip_atomic_fetch_add((unsigned*)(ws + WS_CTL) + CW_QUEUE + 64 * rep_, 1u, __ATOMIC_RELAXED, __HIP_MEMORY_SCOPE_AGENT);
            __syncthreads();
            const unsigned uu = qslot[0];
            __syncthreads();
            if (uu >= 1024u) break;
            const int qb128 = 31 - (int)(uu >> 5), hd = 15 - (int)((uu & 31u) >> 1), bb = (int)(uu & 1u);
            diff_unit_pc4(lds, ws, subln, lam, kmaxw, bb * 16 + hd, qb128, wave, lane);
        }
        __syncthreads(); }
    SEAM(9);
    if (IN(10)) { pg8::Gemm g{OB, (const bf16*)(ws + WS_WCOUT), M, 4096, 4096}; pg8::StaticOrder S; S.init(M, 4096, G, (int)blockIdx.x);
        pg8::EpiResid E{H, H, HB, ss3};
        pg8::gemm_phase<pg8::EpiResid, pg8::StaticOrder, true, true>(lds + RING_OFF, g, S, E); }
    SEAM(10);
    if (IN(11)) REP(11) { pg8::Gemm g{HB, (const bf16*)(ws + WS_WUP1), M, FF2, 4096}; pg8::StaticOrder S; S.init(M, FF2, G, (int)blockIdx.x);
        pg8::EpiUp E{ss3, (bf16*)(ws + WS_UP)};
        pg8::gemm_phase<pg8::EpiUp, pg8::StaticOrder, true, true>(lds + RING_OFF, g, S, E); }
    SEAM(11);
    if (IN(12)) REP(12) conv_act_phase(ws, ws, kargs()->conv_w + 3 * FF2, kargs()->conv_b + FF2, blockIdx.x * (NWAVES * 64) + tid, G * NWAVES * 64);
    SEAM(12);
    if (IN(13)) { pg8::Gemm g{(const bf16*)(ws + WS_ACT), (const bf16*)(ws + WS_WDN1), M, 4096, FF}; pg8::StaticOrder S; S.init(M, 4096, G, (int)blockIdx.x);
        pg8::EpiResid E{H, kargs()->out, nullptr, nullptr};
        pg8::gemm_phase<pg8::EpiResid, pg8::StaticOrder, true, true>(lds + RING_OFF, g, S, E); }
    SEAM(13);
    if (IN(14)) final_norm_phase(kargs()->out, kargs()->norm_final, gw, NGW, lane);
#undef IN
#undef SEAM
}

extern "C" void kernel_launch(void* const* d_in, const int* in_sizes, int n_in, void* d_out, int out_size, void* d_ws, size_t ws_size, hipStream_t stream) {
    static int grid = 0;
    if (grid == 0) {
        if (n_in != 21 || in_sizes[0] != M * DM || out_size != M * DM || ws_size < WS_END) { fprintf(stderr, "kernel_launch: unexpected shapes (n_in %d, in0 %d, out %d, ws %zu); nothing launched\n", n_in, n_in > 0 ? in_sizes[0] : -1, out_size, ws_size); grid = -1; return; }
        int dev = 0, cus = 0, per_cu = 0;
        if (hipGetDevice(&dev) != hipSuccess || hipDeviceGetAttribute(&cus, hipDeviceAttributeMultiprocessorCount, dev) != hipSuccess) { grid = -1; return; }
        if (hipFuncSetAttribute((const void*)fwd_kernel, hipFuncAttributeMaxDynamicSharedMemorySize, LDS_BYTES) != hipSuccess) { fprintf(stderr, "kernel_launch: hipFuncSetAttribute failed\n"); grid = -1; return; }
        if (hipOccupancyMaxActiveBlocksPerMultiprocessor(&per_cu, (const void*)fwd_kernel, NWAVES * 64, LDS_BYTES) != hipSuccess || per_cu < 1) fprintf(stderr, "kernel_launch: note: occupancy query reports %d\n", per_cu);
        (void)hipGetLastError();
        grid = cus;
    }
    if (grid < 0) return;
    if (hipMemsetAsync((char*)d_ws + WS_CTL, 0, CTL_ZERO_BYTES, stream) != hipSuccess) { fprintf(stderr, "kernel_launch: memset failed\n"); return; }
    Args a{};
    const float** pp = (const float**)&a.p;
    for (int i = 0; i < 21; ++i) pp[i] = (const float*)d_in[i];
    a.p.out = (float*)d_out; a.p.ws = (unsigned char*)d_ws;
#if MK_ONE_LAUNCH
    a.ph_lo = 0; a.ph_hi = N_PHASES;
    hipLaunchKernelGGL(fwd_kernel, dim3(grid), dim3(NWAVES * 64), LDS_BYTES, stream, a);
#else
    for (int ph = 0; ph < N_PHASES; ++ph) { a.ph_lo = ph; a.ph_hi = ph + 1; hipLaunchKernelGGL(fwd_kernel, dim3(grid), dim3(NWAVES * 64), LDS_BYTES, stream, a); }
#endif
}
```

```cpp
#include <hip/hip_runtime.h>
#include <cstdio>
#include <cstdint>
#include <cmath>
namespace pg8 {
#define PG8_LAS __attribute__((address_space(3)))
typedef unsigned short bf16_t;
typedef short bf16x8 __attribute__((ext_vector_type(8)));
typedef float f32x4 __attribute__((ext_vector_type(4)));
typedef unsigned u32x4 __attribute__((ext_vector_type(4)));
constexpr int BM = 256, BK = 64, HALF = 128, HTB = HALF * BK * 2  , STAGE_BYTES = 8 * HTB, NXCD = 8, WGM = 8;

__host__ __device__ __forceinline__ int lds_byte(int r, int c) { const int st = (r >> 4) * 2 + (c >> 5), rr = r & 15, cc = c & 31, ob = rr * 64 + cc * 2; return st * 1024 + (ob ^ (((ob >> 9) & 1) << 5)); }
__host__ __device__ __forceinline__ void stage_rc(int b, int& R, int& C) { const int st = b / 1024, sb = b % 1024, swz = sb ^ (((sb >> 9) & 1) << 5); R = (st >> 1) * 16 + swz / 64; C = (st & 1) * 32 + (swz % 64) / 2; }
__host__ __device__ __forceinline__ int perm32(int rho) { const int n = rho >> 4, i = rho & 15; return 8 * (i >> 2) + 4 * n + (i & 3); }

struct Unit { int pm, pn; };
struct Gemm { const bf16_t* A; const bf16_t* Bt; int M, N, K; };

struct StaticOrder {
    int nM, nN, nwg, G, c;
    __host__ __device__ void init(int M, int N, int G_, int c_) { nM = M / BM; nN = N / BM; nwg = nM * nN; G = G_; c = c_; }
    __host__ __device__ __forceinline__ bool next(int i, Unit& u) const {
        const long L = (long)i * G + c; if (L >= nwg) return false;
        int wgid = (int)L; { const int q = nwg / NXCD, r = nwg % NXCD, xcd = wgid % NXCD, off = wgid / NXCD; wgid = (xcd < r ? xcd * (q + 1) : r * (q + 1) + (xcd - r) * q) + off; }
        const int nig = WGM * nN, gid = wgid / nig, fm = gid * WGM, gsz = (nM - fm) < WGM ? (nM - fm) : WGM;
        u.pm = fm + ((wgid % nig) % gsz); u.pn = (wgid % nig) / gsz; return true;
    }
    __device__ __forceinline__ void a_ready(const Unit&) const {}
    __device__ __forceinline__ void done(const Unit&) const {}
};
__device__ __forceinline__ unsigned cvt_pk_bf16(float lo, float hi) { unsigned r; asm volatile("v_cvt_pk_bf16_f32 %0, %1, %2" : "=v"(r) : "v"(lo), "v"(hi)); return r; }
typedef float f32x2 __attribute__((ext_vector_type(2)));
constexpr float RMS_EPS = 1e-6f;
__device__ __forceinline__ unsigned f2bf1(float f) { unsigned u = __builtin_bit_cast(unsigned, f); return (u + 0x7fffu + ((u >> 16) & 1u)) >> 16; }
__device__ __forceinline__ void store8(bf16_t* p, const f32x4& v0, const f32x4& v1) {
    u32x4 w; w.x = cvt_pk_bf16(v0[0], v0[1]); w.y = cvt_pk_bf16(v0[2], v0[3]); w.z = cvt_pk_bf16(v1[0], v1[1]); w.w = cvt_pk_bf16(v1[2], v1[3]); *(u32x4*)p = w; }
__device__ __forceinline__ float sq8(const f32x4& v0, const f32x4& v1) { return ((v0[0] * v0[0] + v0[1] * v0[1]) + (v0[2] * v0[2] + v0[3] * v0[3])) + ((v1[0] * v1[0] + v1[1] * v1[1]) + (v1[2] * v1[2] + v1[3] * v1[3])); }
typedef unsigned long long u64_t;
__device__ __forceinline__ void atomic_add_fix(u64_t* p, float v) { (void)__hip_atomic_fetch_add(p, (u64_t)(v * 4294967296.f), __ATOMIC_RELAXED, __HIP_MEMORY_SCOPE_AGENT); }
__device__ __forceinline__ float rstd_fix(const u64_t* ss, int row, float invn) { return rsqrtf((float)ss[row] * (invn * 2.3283064365386963e-10f) + RMS_EPS); }
__device__ __forceinline__ void store8_t(bf16_t* p, const f32x4& v0, const f32x4& v1) {
#pragma unroll
    for (int j = 0; j < 4; ++j) { p[(size_t)j * 4096] = (bf16_t)f2bf1(v0[j]); p[(size_t)(j + 4) * 4096] = (bf16_t)f2bf1(v1[j]); } }
__device__ __forceinline__ void rope8(f32x4& v0, f32x4& v1, const f32x4& c, const f32x4& s) {
    const f32x4 a = v0, b = v1;
    v0[0] = a[0] * c[0] - a[1] * s[0]; v0[1] = a[1] * c[0] + a[0] * s[0]; v0[2] = a[2] * c[1] - a[3] * s[1]; v0[3] = a[3] * c[1] + a[2] * s[1];
    v1[0] = b[0] * c[2] - b[1] * s[2]; v1[1] = b[1] * c[2] + b[0] * s[2]; v1[2] = b[2] * c[3] - b[3] * s[3]; v1[3] = b[3] * c[3] + b[2] * s[3]; }

struct EpiABIn {
    static constexpr bool PERM = true, AFTER_DRAIN = false;
    const u64_t* ss0; bf16_t *CQ, *CKV, *KR, *SBQ, *SBK, *SBVT; u64_t *ssq, *sskv; const float *rc, *rs;
    __device__ __forceinline__ void operator()(const f32x4 (&acc)[2][2][4][2], const Unit& u, int wr, int wc, int fr, int fq) const {
        const int pn = u.pn;
#pragma unroll
        for (int ai = 0; ai < 2; ++ai)
#pragma unroll
            for (int m = 0; m < 4; ++m) {
                const int row = u.pm * BM + ai * HALF + wr * 64 + m * 16 + fr;
                const float sc = rstd_fix(ss0, row, 1.f / 4096.f);
                if (pn < 6) {
                    bf16_t* dst = pn < 4 ? CQ + (size_t)row * 1024 + pn * 256 : CKV + (size_t)row * 512 + (pn - 4) * 256;
                    float part = 0.f;
#pragma unroll
                    for (int bj = 0; bj < 2; ++bj) { const f32x4 v0 = acc[ai][bj][m][0] * sc, v1 = acc[ai][bj][m][1] * sc; part += sq8(v0, v1); store8(dst + bj * HALF + wc * 32 + 8 * fq, v0, v1); }
                    part += __shfl_xor(part, 16); part += __shfl_xor(part, 32);
                    if (fq == 0) atomic_add_fix((pn < 4 ? ssq : sskv) + row, part);
                } else if (pn == 6) {
                    if (wc < 2) { f32x4 v0 = acc[ai][0][m][0] * sc, v1 = acc[ai][0][m][1] * sc; const int pos = row & 4095, i0 = 16 * wc + 4 * fq;
                        rope8(v0, v1, *(const f32x4*)(rc + pos * 32 + i0), *(const f32x4*)(rs + pos * 32 + i0)); store8(KR + (size_t)row * 64 + wc * 32 + 8 * fq, v0, v1); }
                } else {
                    const int t = (pn - 7) >> 3, ct = ((pn - 7) & 7) * 256;
                    if (t < 2) { bf16_t* dst = (t == 0 ? SBQ : SBK) + (size_t)row * 2048 + ct; const float sq = t == 0 ? sc * 0.08838834764831845f : sc;
#pragma unroll
                        for (int bj = 0; bj < 2; ++bj) store8(dst + bj * HALF + wc * 32 + 8 * fq, acc[ai][bj][m][0] * sq, acc[ai][bj][m][1] * sq);
                    } else { const int b = row >> 12, s = row & 4095;
#pragma unroll
                        for (int bj = 0; bj < 2; ++bj) { const int col = ct + bj * HALF + wc * 32 + 8 * fq; store8_t(SBVT + ((size_t)(b * 2048 + col)) * 4096 + s, acc[ai][bj][m][0] * sc, acc[ai][bj][m][1] * sc); }
                    }
                }
            }
    }
};
struct EpiUQ {
    static constexpr bool PERM = true, AFTER_DRAIN = false;
    const u64_t* ssq; bf16_t* QA; const float *rc, *rs;
    __device__ __forceinline__ void operator()(const f32x4 (&acc)[2][2][4][2], const Unit& u, int wr, int wc, int fr, int fq) const {
#pragma unroll
        for (int ai = 0; ai < 2; ++ai)
#pragma unroll
            for (int m = 0; m < 4; ++m) {
                const int row = u.pm * BM + ai * HALF + wr * 64 + m * 16 + fr;
                const float sc = rstd_fix(ssq, row, 1.f / 1024.f) * (0.07216878364870322f * 1.4426950408889634f);
#pragma unroll
                for (int bj = 0; bj < 2; ++bj) { const int cb = u.pn * BM + bj * HALF + wc * 32, hd = cb % 192;
                    f32x4 v0 = acc[ai][bj][m][0] * sc, v1 = acc[ai][bj][m][1] * sc;
                    if (hd >= 128) { const int pos = row & 4095, i0 = (hd - 128) / 2 + 4 * fq; rope8(v0, v1, *(const f32x4*)(rc + pos * 32 + i0), *(const f32x4*)(rs + pos * 32 + i0)); }
                    store8(QA + (size_t)row * 3072 + cb + 8 * fq, v0, v1); }
            }
    }
};
struct EpiUKV {
    static constexpr bool PERM = true, AFTER_DRAIN = false;
    const u64_t* sskv; bf16_t *KN, *VAT;
    __device__ __forceinline__ void operator()(const f32x4 (&acc)[2][2][4][2], const Unit& u, int wr, int wc, int fr, int fq) const {
#pragma unroll
        for (int ai = 0; ai < 2; ++ai)
#pragma unroll
            for (int m = 0; m < 4; ++m) {
                const int row = u.pm * BM + ai * HALF + wr * 64 + m * 16 + fr;
                const float sc = rstd_fix(sskv, row, 1.f / 512.f);
                if (u.pn < 8) {
#pragma unroll
                    for (int bj = 0; bj < 2; ++bj) store8(KN + (size_t)row * 2048 + u.pn * BM + bj * HALF + wc * 32 + 8 * fq, acc[ai][bj][m][0] * sc, acc[ai][bj][m][1] * sc);
                } else { const int b = row >> 12, s = row & 4095;
#pragma unroll
                    for (int bj = 0; bj < 2; ++bj) { const int col = (u.pn - 8) * BM + bj * HALF + wc * 32 + 8 * fq; store8_t(VAT + ((size_t)(b * 2048 + col)) * 4096 + s, acc[ai][bj][m][0] * sc, acc[ai][bj][m][1] * sc); }
                }
            }
    }
};
struct EpiResid {
    static constexpr bool PERM = true, AFTER_DRAIN = false;
    const float* resid; float* Hout; bf16_t* HB; u64_t* ssn;
    __device__ __forceinline__ void operator()(const f32x4 (&acc)[2][2][4][2], const Unit& u, int wr, int wc, int fr, int fq) const {
#pragma unroll
        for (int ai = 0; ai < 2; ++ai)
#pragma unroll
            for (int m = 0; m < 4; ++m) {
                const int row = u.pm * BM + ai * HALF + wr * 64 + m * 16 + fr; float part = 0.f;
#pragma unroll
                for (int bj = 0; bj < 2; ++bj) { const size_t off = (size_t)row * 4096 + u.pn * BM + bj * HALF + wc * 32 + 8 * fq;
                    const f32x4 h0 = *(const f32x4*)(resid + off) + acc[ai][bj][m][0], h1 = *(const f32x4*)(resid + off + 4) + acc[ai][bj][m][1];
                    *(f32x4*)(Hout + off) = h0; *(f32x4*)(Hout + off + 4) = h1; if (HB) store8(HB + off, h0, h1); part += sq8(h0, h1); }
                part += __shfl_xor(part, 16); part += __shfl_xor(part, 32);
                if (fq == 0 && ssn) atomic_add_fix(ssn + row, part);
            }
    }
};
struct EpiUp {
    static constexpr bool PERM = true, AFTER_DRAIN = false;
    const u64_t* ss; bf16_t* UP;
    __device__ __forceinline__ void operator()(const f32x4 (&acc)[2][2][4][2], const Unit& u, int wr, int wc, int fr, int fq) const {
#pragma unroll
        for (int ai = 0; ai < 2; ++ai)
#pragma unroll
            for (int m = 0; m < 4; ++m) {
                const int row = u.pm * BM + ai * HALF + wr * 64 + m * 16 + fr;
                const float sc = rstd_fix(ss, row, 1.f / 4096.f);
#pragma unroll
                for (int bj = 0; bj < 2; ++bj) store8(UP + (size_t)row * 22016 + u.pn * BM + bj * HALF + wc * 32 + 8 * fq, acc[ai][bj][m][0] * sc, acc[ai][bj][m][1] * sc);
            }
    }
};
struct EpiCIn {
    static constexpr bool PERM = true, AFTER_DRAIN = false;
    const u64_t* ss; bf16_t *CQ1, *CK1, *CVT; unsigned* kmax;
    __device__ __forceinline__ void operator()(const f32x4 (&acc)[2][2][4][2], const Unit& u, int wr, int wc, int fr, int fq) const {
        float kmx[2] = {0.f, 0.f};
#pragma unroll
        for (int ai = 0; ai < 2; ++ai)
#pragma unroll
            for (int m = 0; m < 4; ++m) {
                const int row = u.pm * BM + ai * HALF + wr * 64 + m * 16 + fr;
                const float sc = rstd_fix(ss, row, 1.f / 4096.f);
                if (u.pn < 32) { bf16_t* dst = (u.pn < 16 ? CQ1 : CK1) + (size_t)row * 4096 + (u.pn & 15) * BM; const float sq = u.pn < 16 ? sc * (0.08838834764831845f * 1.4426950408889634f) : sc;
#pragma unroll
                    for (int bj = 0; bj < 2; ++bj) { const f32x4 v0 = acc[ai][bj][m][0] * sq, v1 = acc[ai][bj][m][1] * sq; store8(dst + bj * HALF + wc * 32 + 8 * fq, v0, v1);
                        if (u.pn >= 16) { float part = sq8(v0, v1); part += __shfl_xor(part, 16); part += __shfl_xor(part, 32); kmx[bj] = fmaxf(kmx[bj], part); } }
                } else { const int b = row >> 12, s = row & 4095;
#pragma unroll
                    for (int bj = 0; bj < 2; ++bj) { const int col = (u.pn - 32) * BM + bj * HALF + wc * 32 + 8 * fq; store8_t(CVT + ((size_t)(b * 4096 + col)) * 4096 + s, acc[ai][bj][m][0] * sc, acc[ai][bj][m][1] * sc); }
                }
            }
        if (u.pn >= 16 && u.pn < 32) {
#pragma unroll
            for (int bj = 0; bj < 2; ++bj) { float v = kmx[bj]; v = fmaxf(v, __shfl_xor(v, 1)); v = fmaxf(v, __shfl_xor(v, 2)); v = fmaxf(v, __shfl_xor(v, 4)); v = fmaxf(v, __shfl_xor(v, 8));
                if (fr == 0 && fq == 0) (void)__hip_atomic_fetch_max(kmax + (((u.pm >> 4) * 32 + (u.pn - 16) * 2 + bj) * 4 + wc), __builtin_bit_cast(unsigned, v), __ATOMIC_RELAXED, __HIP_MEMORY_SCOPE_AGENT); } }
    }
};

__device__ __forceinline__ float dpp_shr1_keep(float old, float src) { return __builtin_bit_cast(float, __builtin_amdgcn_update_dpp(__builtin_bit_cast(int, old), __builtin_bit_cast(int, src), 0x111, 0xf, 0xf, false)); }
__device__ __forceinline__ float dpp_ror1(float src) { return __builtin_bit_cast(float, __builtin_amdgcn_update_dpp(0, __builtin_bit_cast(int, src), 0x121, 0xf, 0xf, false)); }
struct EpiUpConv {
    static constexpr bool PERM = true, AFTER_DRAIN = false;
    const u64_t* ss; bf16_t* ACT; float *HEAD, *TAIL; const float *cw, *cb; PG8_LAS float* xch;
    __device__ __forceinline__ void operator()(const f32x4 (&acc)[2][2][4][2], const Unit& u, int wr, int wc, int fr, int fq) const {
        const int cp = u.pn * 128 + wc * 32 + 8 * fq;
        float sc[2][4];
#pragma unroll
        for (int ai = 0; ai < 2; ++ai)
#pragma unroll
            for (int m = 0; m < 4; ++m) sc[ai][m] = rstd_fix(ss, u.pm * BM + ai * HALF + wr * 64 + m * 16 + fr, 1.f / 4096.f);
#pragma unroll
        for (int ai = 0; ai < 2; ++ai) {
            if (fr >= 14) { PG8_LAS float* d = xch + (((2 * ai + wr) * 4 + wc) * 2 + (fr - 14)) * 64 + fq * 8;
#pragma unroll
                for (int bj = 0; bj < 2; ++bj) { const f32x4 v0 = acc[ai][bj][3][0] * sc[ai][3], v1 = acc[ai][bj][3][1] * sc[ai][3]; *(PG8_LAS f32x4*)(d + bj * 32) = v0; *(PG8_LAS f32x4*)(d + bj * 32 + 4) = v1;
                    if (ai == 1 && wr == 1) { float* t = TAIL + ((size_t)(u.pm * 2 + (fr - 14)) * 2 + bj) * 11008 + cp; *(f32x4*)t = v0; *(f32x4*)(t + 4) = v1; } } }
        }
        if (wr == 0 && fr < 2) {
#pragma unroll
            for (int bj = 0; bj < 2; ++bj) { float* t = HEAD + ((size_t)(u.pm * 2 + fr) * 2 + bj) * 11008 + cp; *(f32x4*)t = acc[0][bj][0][0] * sc[0][0]; *(f32x4*)(t + 4) = acc[0][bj][0][1] * sc[0][0]; } }
        asm volatile("s_waitcnt lgkmcnt(0)\n\ts_barrier" ::: "memory");
        unsigned plo[2][4][2];
#pragma unroll
        for (int hf = 0; hf < 2; ++hf) {
            const int c0 = cp + 4 * hf;
            f32x4 wg[3], wu[3];
#pragma unroll
            for (int j = 0; j < 3; ++j) { wg[j] = *(const f32x4*)(cw + j * 22016 + c0); wu[j] = *(const f32x4*)(cw + j * 22016 + 11008 + c0); }
            const f32x4 bg = *(const f32x4*)(cb + c0), bu = *(const f32x4*)(cb + 11008 + c0);
#pragma unroll
            for (int ai = 0; ai < 2; ++ai) {
                const int seg = 2 * ai + wr;
                f32x4 pg = {0.f, 0.f, 0.f, 0.f}, pu = pg;
                if (seg > 0 && fr >= 14) { const PG8_LAS float* s = xch + ((((seg - 1) * 4 + wc) * 2 + (fr - 14)) * 64) + fq * 8 + 4 * hf; pg = *(const PG8_LAS f32x4*)s; pu = *(const PG8_LAS f32x4*)(s + 32); }
                f32x4 p1g, p1u;
#pragma unroll
                for (int e = 0; e < 4; ++e) { p1g[e] = dpp_shr1_keep(0.f, pg[e]); p1u[e] = dpp_shr1_keep(0.f, pu[e]); }
#pragma unroll
                for (int m = 0; m < 4; ++m) {
                    const f32x4 xg = acc[ai][0][m][hf] * sc[ai][m], xu = acc[ai][1][m][hf] * sc[ai][m];
                    f32x4 ag, au; float o[4];
#pragma unroll
                    for (int e = 0; e < 4; ++e) { ag[e] = dpp_shr1_keep(dpp_ror1(pg[e]), xg[e]); au[e] = dpp_shr1_keep(dpp_ror1(pu[e]), xu[e]);
                        const float a2g = dpp_shr1_keep(dpp_ror1(p1g[e]), ag[e]), a2u = dpp_shr1_keep(dpp_ror1(p1u[e]), au[e]);
                        const float gv = wg[0][e] * a2g + wg[1][e] * ag[e] + wg[2][e] * xg[e] + bg[e], uv = wu[0][e] * a2u + wu[1][e] * au[e] + wu[2][e] * xu[e] + bu[e];
                        o[e] = gv * uv * __builtin_amdgcn_rcpf(1.f + __builtin_amdgcn_exp2f(gv * -1.4426950408889634f)); }
                    pg = xg; pu = xu; p1g = ag; p1u = au;
                    const unsigned w0 = cvt_pk_bf16(o[0], o[1]), w1 = cvt_pk_bf16(o[2], o[3]);
                    if (hf == 0) { plo[ai][m][0] = w0; plo[ai][m][1] = w1; }
                    else if (!(seg == 0 && m == 0 && fr < 2)) { u32x4 w; w.x = plo[ai][m][0]; w.y = plo[ai][m][1]; w.z = w0; w.w = w1; *(u32x4*)(ACT + (size_t)(u.pm * BM + ai * HALF + wr * 64 + m * 16 + fr) * 11008 + cp) = w; }
                }
            }
        }
    }
};
template <class Epi, class Sched, bool ALIGN_EPI = false, bool SP2 = false>
__device__ __forceinline__ void gemm_phase(PG8_LAS unsigned char* lds, const Gemm g, const Sched& S, const Epi& E) {
    const int tid = threadIdx.x, wid = __builtin_amdgcn_readfirstlane(tid >> 6), lane = tid & 63, wr = wid >> 2, wc = wid & 3, fr = lane & 15, fq = lane >> 4;
    const int K = g.K, nt = K / BK;
    unsigned voffA[2], voffB[2];
#pragma unroll
    for (int i = 0; i < 2; ++i) { int R, C; stage_rc(tid * 16 + i * 8192, R, C); const int Rb = Epi::PERM ? ((R & ~31) + perm32(R & 31)) : R;
        voffA[i] = (unsigned)(R * K + C) * 2u; voffB[i] = (unsigned)(Rb * K + C) * 2u; }
    const size_t kstep = (size_t)(BK * 2);
    const size_t hstep = (size_t)HALF * K * 2;
    const size_t tstep = 2 * hstep;
    const unsigned ldsw = (unsigned)wid * 1024u;
    const int aoff = lds_byte(wr * 64 + fr, fq * 8), boff = lds_byte(wc * 32 + fr, fq * 8);
#define PG8_SA(b, h) (((b) * 2 + (h)) * HTB)
#define PG8_SB(b, h) ((4 + (b) * 2 + (h)) * HTB)
#define PG8_STAGE(bufoff, gbase, voff) do { _Pragma("unroll") for (int _i = 0; _i < 2; ++_i) \
        __builtin_amdgcn_global_load_lds((const unsigned*)((const char*)(gbase) + (voff)[_i]), (PG8_LAS unsigned*)(lds + (bufoff) + ldsw + _i * 8192), 16, 0, 0); } while (0)
#define PG8_LDA(dst, b, h) do { _Pragma("unroll") for (int m = 0; m < 4; ++m) _Pragma("unroll") for (int k = 0; k < 2; ++k) dst[m][k] = *(const PG8_LAS bf16x8*)(lds + PG8_SA(b, h) + aoff + m * 2048 + k * 1024); } while (0)
#define PG8_LDB(dst, b, h) do { _Pragma("unroll") for (int n = 0; n < 2; ++n) _Pragma("unroll") for (int k = 0; k < 2; ++k) dst[n][k] = *(const PG8_LAS bf16x8*)(lds + PG8_SB(b, h) + boff + n * 2048 + k * 1024); } while (0)
#define PG8_MMA(ai, bj, At, Bt) do { __builtin_amdgcn_s_setprio(1); _Pragma("unroll") for (int m = 0; m < 4; ++m) _Pragma("unroll") for (int n = 0; n < 2; ++n) _Pragma("unroll") for (int k = 0; k < 2; ++k) \
        acc[ai][bj][m][n] = __builtin_amdgcn_mfma_f32_16x16x32_bf16(Bt[n][k], At[m][k], acc[ai][bj][m][n], 0, 0, 0); __builtin_amdgcn_s_setprio(0); } while (0)
#define PG8_WAIT_V(n) asm volatile("s_waitcnt vmcnt(" #n ")" ::: "memory")
#define PG8_WAIT_L(n) asm volatile("s_waitcnt lgkmcnt(" #n ")" ::: "memory")
#define PG8_BAR __builtin_amdgcn_s_barrier()
#define PG8_SCHED __builtin_amdgcn_sched_barrier(0)
    Unit cur, nxt; int ui = 0;
    if (!S.next(0, cur)) return;
    f32x4 acc[2][2][4][2];
#pragma unroll
    for (int a = 0; a < 2; ++a)
#pragma unroll
        for (int b = 0; b < 2; ++b)
#pragma unroll
            for (int m = 0; m < 4; ++m)
#pragma unroll
                for (int n = 0; n < 2; ++n) acc[a][b][m][n] = (f32x4){0.f, 0.f, 0.f, 0.f};
    bf16x8 At[4][2], B0[2][2], B1[2][2];
    const char* cA = (const char*)g.A + (size_t)cur.pm * tstep; const char* cB = (const char*)g.Bt + (size_t)cur.pn * tstep;
    S.a_ready(cur);
    if constexpr (SP2) {
        PG8_STAGE(PG8_SB(0, 0), cB, voffB); PG8_STAGE(PG8_SB(0, 1), cB + hstep, voffB); PG8_STAGE(PG8_SA(0, 0), cA, voffA); PG8_STAGE(PG8_SA(0, 1), cA + hstep, voffA);
        if (wr == 1) PG8_BAR;
        PG8_WAIT_V(2); PG8_BAR;
        PG8_STAGE(PG8_SB(1, 0), cB + kstep, voffB); PG8_STAGE(PG8_SA(1, 0), cA + kstep, voffA); PG8_STAGE(PG8_SB(1, 1), cB + hstep + kstep, voffB);
        PG8_WAIT_V(6); PG8_BAR;
    } else {
        PG8_STAGE(PG8_SB(0, 0), cB, voffB); PG8_STAGE(PG8_SA(0, 0), cA, voffA); PG8_STAGE(PG8_SB(0, 1), cB + hstep, voffB); PG8_STAGE(PG8_SA(0, 1), cA + hstep, voffA);
        if (wr == 1) PG8_BAR;
        PG8_WAIT_V(4); PG8_BAR;
        PG8_STAGE(PG8_SB(1, 0), cB + kstep, voffB); PG8_STAGE(PG8_SA(1, 0), cA + kstep, voffA); PG8_STAGE(PG8_SB(1, 1), cB + hstep + kstep, voffB);
        PG8_WAIT_V(6); PG8_BAR;
    }
    for (;;) {
        const bool has_next = S.next(ui + 1, nxt);
        const char* nA = has_next ? (const char*)g.A + (size_t)nxt.pm * tstep : cA; const char* nB = has_next ? (const char*)g.Bt + (size_t)nxt.pn * tstep : cB;
        for (int t = 0; t < nt; t += 2) {
            const bool last = (t == nt - 2);
            const char* a1 = cA + (size_t)(t + 1) * kstep;
            const char* a2 = last ? nA : cA + (size_t)(t + 2) * kstep; const char* b2 = last ? nB : cB + (size_t)(t + 2) * kstep;
            const char* a3 = a2 + kstep; const char* b3 = b2 + kstep;
            if (last && has_next) S.a_ready(nxt);
            if constexpr (SP2) {
            PG8_LDB(B0, 0, 0); PG8_LDB(B1, 0, 1); PG8_SCHED; PG8_LDA(At, 0, 0); PG8_STAGE(PG8_SA(1, 1), a1 + hstep, voffA);
            PG8_WAIT_V(8); PG8_WAIT_L(0); PG8_BAR; PG8_MMA(0, 0, At, B0); PG8_MMA(0, 1, At, B1); PG8_BAR; PG8_SCHED;
            PG8_LDA(At, 0, 1); PG8_STAGE(PG8_SB(0, 0), b2, voffB); PG8_STAGE(PG8_SB(0, 1), b2 + hstep, voffB); PG8_STAGE(PG8_SA(0, 0), a2, voffA);
            PG8_WAIT_V(8); PG8_WAIT_L(0); PG8_BAR; PG8_MMA(1, 0, At, B0); PG8_MMA(1, 1, At, B1); PG8_BAR; PG8_SCHED;
            PG8_LDB(B0, 1, 0); PG8_LDB(B1, 1, 1); PG8_SCHED; PG8_LDA(At, 1, 0); PG8_STAGE(PG8_SA(0, 1), a2 + hstep, voffA);
            PG8_WAIT_V(8); PG8_WAIT_L(0); PG8_BAR; PG8_MMA(0, 0, At, B0); PG8_MMA(0, 1, At, B1); PG8_BAR; PG8_SCHED;
            PG8_LDA(At, 1, 1); PG8_STAGE(PG8_SB(1, 0), b3, voffB); PG8_STAGE(PG8_SB(1, 1), b3 + hstep, voffB); PG8_STAGE(PG8_SA(1, 0), a3, voffA);
            PG8_WAIT_V(8); PG8_WAIT_L(0); PG8_BAR; PG8_MMA(1, 0, At, B0); PG8_MMA(1, 1, At, B1); PG8_BAR; PG8_SCHED;
            } else {
            PG8_LDB(B0, 0, 0); PG8_SCHED; PG8_LDA(At, 0, 0); PG8_STAGE(PG8_SA(1, 1), a1 + hstep, voffA);
            PG8_WAIT_L(8); PG8_BAR; PG8_WAIT_L(0); PG8_MMA(0, 0, At, B0); PG8_BAR; PG8_SCHED;
            PG8_LDB(B1, 0, 1); PG8_STAGE(PG8_SB(0, 0), b2, voffB);
            PG8_BAR; PG8_WAIT_L(0); PG8_MMA(0, 1, At, B1); PG8_BAR;
            PG8_LDA(At, 0, 1); PG8_STAGE(PG8_SA(0, 0), a2, voffA);
            PG8_BAR; PG8_WAIT_L(0); PG8_MMA(1, 0, At, B0); PG8_BAR; PG8_SCHED;
            PG8_STAGE(PG8_SB(0, 1), b2 + hstep, voffB);
            PG8_WAIT_V(6); PG8_BAR; PG8_MMA(1, 1, At, B1); PG8_BAR;
            PG8_LDB(B0, 1, 0); PG8_SCHED; PG8_LDA(At, 1, 0); PG8_STAGE(PG8_SA(0, 1), a2 + hstep, voffA);
            PG8_WAIT_L(8); PG8_BAR; PG8_WAIT_L(0); PG8_MMA(0, 0, At, B0); PG8_BAR; PG8_SCHED;
            PG8_LDB(B1, 1, 1); PG8_STAGE(PG8_SB(1, 0), b3, voffB);
            PG8_BAR; PG8_WAIT_L(0); PG8_MMA(0, 1, At, B1); PG8_BAR;
            PG8_LDA(At, 1, 1); PG8_STAGE(PG8_SA(1, 0), a3, voffA);
            PG8_BAR; PG8_WAIT_L(0); PG8_MMA(1, 0, At, B0); PG8_BAR; PG8_SCHED;
            PG8_STAGE(PG8_SB(1, 1), b3 + hstep, voffB);
            PG8_WAIT_V(6); PG8_BAR; PG8_MMA(1, 1, At, B1); PG8_BAR;
            }
        }
        if constexpr (ALIGN_EPI) { if (wr == 0) PG8_BAR; }
        if constexpr (!Epi::AFTER_DRAIN) { E(acc, cur, wr, wc, fr, fq); S.done(cur); }
        if (!has_next) break;
#pragma unroll
        for (int a = 0; a < 2; ++a)
#pragma unroll
            for (int b = 0; b < 2; ++b)
#pragma unroll
                for (int m = 0; m < 4; ++m)
#pragma unroll
                    for (int n = 0; n < 2; ++n) acc[a][b][m][n] = (f32x4){0.f, 0.f, 0.f, 0.f};
        cur = nxt; cA = nA; cB = nB; ++ui;
        if constexpr (ALIGN_EPI) { if (wr == 1) PG8_BAR; }
    }
    PG8_WAIT_V(0);
    if constexpr (!ALIGN_EPI) { if (wr == 0) PG8_BAR; }
    PG8_BAR;
    if constexpr (Epi::AFTER_DRAIN) { E.fused(acc, cur, wr, wc, fr, fq, lds, wid, lane); S.done(cur); }
#undef PG8_SA
#undef PG8_SB
#undef PG8_STAGE
#undef PG8_LDA
#undef PG8_LDB
#undef PG8_MMA
#undef PG8_WAIT_V
#undef PG8_WAIT_L
#undef PG8_BAR
#undef PG8_SCHED
}
}

constexpr int NWAVES = 8;
constexpr int SEQ = 4096, DM = 4096, M = 8192, FF = 11008, FF2 = 22016, NAB = 7936;
constexpr float EPS = 1e-6f;
constexpr float LAMBDA_INIT = 0.35550906f;
#ifndef MK_ONE_LAUNCH
#define MK_ONE_LAUNCH 1
#endif
constexpr int N_PHASES = 15;

constexpr size_t MiB = 1u << 20;
constexpr size_t WS_CTL = 0, CTL_ZERO_BYTES = 1 * MiB;
constexpr size_t WS_SS = 262144;
constexpr size_t WS_ROPE = 1 * MiB;
constexpr size_t WS_WABIN = 2 * MiB, WS_WUQ = 64 * MiB, WS_WUKV = 70 * MiB, WS_WABOUT = 74 * MiB, WS_WCIN = 106 * MiB, WS_WCOUT = 202 * MiB;
constexpr size_t WS_WUP0 = 234 * MiB, WS_WUP1 = 406 * MiB, WS_WDN0 = 578 * MiB, WS_WDN1 = 664 * MiB;
constexpr size_t WS_HB = 752 * MiB, WS_H = 816 * MiB, WS_CQ = 944 * MiB, WS_CKV = 960 * MiB, WS_KR = 968 * MiB, WS_SBQ = 970 * MiB, WS_SBK = 1002 * MiB, WS_SBVT = 1034 * MiB;
constexpr size_t WS_QA = 1066 * MiB, WS_KN = 1114 * MiB, WS_VAT = 1146 * MiB, WS_O = 1178 * MiB, WS_UP = 1242 * MiB, WS_ACT = 1586 * MiB;
constexpr size_t WS_CQ1 = 1758 * MiB, WS_CK1 = 1822 * MiB, WS_CVT = 1886 * MiB, WS_DS = 1950 * MiB, WS_DS1 = 2078 * MiB, WS_HEAD = 2206 * MiB, WS_TAIL = 2214 * MiB, WS_END = 2222 * MiB;
static_assert(WS_WABIN + (size_t)NAB * 4096 * 2 <= WS_WUQ && WS_WUP0 + (size_t)FF2 * 4096 * 2 <= WS_WUP1 && WS_WDN1 + (size_t)4096 * FF * 2 <= WS_HB && WS_UP + (size_t)M * FF2 * 2 <= WS_ACT && WS_ACT + (size_t)M * FF * 2 <= WS_CQ1, "d_ws map");
constexpr int CW_KMAX = 2048, CW_QUEUE = 2560;
constexpr int CW_BAR = 4096;

constexpr int RING_OFF = 0, RING_BYTES = 131072;
constexpr int LDSCTL_OFF = 139264, MISC_OFF = LDSCTL_OFF + 320;
constexpr int LDS_BYTES = 147456;

#define GAS __attribute__((address_space(1)))
#define LAS __attribute__((address_space(3)))
typedef unsigned short bf16;
typedef unsigned v4u __attribute__((ext_vector_type(4)));
typedef float f32x4 __attribute__((ext_vector_type(4)));
typedef short bf16x8 __attribute__((ext_vector_type(8)));
typedef GAS unsigned gu32;
#define RLX_AGENT __ATOMIC_RELAXED, __HIP_MEMORY_SCOPE_AGENT
#define LDS_WAIT() asm volatile("s_waitcnt lgkmcnt(0)" ::: "memory")
#define VM_WAIT() asm volatile("s_waitcnt vmcnt(0)" ::: "memory")
__device__ __forceinline__ unsigned f2bf(float f) { unsigned u = __builtin_bit_cast(unsigned, f); return (u + 0x7fffu + ((u >> 16) & 1u)) >> 16; }
__device__ __forceinline__ unsigned pk2(float lo, float hi) { return f2bf(lo) | (f2bf(hi) << 16); }
__device__ __forceinline__ float bf2f(unsigned short b) { return __builtin_bit_cast(float, (unsigned)b << 16); }
__device__ __forceinline__ float bflo(unsigned w) { return __builtin_bit_cast(float, w << 16); }
__device__ __forceinline__ float bfhi(unsigned w) { return __builtin_bit_cast(float, w & 0xffff0000u); }
__device__ __forceinline__ float wave_sum(float v) {
#pragma unroll
    for (int o = 1; o < 64; o <<= 1) v += __shfl_xor(v, o);
    return v;
}
__device__ __forceinline__ float wave_max(float v) {
#pragma unroll
    for (int o = 1; o < 64; o <<= 1) v = fmaxf(v, __shfl_xor(v, o));
    return v;
}
#define XB_TMO      128
#define XB_XCNT(j)  (256  + 64 * (j))
#define XB_XSUB(j)  (1280 + 64 * (j))
#define XB_XGEN(j)  (2304 + 64 * (j))
#define XB_TOP      3328
#define XB_TOPGEN   3392
#define XCD_BAR_WORDS 3456
#define XB_SPIN_CAP (1u << 18)

__device__ __forceinline__ unsigned xb_ld(unsigned* p)              { return __hip_atomic_load(p, __ATOMIC_RELAXED, __HIP_MEMORY_SCOPE_AGENT); }
__device__ __forceinline__ unsigned xb_add(unsigned* p, unsigned v) { return __hip_atomic_fetch_add(p, v, __ATOMIC_RELAXED, __HIP_MEMORY_SCOPE_AGENT); }
__device__ __forceinline__ unsigned xb_xcc_id() { return (unsigned)__builtin_amdgcn_s_getreg((3 << 11) | 20) & 0xFu; }
#define XB_SPIN(cond, bar) do { unsigned _sp = 0; while (cond) { __builtin_amdgcn_s_sleep(1); \
    if ((++_sp & 255u) == 0u) { if (xb_ld(&(bar)[XB_TMO])) break; if (_sp > XB_SPIN_CAP) { atomicAdd(&(bar)[XB_TMO], 1u); break; } } } } while (0)

struct XcdBarrier {
    unsigned* bar; unsigned x;
    volatile LAS unsigned* st;
};

__device__ __forceinline__ XcdBarrier xcd_barrier_post(unsigned* bar, volatile LAS unsigned* st) {
    XcdBarrier b; b.bar = bar; b.x = xb_xcc_id(); b.st = st;
    if (threadIdx.x == 0) (void)xb_add(&bar[XB_XCNT(b.x)], 1u);
    return b;
}
__device__ __forceinline__ void xcd_barrier_complete(unsigned* bar, unsigned x, unsigned& nloc, unsigned& nx) {
    const unsigned G = gridDim.x * gridDim.y * gridDim.z;
    unsigned sum, cnt, mine, sp = 0u;
    for (;;) {
        sum = 0u; cnt = 0u; mine = 0u;
#pragma unroll
        for (unsigned j = 0; j < 16; ++j) { const unsigned c = xb_ld(&bar[XB_XCNT(j)]); sum += c; cnt += (c > 0u) ? 1u : 0u; mine = (j == x) ? c : mine; }
        if (sum == G) break;
        __builtin_amdgcn_s_sleep(1);
        if ((++sp & 255u) == 0u) { if (xb_ld(&bar[XB_TMO])) break; if (sp > XB_SPIN_CAP) { atomicAdd(&bar[XB_TMO], 1u); break; } }
    }
    nloc = mine > 0u ? mine : 1u; nx = cnt > 0u ? cnt : 1u;
}

__device__ __forceinline__ void xcd_barrier(const XcdBarrier& b) {
    asm volatile("s_waitcnt vmcnt(0)" ::: "memory");
    __syncthreads();
    if (threadIdx.x == 0) {
        unsigned* bar = b.bar;
        __builtin_amdgcn_s_waitcnt(0);
        unsigned nloc = b.st[0], nx = b.st[1];
        if (nloc == 0u) { xcd_barrier_complete(bar, b.x, nloc, nx); b.st[0] = nloc; b.st[1] = nx; }
        const unsigned old = xb_add(&bar[XB_XSUB(b.x)], 1u);
        const unsigned gen = old / nloc;
        if (old + 1u == (gen + 1u) * nloc) {
            __builtin_amdgcn_fence(__ATOMIC_RELEASE, "agent");
            asm volatile("s_waitcnt vmcnt(0)" ::: "memory");
            const unsigned og = xb_add(&bar[XB_TOP], 1u);
            const unsigned tg = og / nx;
            if (og + 1u == (tg + 1u) * nx) xb_add(&bar[XB_TOPGEN], 1u);
            else XB_SPIN(xb_ld(&bar[XB_TOPGEN]) == tg, bar);
            __builtin_amdgcn_fence(__ATOMIC_ACQUIRE, "agent");
            xb_add(&bar[XB_XGEN(b.x)], 1u);
            asm volatile("s_waitcnt vmcnt(0)" ::: "memory");
        } else {
            XB_SPIN(xb_ld(&bar[XB_XGEN(b.x)]) == gen, bar);
            __builtin_amdgcn_fence(__ATOMIC_ACQUIRE, "agent");
            asm volatile("s_waitcnt vmcnt(0)" ::: "memory");
        }
    }
    __syncthreads();
}

typedef float f32x16 __attribute__((ext_vector_type(16)));
typedef float f32x2v __attribute__((ext_vector_type(2)));
typedef __bf16 bf16x2v __attribute__((ext_vector_type(2)));
#define MFMA32(a, b, c) __builtin_amdgcn_mfma_f32_32x32x16_bf16((a), (b), (c), 0, 0, 0)
__device__ __forceinline__ int swz23(int m) { return (m & ~12) | ((m & 4) << 1) | ((m & 8) >> 1); }
__device__ __forceinline__ unsigned pkbf(float a, float b) { const f32x2v v = {a, b}; return __builtin_bit_cast(unsigned, __builtin_convertvector(v, bf16x2v)); }
__device__ __forceinline__ bf16x8 pack8(const f32x16& x, int c) { v4u w; w.x = pkbf(x[8 * c], x[8 * c + 1]); w.y = pkbf(x[8 * c + 2], x[8 * c + 3]); w.z = pkbf(x[8 * c + 4], x[8 * c + 5]); w.w = pkbf(x[8 * c + 6], x[8 * c + 7]); return __builtin_bit_cast(bf16x8, w); }
__device__ __forceinline__ float xhalf(float v) { return __shfl_xor(v, 32); }

template <int DQK, int DV> struct AttnTile {
    static constexpr int KS = DQK * 2 + 16, VS = 144, KBYTES = 64 * KS, VBYTES = DV * VS, BUF = KBYTES + VBYTES;
    static constexpr int NK = 64 * (DQK / 8) / 512, NV = DV * 8 / 512;
    v4u rk[NK], rv[NV];
    unsigned gk, gk2, gv;
    __device__ __forceinline__ void init(int k_pitch, int tid) { gk = (unsigned)((tid >> 4) * k_pitch + (tid & 15) * 8) * 2u; gk2 = (unsigned)((tid >> 3) * 64 + (tid & 7) * 8) * 2u; gv = (unsigned)((tid >> 3) * 4096 + (tid & 7) * 8) * 2u; }
    __amdgpu_buffer_rsrc_t r1, r2, rv_;
    __device__ __forceinline__ void bind(const bf16* K1, const bf16* K2, const bf16* VT) {
        r1 = __builtin_amdgcn_make_buffer_rsrc((void*)K1, 0, 0x7fffffff, 0x00020000); r2 = __builtin_amdgcn_make_buffer_rsrc((void*)(DQK == 192 ? K2 : K1), 0, 0x7fffffff, 0x00020000);
        rv_ = __builtin_amdgcn_make_buffer_rsrc((void*)VT, 0, 0x7fffffff, 0x00020000); }
    __device__ __forceinline__ void load(int k_pitch, int kt) {
        const int ko = kt * 64 * k_pitch * 2;
        rk[0] = __builtin_amdgcn_raw_buffer_load_b128(r1, gk, ko, 0); rk[1] = __builtin_amdgcn_raw_buffer_load_b128(r1, gk, ko + k_pitch * 64, 0);
        if (DQK == 192) rk[NK - 1] = __builtin_amdgcn_raw_buffer_load_b128(r2, gk2, kt * 64 * 64 * 2, 0);
#pragma unroll
        for (int i = 0; i < NV; ++i) rv[i] = __builtin_amdgcn_raw_buffer_load_b128(rv_, gv, kt * 128 + i * (64 * 4096 * 2), 0);
    }
    __device__ __forceinline__ void store(LAS unsigned char* buf, int tid) const {
#pragma unroll
        for (int i = 0; i < 2; ++i) { const int c = tid + 512 * i, r = c >> 4, cc = c & 15; *(LAS v4u*)(buf + r * KS + cc * 16) = rk[i]; }
        if (DQK == 192) { const int r = tid >> 3, cc = tid & 7; *(LAS v4u*)(buf + r * KS + 256 + cc * 16) = rk[NK - 1]; }
#pragma unroll
        for (int i = 0; i < NV; ++i) { const int c = tid + 512 * i, d = c >> 3, cc = c & 7; *(LAS v4u*)(buf + KBYTES + d * VS + cc * 16) = rv[i]; }
    }
};
template <int DQK> __device__ __forceinline__ void qk_tile(const LAS unsigned char* kb, int KS, const bf16x8 (&qf)[DQK / 16], int lane, f32x16 (&s)[2]) {
    const int h = lane >> 5, kr = swz23(lane & 31);
    f32x16 a0, a1;
#pragma unroll
    for (int i = 0; i < 16; ++i) { a0[i] = 0.f; a1[i] = 0.f; }
    const LAS unsigned char* p0 = kb + kr * KS + h * 16; const LAS unsigned char* p1 = p0 + 32 * KS;
    constexpr int G = DQK / 32;
    bf16x8 f[2][4];
#define QK_LOAD(dst, g) do { dst[0] = *(const LAS bf16x8*)(p0 + (g) * 64); dst[1] = *(const LAS bf16x8*)(p1 + (g) * 64); dst[2] = *(const LAS bf16x8*)(p0 + (g) * 64 + 32); dst[3] = *(const LAS bf16x8*)(p1 + (g) * 64 + 32); } while (0)
    QK_LOAD(f[0], 0);
#pragma unroll
    for (int g = 0; g < G; ++g) {
        if (g + 1 < G) QK_LOAD(f[(g + 1) & 1], g + 1);
        __builtin_amdgcn_sched_barrier(0);
        a0 = MFMA32(f[g & 1][0], qf[2 * g], a0); a1 = MFMA32(f[g & 1][1], qf[2 * g], a1); a0 = MFMA32(f[g & 1][2], qf[2 * g + 1], a0); a1 = MFMA32(f[g & 1][3], qf[2 * g + 1], a1);
        __builtin_amdgcn_sched_barrier(0);
    }
#undef QK_LOAD
    s[0] = a0; s[1] = a1;
}
template <int DV> __device__ __forceinline__ void pv_tile(const LAS unsigned char* vb, const f32x16 (&p)[2], int lane, f32x16 (&o)[DV / 32]) {
    const int h = lane >> 5, dr = swz23(lane & 31);
    bf16x8 pf[4];
#pragma unroll
    for (int g = 0; g < 4; ++g) pf[g] = pack8(p[g >> 1], g & 1);
    const LAS unsigned char* q = vb + dr * 144 + h * 16;
    constexpr int NB = DV / 32;
    bf16x8 f[2][NB];
#define PV_LOAD(dst, g) do { _Pragma("unroll") for (int db = 0; db < NB; ++db) dst[db] = *(const LAS bf16x8*)(q + db * (32 * 144) + (g) * 32); } while (0)
    PV_LOAD(f[0], 0);
#pragma unroll
    for (int g = 0; g < 4; ++g) {
        if (g + 1 < 4) PV_LOAD(f[(g + 1) & 1], g + 1);
        __builtin_amdgcn_sched_barrier(0);
#pragma unroll
        for (int db = 0; db < NB; ++db) o[db] = MFMA32(f[g & 1][db], pf[g], o[db]);
        __builtin_amdgcn_sched_barrier(0);
    }
#undef PV_LOAD
}
__device__ __forceinline__ void store_o8(bf16* p, const f32x16& x, int c, float sc) {
    v4u w; w.x = pkbf(x[8 * c] * sc, x[8 * c + 1] * sc); w.y = pkbf(x[8 * c + 2] * sc, x[8 * c + 3] * sc); w.z = pkbf(x[8 * c + 4] * sc, x[8 * c + 5] * sc); w.w = pkbf(x[8 * c + 6] * sc, x[8 * c + 7] * sc);
    *(GAS v4u*)p = w; }
__device__ __forceinline__ void sb_unit(LAS unsigned char* lds, unsigned char* ws, int bh, int qb, int tid, int wave, int lane) {
    typedef AttnTile<128, 128> T;
    const int b = bh >> 4, hd = bh & 15, q0 = qb * 256, h = lane >> 5, t = q0 + 32 * wave + (lane & 31);
    const bf16* Q = (const bf16*)(ws + WS_SBQ) + (size_t)b * SEQ * 2048 + hd * 128;
    const bf16* K1 = (const bf16*)(ws + WS_SBK) + (size_t)b * SEQ * 2048 + hd * 128;
    const bf16* VT = (const bf16*)(ws + WS_SBVT) + (size_t)bh * 128 * 4096;
    volatile LAS unsigned* flags = (volatile LAS unsigned*)(lds + 2 * T::BUF);
    bf16x8 qf[8];
#pragma unroll
    for (int kk = 0; kk < 8; ++kk) qf[kk] = __builtin_bit_cast(bf16x8, *(const GAS v4u*)(Q + (size_t)t * 2048 + 16 * kk + 8 * h));
    f32x16 o[4];
#pragma unroll
    for (int db = 0; db < 4; ++db)
#pragma unroll
        for (int i = 0; i < 16; ++i) o[db][i] = 0.f;
    float carry = 0.f; bool mydone = false;
    const int kt_hi = (q0 >> 6) + 3, ktw = (q0 >> 6) + (wave >> 1);
    const float scale = 0.08838834764831845f, L2E = 1.4426950408889634f, LN2 = 0.6931471805599453f;
    T tile; tile.init(2048, tid); tile.bind(K1, K1, VT); tile.load(2048, kt_hi); tile.store(lds, tid); __syncthreads();
    int it = 0;
#pragma unroll 1
    for (int kt = kt_hi; kt >= 0; --kt, ++it) {
        const LAS unsigned char* kb = lds + (it & 1) * T::BUF;
        if (kt > 0) tile.load(2048, kt - 1);
        if (kt <= ktw && !mydone) {
            f32x16 s[2]; qk_tile<128>(kb, T::KS, qf, lane, s);
            float tot[2][2];
#pragma unroll
            for (int blk = 0; blk < 2; ++blk)
#pragma unroll
                for (int c = 0; c < 2; ++c) { float run = 0.f;
#pragma unroll
                    for (int j = 7; j >= 0; --j) { const int i = 8 * c + j, key = kt * 64 + 32 * blk + 16 * c + 8 * h + j; const bool valid = key < t;
                        const float z = s[blk][i];
                        const float sp = fmaxf(z, 0.f) + LN2 * __builtin_amdgcn_logf(1.f + __builtin_amdgcn_exp2f(-fabsf(z) * L2E));
                        const float lk = valid ? -sp : 0.f;
                        s[blk][i] = valid ? (z + lk + run) : -INFINITY;
                        run += lk; }
                    tot[blk][c] = run; }
            float par[2][2], off[2][2];
#pragma unroll
            for (int blk = 0; blk < 2; ++blk)
#pragma unroll
                for (int c = 0; c < 2; ++c) par[blk][c] = xhalf(tot[blk][c]);
            float acc = carry;
            off[1][1] = acc + (h == 0 ? par[1][1] : 0.f); acc += tot[1][1] + par[1][1];
            off[1][0] = acc + (h == 0 ? par[1][0] : 0.f); acc += tot[1][0] + par[1][0];
            off[0][1] = acc + (h == 0 ? par[0][1] : 0.f); acc += tot[0][1] + par[0][1];
            off[0][0] = acc + (h == 0 ? par[0][0] : 0.f); acc += tot[0][0] + par[0][0];
            carry = acc;
#pragma unroll
            for (int blk = 0; blk < 2; ++blk)
#pragma unroll
                for (int i = 0; i < 16; ++i) s[blk][i] = __builtin_amdgcn_exp2f((s[blk][i] + off[blk][i >> 3]) * L2E);
            pv_tile<128>(kb + T::KBYTES, s, lane, o);
            mydone = __all(carry < -110.f);
        }
        if (kt > 0) tile.store(lds + ((it + 1) & 1) * T::BUF, tid);
        if (lane == 0) flags[(it & 1) * 8 + wave] = mydone ? 1u : 0u;
        __syncthreads();
        unsigned alld = 1u;
#pragma unroll
        for (int w = 0; w < 8; ++w) alld &= flags[(it & 1) * 8 + w];
        if (alld) break;
    }
    __syncthreads();
    bf16* orow = (bf16*)(ws + WS_O) + (size_t)(b * SEQ + t) * 4096 + 2048 + hd * 128 + 8 * h;
#pragma unroll
    for (int db = 0; db < 4; ++db) { store_o8(orow + 32 * db, o[db], 0, 1.f); store_o8(orow + 32 * db + 16, o[db], 1, 1.f); }
}
template <int DQK, int DV> struct DmaTile {
    static constexpr int KB = 64 * 256, KRB = (DQK == 192) ? 64 * 128 : 0, VB = DV * 128, BUF = KB + KRB + VB, NVW = DV / 64;
    __amdgpu_buffer_rsrc_t r1, r2, rv;
    unsigned gk0, gk1, gk2, gvE, gvO; int kpb;
    __device__ __forceinline__ void init(const bf16* K1, int k_pitch, const bf16* K2, const bf16* VT, int wave, int lane) {
        r1 = __builtin_amdgcn_make_buffer_rsrc((void*)K1, 0, 0x7fffffff, 0x00020000); r2 = __builtin_amdgcn_make_buffer_rsrc((void*)(DQK == 192 ? K2 : K1), 0, 0x7fffffff, 0x00020000);
        rv = __builtin_amdgcn_make_buffer_rsrc((void*)VT, 0, 0x7fffffff, 0x00020000); kpb = k_pitch * 2;
        { const int p = lane & 15, ra = 8 * wave + (lane >> 4), rb = ra + 4; gk0 = (unsigned)(ra * kpb + ((p ^ (ra & 15)) << 4)); gk1 = (unsigned)(rb * kpb + ((p ^ (rb & 15)) << 4)); }
        { const int p = lane & 7, r = 8 * wave + (lane >> 3); gk2 = (unsigned)(r * 128 + ((p ^ ((r >> 1) & 7)) << 4)); }
        { const int p = lane & 7, l3 = lane >> 3, d0 = 8 * wave * NVW + l3; gvE = (unsigned)(d0 * 8192 + ((p ^ (l3 >> 1)) << 4)); gvO = (unsigned)((d0 + 8) * 8192 + ((p ^ (4 + (l3 >> 1))) << 4)); }
    }
    __device__ __forceinline__ void issue(LAS unsigned char* buf, int kt, int wave) const {
        __builtin_amdgcn_raw_ptr_buffer_load_lds(r1, (LAS void*)(buf + wave * 2048), 16, gk0, kt * 64 * kpb, 0, 0);
        __builtin_amdgcn_raw_ptr_buffer_load_lds(r1, (LAS void*)(buf + wave * 2048 + 1024), 16, gk1, kt * 64 * kpb, 0, 0);
        if (DQK == 192) __builtin_amdgcn_raw_ptr_buffer_load_lds(r2, (LAS void*)(buf + KB + wave * 1024), 16, gk2, kt * 64 * 128, 0, 0);
#pragma unroll
        for (int i = 0; i < NVW; ++i) __builtin_amdgcn_raw_ptr_buffer_load_lds(rv, (LAS void*)(buf + KB + KRB + (wave * NVW + i) * 1024), 16, (i & 1) ? gvO : gvE, kt * 128 + (i >> 1) * (16 * 8192), 0, 0);
    }
};
template <int DQK> __device__ __forceinline__ void qk_tile2(const LAS unsigned char* kb, const bf16x8 (&qf)[DQK / 16], int lane_, f32x16 (&s)[2]) {
    int lane = lane_; asm volatile("" : "+v"(lane));
    const int h = lane >> 5, r = swz23(lane & 31), y = h ^ (r & 15), yr = h ^ ((r >> 1) & 7);
    const LAS unsigned char* p0 = kb + r * 256; const LAS unsigned char* pr = kb + 64 * 256 + r * 128;
    f32x16 a0, a1;
#pragma unroll
    for (int i = 0; i < 16; ++i) { a0[i] = 0.f; a1[i] = 0.f; }
    bf16x8 f[2][2];
#define QK2_LOAD(dst, kk) do { if ((kk) < 8) { const LAS unsigned char* q_ = p0 + ((y ^ (2 * (kk))) << 4); dst[0] = *(const LAS bf16x8*)q_; dst[1] = *(const LAS bf16x8*)(q_ + 32 * 256); } \
                               else { const LAS unsigned char* q_ = pr + ((yr ^ (2 * ((kk) - 8))) << 4); dst[0] = *(const LAS bf16x8*)q_; dst[1] = *(const LAS bf16x8*)(q_ + 32 * 128); } } while (0)
    QK2_LOAD(f[0], 0);
#pragma unroll
    for (int kk = 0; kk < DQK / 16; ++kk) {
        if (kk + 1 < DQK / 16) QK2_LOAD(f[(kk + 1) & 1], kk + 1);
        __builtin_amdgcn_sched_barrier(0);
        a0 = MFMA32(f[kk & 1][0], qf[kk], a0); a1 = MFMA32(f[kk & 1][1], qf[kk], a1);
        __builtin_amdgcn_sched_barrier(0);
    }
#undef QK2_LOAD
    s[0] = a0; s[1] = a1;
}
__device__ __forceinline__ float xmax_half(float v) {
    const unsigned u = __builtin_bit_cast(unsigned, v); const auto r = __builtin_amdgcn_permlane32_swap(u, u, false, false);
    return fmaxf(__builtin_bit_cast(float, r[0]), __builtin_bit_cast(float, r[1])); }
template <int DV> __device__ __forceinline__ void pv_tile2p(const LAS unsigned char* vb, const bf16x8 (&pf)[4], int lane_, f32x16 (&o)[DV / 32]) {
    int lane = lane_; asm volatile("" : "+v"(lane));
    const int h = lane >> 5, dr = swz23(lane & 31), yv = h ^ ((dr >> 1) & 7);
    const LAS unsigned char* q = vb + dr * 128;
    constexpr int NB = DV / 32, W = (DV == 256) ? 2 : 4, SPG = NB / W, NS = 4 * SPG;
    bf16x8 f[2][W];
#define PV2_LOAD(dst, st) do { const int g_ = (st) / SPG, b0_ = W * ((st) % SPG); const LAS unsigned char* q_ = q + ((yv ^ (2 * g_)) << 4) + b0_ * 4096; \
        _Pragma("unroll") for (int j = 0; j < W; ++j) dst[j] = *(const LAS bf16x8*)(q_ + j * 4096); } while (0)
    PV2_LOAD(f[0], 0);
#pragma unroll
    for (int st = 0; st < NS; ++st) {
        if (st + 1 < NS) PV2_LOAD(f[(st + 1) & 1], st + 1);
        __builtin_amdgcn_sched_barrier(0);
#pragma unroll
        for (int j = 0; j < W; ++j) o[W * (st % SPG) + j] = MFMA32(f[st & 1][j], pf[st / SPG], o[W * (st % SPG) + j]);
        __builtin_amdgcn_sched_barrier(0);
    }
#undef PV2_LOAD
}
template <int DV, bool ALIBI> __device__ __forceinline__ float softmax_step(f32x16 (&s)[2], bool past, float tb, float slope_l2, float& mrow, float& lrow, f32x16 (&o)[DV / 32], bf16x8 (&pf)[4]) {
    if (ALIBI) {
        if (past) {
#pragma unroll
            for (int blk = 0; blk < 2; ++blk)
#pragma unroll
                for (int i = 0; i < 16; ++i) s[blk][i] = fmaf(-slope_l2, tb - (float)(32 * blk + 16 * (i >> 3) + (i & 7)), s[blk][i]);
        } else {
#pragma unroll
            for (int blk = 0; blk < 2; ++blk)
#pragma unroll
                for (int i = 0; i < 16; ++i) s[blk][i] = fmaf(-slope_l2, fabsf(tb - (float)(32 * blk + 16 * (i >> 3) + (i & 7))), s[blk][i]); } }
    float mx = fmaxf(fmaxf(s[0][0], s[0][1]), s[1][0]);
#pragma unroll
    for (int i = 2; i < 16; i += 2) mx = fmaxf(fmaxf(mx, s[0][i]), s[0][i + 1]);
#pragma unroll
    for (int i = 1; i < 15; i += 2) mx = fmaxf(fmaxf(mx, s[1][i]), s[1][i + 1]);
    mx = fmaxf(mx, s[1][15]);
    mx = xmax_half(mx);
    const float mnew = fmaxf(mrow, mx), alpha = __builtin_amdgcn_exp2f(mrow - mnew); mrow = mnew;
    const f32x2v mn2 = {mnew, mnew}; f32x2v rs2 = {0.f, 0.f};
#pragma unroll
    for (int blk = 0; blk < 2; ++blk)
#pragma unroll
        for (int i = 0; i < 16; i += 2) { f32x2v x = {s[blk][i], s[blk][i + 1]}; x = x - mn2; x[0] = __builtin_amdgcn_exp2f(x[0]); x[1] = __builtin_amdgcn_exp2f(x[1]); rs2 = rs2 + x; s[blk][i] = x[0]; s[blk][i + 1] = x[1]; }
    lrow = lrow * alpha + (rs2[0] + rs2[1]);
#pragma unroll
    for (int db = 0; db < DV / 32; ++db) o[db] = o[db] * alpha;
#pragma unroll
    for (int g = 0; g < 4; ++g) pf[g] = pack8(s[g >> 1], g & 1);
    return alpha;
}
template <int DQK, int DV, bool ALIBI>
__device__ __forceinline__ void attn4_softmax_unit(LAS unsigned char* lds, const bf16* Q, int q_pitch, const bf16* K1, int k_pitch, const bf16* K2, const bf16* VT, float slope_l2, int q0,
                                                   int wave, int lane, f32x16 (&o)[DV / 32], float& l_out) {
    typedef DmaTile<DQK, DV> T;
    const int h = lane >> 5, t = q0 + 32 * wave + (lane & 31);
    bf16x8 qf[DQK / 16];
#pragma unroll
    for (int kk = 0; kk < DQK / 16; ++kk) qf[kk] = __builtin_bit_cast(bf16x8, *(const GAS v4u*)(Q + (size_t)t * q_pitch + 16 * kk + 8 * h));
#pragma unroll
    for (int db = 0; db < DV / 32; ++db)
#pragma unroll
        for (int i = 0; i < 16; ++i) o[db][i] = 0.f;
    float mrow = -INFINITY, lrow = 0.f;
    const int ntiles = (q0 >> 6) + 4, ktw = (q0 >> 6) + (wave >> 1);
    bf16x8 pf[4];
#pragma unroll
    for (int g = 0; g < 4; ++g) pf[g] = (bf16x8){0, 0, 0, 0, 0, 0, 0, 0};
    T tile; tile.init(K1, k_pitch, K2, VT, wave, lane); tile.issue(lds, 0, wave);
    asm volatile("s_waitcnt vmcnt(0) lgkmcnt(0)\n\ts_barrier" ::: "memory");
    int bi = 0;
#pragma unroll 1
    for (int kt = 0; kt < ntiles; ++kt) {
        const int bn = bi == 2 ? 0 : bi + 1, bp = bi == 0 ? 2 : bi - 1;
        const LAS unsigned char* kb = lds + bi * T::BUF;
        if (kt + 1 < ntiles) tile.issue(lds + bn * T::BUF, kt + 1, wave);
        const float tb = (float)(t - kt * 64 - 8 * h);
        const bool isB = wave >= 4;
        if (isB && kt >= 1 && kt - 1 <= ktw) pv_tile2p<DV>(lds + bp * T::BUF + T::KB + T::KRB, pf, lane, o);
        if (kt <= ktw) { f32x16 s[2]; qk_tile2<DQK>(kb, qf, lane, s); softmax_step<DV, ALIBI>(s, kt < ktw, tb, slope_l2, mrow, lrow, o, pf); }
        if (!isB && kt <= ktw) pv_tile2p<DV>(kb + T::KB + T::KRB, pf, lane, o);
        asm volatile("s_waitcnt vmcnt(0) lgkmcnt(0)\n\ts_barrier" ::: "memory");
        bi = bn;
    }
    if (wave >= 4 && ntiles - 1 <= ktw) pv_tile2p<DV>(lds + (bi == 0 ? 2 : bi - 1) * T::BUF + T::KB + T::KRB, pf, lane, o);
    asm volatile("s_waitcnt lgkmcnt(0)\n\ts_barrier" ::: "memory");
    l_out = lrow + xhalf(lrow);
}
constexpr int PC_FLG = 136192;
template <bool ALIBI> __device__ __forceinline__ float softmax_step_p(f32x16 (&s)[2], bool past, float tb, float slope_l2, float& mrow, float& lrow, bf16x8 (&pf)[4]) {
    if (ALIBI) {
        if (past) {
#pragma unroll
            for (int blk = 0; blk < 2; ++blk)
#pragma unroll
                for (int i = 0; i < 16; ++i) s[blk][i] = fmaf(-slope_l2, tb - (float)(32 * blk + 16 * (i >> 3) + (i & 7)), s[blk][i]);
        } else {
#pragma unroll
            for (int blk = 0; blk < 2; ++blk)
#pragma unroll
                for (int i = 0; i < 16; ++i) s[blk][i] = fmaf(-slope_l2, fabsf(tb - (float)(32 * blk + 16 * (i >> 3) + (i & 7))), s[blk][i]); } }
    float mx = fmaxf(fmaxf(s[0][0], s[0][1]), s[1][0]);
#pragma unroll
    for (int i = 2; i < 16; i += 2) mx = fmaxf(fmaxf(mx, s[0][i]), s[0][i + 1]);
#pragma unroll
    for (int i = 1; i < 15; i += 2) mx = fmaxf(fmaxf(mx, s[1][i]), s[1][i + 1]);
    mx = fmaxf(mx, s[1][15]);
    mx = xmax_half(mx);
    const float mnew = fmaxf(mrow, mx), alpha = __builtin_amdgcn_exp2f(mrow - mnew); mrow = mnew;
    const f32x2v mn2 = {mnew, mnew}; f32x2v rs2 = {0.f, 0.f};
#pragma unroll
    for (int blk = 0; blk < 2; ++blk)
#pragma unroll
        for (int i = 0; i < 16; i += 2) { f32x2v x = {s[blk][i], s[blk][i + 1]}; x = x - mn2; x[0] = __builtin_amdgcn_exp2f(x[0]); x[1] = __builtin_amdgcn_exp2f(x[1]); rs2 = rs2 + x; s[blk][i] = x[0]; s[blk][i + 1] = x[1]; }
    lrow = lrow * alpha + (rs2[0] + rs2[1]);
#pragma unroll
    for (int g = 0; g < 4; ++g) pf[g] = pack8(s[g >> 1], g & 1);
    return alpha;
}
__device__ __forceinline__ void pv_tile256_deep(const LAS unsigned char* vb, const bf16x8 (&pf)[4], int lane_, f32x16 (&o)[8]) {
    int lane = lane_; asm volatile("" : "+v"(lane));
    const int h = lane >> 5, dr = swz23(lane & 31), yv = h ^ ((dr >> 1) & 7);
    const LAS unsigned char* q = vb + dr * 128;
    bf16x8 f[3][4];
#define PVD_LOAD(dst, st) do { const int g_ = (st) >> 1, b0_ = 4 * ((st) & 1); const LAS unsigned char* q_ = q + ((yv ^ (2 * g_)) << 4) + b0_ * 4096; \
        _Pragma("unroll") for (int j = 0; j < 4; ++j) dst[j] = *(const LAS bf16x8*)(q_ + j * 4096); } while (0)
    PVD_LOAD(f[0], 0); PVD_LOAD(f[1], 1);
#pragma unroll
    for (int st = 0; st < 8; ++st) {
        if (st + 2 < 8) PVD_LOAD(f[(st + 2) % 3], st + 2);
        __builtin_amdgcn_sched_barrier(0);
#pragma unroll
        for (int j = 0; j < 4; ++j) o[4 * (st & 1) + j] = MFMA32(f[st % 3][j], pf[st >> 1], o[4 * (st & 1) + j]);
        __builtin_amdgcn_sched_barrier(0);
    }
#undef PVD_LOAD
}
__device__ __forceinline__ void qk_tile128_deep(const LAS unsigned char* kb, const bf16x8 (&qf)[8], int lane_, f32x16 (&s)[2]) {
    int lane = lane_; asm volatile("" : "+v"(lane));
    const int h = lane >> 5, r = swz23(lane & 31), y = h ^ (r & 15);
    const LAS unsigned char* p0 = kb + r * 256;
    f32x16 a0, a1;
#pragma unroll
    for (int i = 0; i < 16; ++i) { a0[i] = 0.f; a1[i] = 0.f; }
    bf16x8 f[4][2];
#define QKD_LOAD(dst, kk) do { const LAS unsigned char* q_ = p0 + ((y ^ (2 * (kk))) << 4); dst[0] = *(const LAS bf16x8*)q_; dst[1] = *(const LAS bf16x8*)(q_ + 32 * 256); } while (0)
    QKD_LOAD(f[0], 0); QKD_LOAD(f[1], 1); QKD_LOAD(f[2], 2);
#pragma unroll
    for (int kk = 0; kk < 8; ++kk) {
        if (kk + 3 < 8) QKD_LOAD(f[(kk + 3) & 3], kk + 3);
        __builtin_amdgcn_sched_barrier(0);
        a0 = MFMA32(f[kk & 3][0], qf[kk], a0); a1 = MFMA32(f[kk & 3][1], qf[kk], a1);
        __builtin_amdgcn_sched_barrier(0);
    }
#undef QKD_LOAD
    s[0] = a0; s[1] = a1;
}
constexpr int PE_K = 0, PE_V = 32768, PE_P = 98304, PE_PBLK = 4352, PE_L = 133120, PE_FLG = 135168;
__device__ __forceinline__ void diff_unit_pc4(LAS unsigned char* lds, unsigned char* ws, const float* subln, float lam, const unsigned* kmaxw, int bh, int qb128, int wave, int lane) {
    const int b = bh >> 4, hd = bh & 15, q0 = qb128 * 128, h = lane >> 5, rg = wave & 3; const bool isA = wave < 4;
    const int t = q0 + 32 * rg + (lane & 31);
    const int ntiles = (q0 >> 6) + 2, ktw = (q0 >> 6) + (rg >> 1), kt_hi = ntiles - 1;
    const float slope_l2 = __builtin_amdgcn_exp2f(-0.5f * (float)(hd + 1)) * 1.4426950408889634f;
    const bf16* VT = (const bf16*)(ws + WS_CVT) + (size_t)bh * 256 * 4096;
    const __amdgpu_buffer_rsrc_t rv = __builtin_amdgcn_make_buffer_rsrc((void*)VT, 0, 0x7fffffff, 0x00020000);
    volatile LAS unsigned* flg = (volatile LAS unsigned*)(lds + PE_FLG);
    unsigned gk0, gk1, gvE, gvO;
    { const int p = lane & 15, ra = 8 * wave + (lane >> 4), rb = ra + 4; gk0 = (unsigned)(ra * 8192 + ((p ^ (ra & 15)) << 4)); gk1 = (unsigned)(rb * 8192 + ((p ^ (rb & 15)) << 4)); }
    { const int p = lane & 7, l3 = lane >> 3, d0 = 32 * wave + l3; gvE = (unsigned)(d0 * 8192 + ((p ^ (l3 >> 1)) << 4)); gvO = (unsigned)((d0 + 8) * 8192 + ((p ^ (4 + (l3 >> 1))) << 4)); }
#define PE_ISSUE_K(kt_, ib_) do { LAS unsigned char* d_ = lds + PE_K + ((ib_) & 1) * 16384 + wave * 2048; \
    __builtin_amdgcn_raw_ptr_buffer_load_lds(rk, (LAS void*)d_, 16, gk0, (kt_) * 64 * 8192, 0, 0); __builtin_amdgcn_raw_ptr_buffer_load_lds(rk, (LAS void*)(d_ + 1024), 16, gk1, (kt_) * 64 * 8192, 0, 0); } while (0)
#define PE_ISSUE_V(kt_, ib_) do { LAS unsigned char* d_ = lds + PE_V + ((ib_) & 1) * 32768 + wave * 4096; \
    __builtin_amdgcn_raw_ptr_buffer_load_lds(rv, (LAS void*)d_, 16, gvE, (kt_) * 128, 0, 0); __builtin_amdgcn_raw_ptr_buffer_load_lds(rv, (LAS void*)(d_ + 1024), 16, gvO, (kt_) * 128, 0, 0); \
    __builtin_amdgcn_raw_ptr_buffer_load_lds(rv, (LAS void*)(d_ + 2048), 16, gvE, (kt_) * 128 + 16 * 8192, 0, 0); __builtin_amdgcn_raw_ptr_buffer_load_lds(rv, (LAS void*)(d_ + 3072), 16, gvO, (kt_) * 128 + 16 * 8192, 0, 0); } while (0)
#define PE_BAR() asm volatile("s_waitcnt vmcnt(0) lgkmcnt(0)\n\ts_barrier" ::: "memory")
#define PE_FIN(it_) ((flg[((it_) & 1) * 8 + 4] & flg[((it_) & 1) * 8 + 5] & flg[((it_) & 1) * 8 + 6] & flg[((it_) & 1) * 8 + 7]) != 0u)
#pragma unroll 1
    for (int mp = 0; mp < 2; ++mp) {
        const bf16* K1 = (const bf16*)(ws + WS_CK1) + (size_t)b * SEQ * 4096 + (2 * hd + mp) * 128;
        const __amdgpu_buffer_rsrc_t rk = __builtin_amdgcn_make_buffer_rsrc((void*)K1, 0, 0x7fffffff, 0x00020000);
        if (isA) {
            const bf16* Q = (const bf16*)(ws + WS_CQ1) + (size_t)b * SEQ * 4096 + (2 * hd + mp) * 128;
            const __amdgpu_buffer_rsrc_t rq = __builtin_amdgcn_make_buffer_rsrc((void*)Q, 0, 0x7fffffff, 0x00020000); const int qoff = t * 8192 + h * 16;
            bf16x8 qf[8];
#pragma unroll
            for (int kk = 0; kk < 8; ++kk) qf[kk] = __builtin_bit_cast(bf16x8, __builtin_amdgcn_raw_buffer_load_b128(rq, qoff, 32 * kk, 0));
            float bq;
            { float qn = 0.f;
#pragma unroll
              for (int kk = 0; kk < 8; ++kk) { const v4u w = __builtin_bit_cast(v4u, qf[kk]); qn += bflo(w.x) * bflo(w.x) + bfhi(w.x) * bfhi(w.x) + bflo(w.y) * bflo(w.y) + bfhi(w.y) * bfhi(w.y) + bflo(w.z) * bflo(w.z) + bfhi(w.z) * bfhi(w.z) + bflo(w.w) * bflo(w.w) + bfhi(w.w) * bfhi(w.w); }
              qn += xhalf(qn);
              const unsigned* km = kmaxw + ((b * 32 + 2 * hd + mp) * 4);
              const float k2 = (__builtin_bit_cast(float, km[0]) + __builtin_bit_cast(float, km[1])) + (__builtin_bit_cast(float, km[2]) + __builtin_bit_cast(float, km[3]));
              bq = sqrtf(qn * k2 * 1.03f) + 1.f; }
            float mrow = -INFINITY, lrow = 0.f; bool mydone = false, fin = false;
            PE_ISSUE_K(kt_hi, 0);
            PE_BAR();
#pragma unroll 1
            for (int it = 0, kt = kt_hi; ; ++it, --kt) {
                if (!fin) { if (kt >= 1) PE_ISSUE_K(kt - 1, it + 1); if (kt >= 0) PE_ISSUE_V(kt, it); }
                bool pub = false;
                if (!fin && kt >= 0 && kt <= ktw && !mydone) {
                    f32x16 s[2]; bf16x8 pf[4]; qk_tile128_deep(lds + PE_K + (it & 1) * 16384, qf, lane, s);
                    const float alpha = softmax_step_p<true>(s, kt < ktw, (float)(t - kt * 64 - 8 * h), slope_l2, mrow, lrow, pf);
                    LAS unsigned char* pb = lds + PE_P + ((it & 1) * 4 + rg) * PE_PBLK;
#pragma unroll
                    for (int g = 0; g < 4; ++g) *(LAS bf16x8*)(pb + g * 1024 + lane * 16) = pf[g];
                    *(LAS float*)(pb + 4096 + lane * 4) = alpha;
                    pub = true;
                    mydone = __all(bq - slope_l2 * (float)(t - 64 * kt + 1) - mrow < -150.f);
                }
                if (lane == 0) { flg[(it & 1) * 8 + rg] = pub ? 1u : 0u; flg[(it & 1) * 8 + 4 + rg] = (mydone || kt <= 0) ? 1u : 0u; }
                PE_BAR();
                if (fin) break;
                fin = PE_FIN(it);
            }
            { const float lt = lrow + xhalf(lrow); *(LAS float*)(lds + PE_L + (mp * 4 + rg) * 256 + lane * 4) = lt; }
            PE_BAR();
        } else {
            f32x16 o[8];
#pragma unroll
            for (int db = 0; db < 8; ++db)
#pragma unroll
                for (int i = 0; i < 16; ++i) o[db][i] = 0.f;
            bool fin = false;
            PE_ISSUE_K(kt_hi, 0);
            PE_BAR();
#pragma unroll 1
            for (int it = 0, kt = kt_hi; ; ++it, --kt) {
                if (!fin) { if (kt >= 1) PE_ISSUE_K(kt - 1, it + 1); if (kt >= 0) PE_ISSUE_V(kt, it); }
                if (it >= 1 && flg[((it - 1) & 1) * 8 + rg] != 0u) {
                    const LAS unsigned char* pb = lds + PE_P + (((it - 1) & 1) * 4 + rg) * PE_PBLK; bf16x8 pf[4];
#pragma unroll
                    for (int g = 0; g < 4; ++g) pf[g] = *(const LAS bf16x8*)(pb + g * 1024 + lane * 16);
                    const float alpha = *(const LAS float*)(pb + 4096 + lane * 4);
#pragma unroll
                    for (int db = 0; db < 8; ++db) o[db] = o[db] * alpha;
                    pv_tile256_deep(lds + PE_V + ((it - 1) & 1) * 32768, pf, lane, o);
                }
                PE_BAR();
                if (fin) break;
                fin = PE_FIN(it);
            }
            { const __amdgpu_buffer_rsrc_t rds = __builtin_amdgcn_make_buffer_rsrc((void*)(ws + (mp ? WS_DS1 : WS_DS)), 0, 0x7fffffff, 0x00020000);
              const int dso = (((b * SEQ + t) * 16 + hd) * 256 + 8 * h) * 4;
#pragma unroll
              for (int db = 0; db < 8; ++db)
#pragma unroll
                  for (int c = 0; c < 2; ++c) { f32x4 a, bq;
#pragma unroll
                      for (int e = 0; e < 4; ++e) { a[e] = o[db][8 * c + e]; bq[e] = o[db][8 * c + 4 + e]; }
                      __builtin_amdgcn_raw_buffer_store_b128(__builtin_bit_cast(v4u, a), rds, dso, (32 * db + 16 * c) * 4, 0); __builtin_amdgcn_raw_buffer_store_b128(__builtin_bit_cast(v4u, bq), rds, dso, (32 * db + 16 * c + 4) * 4, 0); } }
            PE_BAR();
        }
    }
    {   const float* S0 = (const float*)(ws + WS_DS); const float* S1 = (const float*)(ws + WS_DS1); bf16* O = (bf16*)(ws + WS_O);
        const f32x4 g4 = *(const GAS f32x4*)(subln + 4 * lane);
#pragma unroll 2
        for (int rr = 0; rr < 16; ++rr) { const int r = 16 * wave + rr; const size_t row = (size_t)b * SEQ + q0 + r;
            const float l0 = *(const LAS float*)(lds + PE_L + (0 * 4 + (r >> 5)) * 256 + (r & 31) * 4), l1 = *(const LAS float*)(lds + PE_L + (1 * 4 + (r >> 5)) * 256 + (r & 31) * 4);
            const f32x4 a = *(const GAS f32x4*)(S0 + (row * 16 + hd) * 256 + 4 * lane), c = *(const GAS f32x4*)(S1 + (row * 16 + hd) * 256 + 4 * lane);
            const float i0 = 1.f / l0, i1 = lam / l1;
            const f32x4 x = a * i0 - c * i1;
            const float ss = wave_sum((x[0] * x[0] + x[1] * x[1]) + (x[2] * x[2] + x[3] * x[3]));
            const float rn = rsqrtf(ss * (1.f / 256.f) + EPS) * (1.f - LAMBDA_INIT);
            const f32x4 y = x * rn * g4;
            *(GAS unsigned long long*)(O + row * 4096 + hd * 256 + 4 * lane) = (unsigned long long)pkbf(y[0], y[1]) | ((unsigned long long)pkbf(y[2], y[3]) << 32); }
    }
    PE_BAR();
#undef PE_ISSUE_K
#undef PE_ISSUE_V
#undef PE_BAR
#undef PE_FIN
}
__device__ __forceinline__ void mla_unit2(LAS unsigned char* lds, unsigned char* ws, int bh, int qb, int wave, int lane) {
    const int b = bh >> 4, hd = bh & 15, q0 = qb * 256;
    const bf16* Q = (const bf16*)(ws + WS_QA) + (size_t)b * SEQ * 3072 + hd * 192;
    const bf16* K1 = (const bf16*)(ws + WS_KN) + (size_t)b * SEQ * 2048 + hd * 128;
    const bf16* K2 = (const bf16*)(ws + WS_KR) + (size_t)b * SEQ * 64;
    const bf16* VT = (const bf16*)(ws + WS_VAT) + (size_t)bh * 128 * 4096;
    f32x16 o[4]; float l;
    attn4_softmax_unit<192, 128, false>(lds, Q, 3072, K1, 2048, K2, VT, 0.f, q0, wave, lane, o, l);
    const float il = 1.f / l; const int t = q0 + 32 * wave + (lane & 31), h = lane >> 5;
    bf16* orow = (bf16*)(ws + WS_O) + (size_t)(b * SEQ + t) * 4096 + hd * 128 + 8 * h;
#pragma unroll
    for (int db = 0; db < 4; ++db) { store_o8(orow + 32 * db, o[db], 0, il); store_o8(orow + 32 * db + 16, o[db], 1, il); }
}

template <int MAP> __device__ __forceinline__ int dst_row(int n) {
    if (MAP == 1) {
        if (n < 1536) return n;
        if (n < 1600) { const int i = n - 1536; return 1536 + (i < 32 ? 2 * i : 2 * (i - 32) + 1); }
        return n + 192; }
    if (MAP == 2) {
        const int h = n / 192, j = n - h * 192; if (j < 128) return n; const int r = j - 128; return h * 192 + 128 + (r < 32 ? 2 * r : 2 * (r - 32) + 1); }
    if (MAP == 3) {
        const int h = n >> 8, j = n & 255; return j < 128 ? h * 128 + j : 2048 + h * 128 + (j - 128); }
    if (MAP == 4) {
        const int c = n < 11008 ? n : n - 11008; return (c >> 7) * 256 + (n < 11008 ? 0 : 128) + (c & 127); }
    return n;
}
struct TItem { f32x4 v[8]; };
template <int MAP> __device__ __forceinline__ void transpose_load(TItem& it, const float* W, int K, int N, const float* gain, int item, int lane) {
    const int nblk = N / 32, kb = item / nblk, nb = item - kb * nblk, k0 = 64 * kb, n0 = 32 * nb; const int nq = lane & 7, kq = lane >> 3;
#pragma unroll
    for (int i = 0; i < 8; ++i) { const int kk = 8 * i + kq; const f32x4 v = *(const GAS f32x4*)(W + (size_t)(k0 + kk) * N + n0 + 4 * nq); const float g = gain ? gain[k0 + kk] : 1.f; it.v[i] = v * g; }
}
template <int MAP> __device__ __forceinline__ void transpose_finish(const TItem& it, int K, int N, bf16* WT, LAS float* scr, int item, int lane) {
    const int nblk = N / 32, kb = item / nblk, nb = item - kb * nblk, k0 = 64 * kb, n0 = 32 * nb; const int nq = lane & 7, kq = lane >> 3;
#pragma unroll
    for (int i = 0; i < 8; ++i) { const int kk = 8 * i + kq; LAS float* d = scr + kk * 33 + 4 * nq; d[0] = it.v[i][0]; d[1] = it.v[i][1]; d[2] = it.v[i][2]; d[3] = it.v[i][3]; }
    LDS_WAIT(); asm volatile("" ::: "memory");
    const int c = lane & 7;
#pragma unroll
    for (int p = 0; p < 4; ++p) { const int n = (lane >> 3) + 8 * p; const LAS float* s = scr + (8 * c) * 33 + n;
        v4u o; o.x = pkbf(s[0 * 33], s[1 * 33]); o.y = pkbf(s[2 * 33], s[3 * 33]); o.z = pkbf(s[4 * 33], s[5 * 33]); o.w = pkbf(s[6 * 33], s[7 * 33]);
        *(GAS v4u*)(WT + (size_t)dst_row<MAP>(n0 + n) * K + k0 + 8 * c) = o; }
    LDS_WAIT(); asm volatile("" ::: "memory");
}
template <int MAP> __device__ __forceinline__ void transpose_matrix(const float* W, int K, int N, const float* gain, bf16* WT, LAS float* scr, int first, int n_items, int NGW, int lane) {
    if (first >= n_items) return;
    TItem cur, nxt; transpose_load<MAP>(cur, W, K, N, gain, first, lane);
    for (int it = first; it < n_items; it += NGW) {
        const bool more = it + NGW < n_items;
        if (more) transpose_load<MAP>(nxt, W, K, N, gain, it + NGW, lane);
        transpose_finish<MAP>(cur, K, N, WT, scr, it, lane);
        if (more) cur = nxt;
    }
}
struct P {
    const float *x, *norm_mix, *norm_ffn, *norm_final, *ab_w_in, *ab_q_norm, *ab_w_uq, *ab_kv_norm, *ab_w_ukv, *ab_w_out, *c_w_in, *lq1, *lk1, *lq2, *lk2, *subln, *c_w_out, *w_up, *conv_w, *conv_b, *w_down;
    float* out; unsigned char* ws;
};

typedef const __attribute__((address_space(4))) P* KP;
__device__ __forceinline__ KP kargs() { KP k = (KP)__builtin_amdgcn_kernarg_segment_ptr(); asm volatile("" : "+s"(k)); return k; }
__device__ __forceinline__ void p0_prologue(KP pp, LAS unsigned char* lds, int gw, int NGW, int wave, int lane) {
    unsigned char* ws = pp->ws;
    LAS float* scr = (LAS float*)(lds + wave * 8448);
    constexpr int I_ABIN = 64 * 242, I_UQ = 16 * 96, I_UKV = 8 * 128, I_SQ = 64 * 128, I_CIN = 64 * 384, I_UP = 64 * 688, I_DN = 172 * 128;
    constexpr int NITEMS = I_ABIN + I_UQ + I_UKV + 2 * I_SQ + I_CIN + 2 * I_UP + 2 * I_DN;
    (void)NITEMS;
    { int off = gw;
#define TM(MAP_, W_, K_, N_, G_, WT_, NI_) do { transpose_matrix<MAP_>(W_, K_, N_, G_, (bf16*)(ws + WT_), scr, off, NI_, NGW, lane); off = (off + NGW - (NI_) % NGW) % NGW; } while (0)
      TM(4, pp->w_up, 4096, FF2, pp->norm_ffn, WS_WUP0, I_UP);
      TM(4, pp->w_up + (size_t)4096 * FF2, 4096, FF2, pp->norm_ffn + 4096, WS_WUP1, I_UP);
      TM(0, pp->w_down, FF, 4096, nullptr, WS_WDN0, I_DN);
      TM(0, pp->w_down + (size_t)FF * 4096, FF, 4096, nullptr, WS_WDN1, I_DN);
      TM(0, pp->c_w_in, 4096, 12288, pp->norm_mix + 4096, WS_WCIN, I_CIN);
      TM(1, pp->ab_w_in, 4096, 7744, pp->norm_mix, WS_WABIN, I_ABIN);
      TM(0, pp->ab_w_out, 4096, 4096, nullptr, WS_WABOUT, I_SQ);
      TM(0, pp->c_w_out, 4096, 4096, nullptr, WS_WCOUT, I_SQ);
      TM(2, pp->ab_w_uq, 1024, 3072, pp->ab_q_norm, WS_WUQ, I_UQ);
      TM(3, pp->ab_w_ukv, 512, 4096, pp->ab_kv_norm, WS_WUKV, I_UKV);
#undef TM
    }
    { GAS v4u* z = (GAS v4u*)((bf16*)(ws + WS_WABIN) + (size_t)1600 * 4096);
      for (int i = gw * 64 + lane; i < 192 * 4096 / 8; i += NGW * 64) z[i] = (v4u){0u, 0u, 0u, 0u}; }
    { float* rc = (float*)(ws + WS_ROPE); float* rs = rc + 4096 * 32;
      for (int i = gw * 64 + lane; i < 4096 * 32; i += NGW * 64) { const int pos = i >> 5, k = i & 31; const float inv = exp2f(-(float)k * (13.287712379549449f / 32.f)); float s, c; sincosf((float)pos * inv, &s, &c); rc[i] = c; rs[i] = s; } }
    { bf16* HB = (bf16*)(ws + WS_HB); unsigned long long* ss0 = (unsigned long long*)(ws + WS_SS);
      for (int m = gw; m < M; m += NGW) { const GAS f32x4* xr = (const GAS f32x4*)(pp->x + (size_t)m * DM) + lane; GAS unsigned long long* o8 = (GAS unsigned long long*)(HB + (size_t)m * DM) + lane; float s = 0.f;
#pragma unroll
          for (int j = 0; j < 16; ++j) { const f32x4 v = xr[64 * j]; s += (v[0] * v[0] + v[1] * v[1]) + (v[2] * v[2] + v[3] * v[3]); o8[64 * j] = (unsigned long long)pkbf(v[0], v[1]) | ((unsigned long long)pkbf(v[2], v[3]) << 32); }
          s = wave_sum(s); if (lane == 0) ss0[m] = (unsigned long long)(s * 4294967296.f); } }
}

__device__ __forceinline__ void conv_act_phase(const unsigned char* ws_c, unsigned char* ws, const float* cw, const float* cb, int gtid, int nthr) {
    const bf16* UP = (const bf16*)(ws_c + WS_UP); bf16* ACT = (bf16*)(ws + WS_ACT);
    constexpr int NCG = FF / 8, NITEM = (M / 32) * NCG;
    for (int it0 = gtid; it0 < NITEM; it0 += nthr) { const int it = NITEM - 1 - it0, cg = it % NCG, rsg = it / NCG, c0 = cg * 8, r0 = rsg * 32;
        float wg[3][8], wu[3][8], bg[8], bu[8];
#pragma unroll
        for (int j = 0; j < 3; ++j)
#pragma unroll
            for (int e = 0; e < 8; ++e) { wg[j][e] = cw[j * FF2 + c0 + e]; wu[j][e] = cw[j * FF2 + FF + c0 + e]; }
#pragma unroll
        for (int e = 0; e < 8; ++e) { bg[e] = cb[c0 + e]; bu[e] = cb[FF + c0 + e]; }
        float g1[8], g2[8], u1[8], u2[8];
        const bool first = (r0 & 4095) == 0;
        { v4u a = (v4u){0u, 0u, 0u, 0u}, b2 = a, c = a, d = a;
          if (!first) { a = *(const GAS v4u*)(UP + (size_t)(r0 - 1) * FF2 + c0); b2 = *(const GAS v4u*)(UP + (size_t)(r0 - 2) * FF2 + c0); c = *(const GAS v4u*)(UP + (size_t)(r0 - 1) * FF2 + FF + c0); d = *(const GAS v4u*)(UP + (size_t)(r0 - 2) * FF2 + FF + c0); }
          g1[0] = bflo(a.x); g1[1] = bfhi(a.x); g1[2] = bflo(a.y); g1[3] = bfhi(a.y); g1[4] = bflo(a.z); g1[5] = bfhi(a.z); g1[6] = bflo(a.w); g1[7] = bfhi(a.w);
          g2[0] = bflo(b2.x); g2[1] = bfhi(b2.x); g2[2] = bflo(b2.y); g2[3] = bfhi(b2.y); g2[4] = bflo(b2.z); g2[5] = bfhi(b2.z); g2[6] = bflo(b2.w); g2[7] = bfhi(b2.w);
          u1[0] = bflo(c.x); u1[1] = bfhi(c.x); u1[2] = bflo(c.y); u1[3] = bfhi(c.y); u1[4] = bflo(c.z); u1[5] = bfhi(c.z); u1[6] = bflo(c.w); u1[7] = bfhi(c.w);
          u2[0] = bflo(d.x); u2[1] = bfhi(d.x); u2[2] = bflo(d.y); u2[3] = bfhi(d.y); u2[4] = bflo(d.z); u2[5] = bfhi(d.z); u2[6] = bflo(d.w); u2[7] = bfhi(d.w); }
#pragma unroll 4
        for (int r = r0; r < r0 + 32; ++r) {
            const v4u a = *(const GAS v4u*)(UP + (size_t)r * FF2 + c0), c = *(const GAS v4u*)(UP + (size_t)r * FF2 + FF + c0);
            float g0[8], u0[8], o[8];
            g0[0] = bflo(a.x); g0[1] = bfhi(a.x); g0[2] = bflo(a.y); g0[3] = bfhi(a.y); g0[4] = bflo(a.z); g0[5] = bfhi(a.z); g0[6] = bflo(a.w); g0[7] = bfhi(a.w);
            u0[0] = bflo(c.x); u0[1] = bfhi(c.x); u0[2] = bflo(c.y); u0[3] = bfhi(c.y); u0[4] = bflo(c.z); u0[5] = bfhi(c.z); u0[6] = bflo(c.w); u0[7] = bfhi(c.w);
#pragma unroll
            for (int e = 0; e < 8; ++e) { const float gv = wg[0][e] * g2[e] + wg[1][e] * g1[e] + wg[2][e] * g0[e] + bg[e], uv = wu[0][e] * u2[e] + wu[1][e] * u1[e] + wu[2][e] * u0[e] + bu[e];
                o[e] = gv / (1.f + __expf(-gv)) * uv; g2[e] = g1[e]; g1[e] = g0[e]; u2[e] = u1[e]; u1[e] = u0[e]; }
            v4u w; w.x = pkbf(o[0], o[1]); w.y = pkbf(o[2], o[3]); w.z = pkbf(o[4], o[5]); w.w = pkbf(o[6], o[7]);
            *(GAS v4u*)(ACT + (size_t)r * FF + c0) = w; }
    }
}
__device__ __forceinline__ void conv_fixup_panel(unsigned char* ws, const float* cw, const float* cb, int pm, int tid) {
    const float* HEAD = (const float*)(ws + WS_HEAD) + (size_t)pm * 4 * 11008; const float* TAIL = (const float*)(ws + WS_TAIL) + (size_t)(pm - 1) * 4 * 11008; bf16* ACT = (bf16*)(ws + WS_ACT);
    const bool first = (pm & 15) == 0;
    for (int c = tid; c < FF; c += NWAVES * 64) {
        float tg[2], tu[2], hg[2], hu[2];
#pragma unroll
        for (int j = 0; j < 2; ++j) { tg[j] = first ? 0.f : TAIL[(j * 2 + 0) * 11008 + c]; tu[j] = first ? 0.f : TAIL[(j * 2 + 1) * 11008 + c]; hg[j] = HEAD[(j * 2 + 0) * 11008 + c]; hu[j] = HEAD[(j * 2 + 1) * 11008 + c]; }
        const float g0 = cw[c], g1 = cw[FF2 + c], g2 = cw[2 * FF2 + c], u0 = cw[FF + c], u1 = cw[FF2 + FF + c], u2 = cw[2 * FF2 + FF + c], bg = cb[c], bu = cb[FF + c];
        { const float gv = g0 * tg[0] + g1 * tg[1] + g2 * hg[0] + bg, uv = u0 * tu[0] + u1 * tu[1] + u2 * hu[0] + bu; ACT[(size_t)(pm * 256) * FF + c] = (bf16)f2bf(gv / (1.f + __expf(-gv)) * uv); }
        { const float gv = g0 * tg[1] + g1 * hg[0] + g2 * hg[1] + bg, uv = u0 * tu[1] + u1 * hu[0] + u2 * hu[1] + bu; ACT[(size_t)(pm * 256 + 1) * FF + c] = (bf16)f2bf(gv / (1.f + __expf(-gv)) * uv); }
    }
}
__device__ __forceinline__ void final_norm_phase(float* out, const float* g, int gw, int NGW, int lane) {
    for (int m = gw; m < M; m += NGW) { GAS f32x4* xr = (GAS f32x4*)(out + (size_t)m * DM) + lane; f32x4 v[16]; float s = 0.f;
#pragma unroll
        for (int j = 0; j < 16; ++j) { v[j] = xr[64 * j]; s += (v[j][0] * v[j][0] + v[j][1] * v[j][1]) + (v[j][2] * v[j][2] + v[j][3] * v[j][3]); }
        const float rn = rsqrtf(wave_sum(s) * (1.f / DM) + EPS);
#pragma unroll
        for (int j = 0; j < 16; ++j) { const f32x4 gg = *((const GAS f32x4*)g + lane + 64 * j); xr[64 * j] = v[j] * rn * gg; } }
}

struct Args { P p; int ph_lo, ph_hi; };
static_assert(sizeof(Args) == 23 * 8 + 8, "Args has no padding");
__global__ void __launch_bounds__(NWAVES * 64, 2) fwd_kernel(Args args) {
    extern __shared__ __attribute__((aligned(16))) unsigned char lds_raw[];
    LAS unsigned char* lds = (LAS unsigned char*)lds_raw;
    volatile LAS unsigned* MISC = (volatile LAS unsigned*)(lds + MISC_OFF);
    const int tid = threadIdx.x, lane = tid & 63, wave = __builtin_amdgcn_readfirstlane(tid >> 6);
    const int G = gridDim.x, gw = blockIdx.x * NWAVES + wave, NGW = G * NWAVES;
    unsigned char* ws = kargs()->ws;
    gu32* ctl = (gu32*)(ws + WS_CTL);
    for (int u = tid; u < (LDS_BYTES - LDSCTL_OFF) / 4; u += NWAVES * 64) ((LAS unsigned*)(lds + LDSCTL_OFF))[u] = 0u;
    __syncthreads();
#if MK_ONE_LAUNCH
    XcdBarrier bar = xcd_barrier_post((unsigned*)(ctl + CW_BAR), MISC + 8);
#define GRID_BAR() xcd_barrier(bar)
#else
    (void)MISC; (void)ctl;
#define GRID_BAR() do { } while (0)
#endif
    const int lo = args.ph_lo, hi = args.ph_hi;
#ifndef PHASE_MASK
#define PHASE_MASK 0x7fff
#endif
#define IN(k) (((PHASE_MASK >> (k)) & 1) && lo <= (k) && (k) < hi)
#ifndef REPEAT_PHASE
#define REPEAT_PHASE -1
#endif
#define REP(k) for (int rep_ = 0; rep_ < ((REPEAT_PHASE == (k)) ? 2 : 1); ++rep_)
#define SEAM(k) do { if (IN(k) && IN((k) + 1)) GRID_BAR(); } while (0)
    pg8::u64_t* SS = (pg8::u64_t*)(ws + WS_SS);
    pg8::u64_t *ss0 = SS, *ss1 = SS + 8192, *ss2 = SS + 2 * 8192, *ss3 = SS + 3 * 8192, *ssq = SS + 5 * 8192, *sskv = SS + 6 * 8192;
    const float* rc = (const float*)(ws + WS_ROPE); const float* rs = rc + 4096 * 32;
    bf16* HB = (bf16*)(ws + WS_HB); float* H = (float*)(ws + WS_H); bf16* OB = (bf16*)(ws + WS_O);

    if (IN(0)) REP(0) { p0_prologue(kargs(), lds, gw, NGW, wave, lane); __syncthreads(); }
    SEAM(0);
    if (IN(1)) REP(1) { pg8::Gemm g{HB, (const bf16*)(ws + WS_WABIN), M, NAB, 4096}; pg8::StaticOrder S; S.init(M, NAB, G, (int)blockIdx.x);
        pg8::EpiABIn E{ss0, (bf16*)(ws + WS_CQ), (bf16*)(ws + WS_CKV), (bf16*)(ws + WS_KR), (bf16*)(ws + WS_SBQ), (bf16*)(ws + WS_SBK), (bf16*)(ws + WS_SBVT), ssq, sskv, rc, rs};
        pg8::gemm_phase<pg8::EpiABIn, pg8::StaticOrder, true, true>(lds + RING_OFF, g, S, E); }
    SEAM(1);
    if (IN(2)) REP(2) {
        { pg8::Gemm g{(const bf16*)(ws + WS_CQ), (const bf16*)(ws + WS_WUQ), M, 3072, 1024}; pg8::StaticOrder S; S.init(M, 3072, G, (int)blockIdx.x);
          pg8::EpiUQ E{ssq, (bf16*)(ws + WS_QA), rc, rs};
          pg8::gemm_phase<pg8::EpiUQ, pg8::StaticOrder, true, true>(lds + RING_OFF, g, S, E); }
        { pg8::Gemm g{(const bf16*)(ws + WS_CKV), (const bf16*)(ws + WS_WUKV), M, 4096, 512}; pg8::StaticOrder S; S.init(M, 4096, G, (int)blockIdx.x);
          pg8::EpiUKV E{sskv, (bf16*)(ws + WS_KN), (bf16*)(ws + WS_VAT)};
          pg8::gemm_phase<pg8::EpiUKV, pg8::StaticOrder, true, true>(lds + RING_OFF, g, S, E); }
    }
    SEAM(2);
    if (IN(3)) REP(3) {
        for (int j = blockIdx.x; j < 256; j += G) { const int bh = j & 31, pr = j >> 5;
#pragma unroll 1
            for (int u = 0; u < 2; ++u) mla_unit2(lds, ws, bh, u ? pr : 15 - pr, wave, lane); }
        for (int j = blockIdx.x; j < 256; j += G) { const int bh = j & 31, pr = j >> 5;
#pragma unroll 1
            for (int u = 0; u < 2; ++u) sb_unit(lds, ws, bh, u ? pr : 15 - pr, tid, wave, lane); }
        __syncthreads(); }
    SEAM(3);
    if (IN(4)) { pg8::Gemm g{OB, (const bf16*)(ws + WS_WABOUT), M, 4096, 4096}; pg8::StaticOrder S; S.init(M, 4096, G, (int)blockIdx.x);
        pg8::EpiResid E{kargs()->x, H, HB, ss1};
        pg8::gemm_phase<pg8::EpiResid, pg8::StaticOrder, true, true>(lds + RING_OFF, g, S, E); }
    SEAM(4);
    if (IN(5)) REP(5) { pg8::Gemm g{HB, (const bf16*)(ws + WS_WUP0), M, FF2, 4096}; pg8::StaticOrder S; S.init(M, FF2, G, (int)blockIdx.x);
        pg8::EpiUpConv E{ss1, (bf16*)(ws + WS_ACT), (float*)(ws + WS_HEAD), (float*)(ws + WS_TAIL), kargs()->conv_w, kargs()->conv_b, (PG8_LAS float*)(lds + RING_BYTES)};
        pg8::gemm_phase<pg8::EpiUpConv, pg8::StaticOrder, true, true>(lds + RING_OFF, g, S, E); }
    do { if (IN(5) && IN(7)) GRID_BAR(); } while (0);
    if (IN(7)) { pg8::Gemm g{(const bf16*)(ws + WS_ACT), (const bf16*)(ws + WS_WDN0), M, 4096, FF}; pg8::StaticOrder S; S.init(M, 4096, G, (int)blockIdx.x);
        { pg8::Unit uf; int last = -1; for (int i = 0; S.next(i, uf); ++i) if (uf.pm != last) { last = uf.pm; conv_fixup_panel(ws, kargs()->conv_w, kargs()->conv_b, last, tid); }
          asm volatile("s_waitcnt vmcnt(0)" ::: "memory"); __syncthreads(); }
        pg8::EpiResid E{H, H, HB, ss2};
        pg8::gemm_phase<pg8::EpiResid, pg8::StaticOrder, true, true>(lds + RING_OFF, g, S, E); }
    SEAM(7);
    if (IN(8)) REP(8) { pg8::Gemm g{HB, (const bf16*)(ws + WS_WCIN), M, 12288, 4096}; pg8::StaticOrder S; S.init(M, 12288, G, (int)blockIdx.x);
        pg8::EpiCIn E{ss2, (bf16*)(ws + WS_CQ1), (bf16*)(ws + WS_CK1), (bf16*)(ws + WS_CVT), (unsigned*)(ws + WS_CTL) + CW_KMAX};
        pg8::gemm_phase<pg8::EpiCIn, pg8::StaticOrder, true, true>(lds + RING_OFF, g, S, E); }
    SEAM(8);
    if (IN(9)) REP(9) {
        float d1 = 0.f, d2 = 0.f;
        { KP ka = kargs(); const float *q1 = ka->lq1, *k1 = ka->lk1, *q2 = ka->lq2, *k2 = ka->lk2; for (int j = lane; j < 128; j += 64) { d1 += q1[j] * k1[j]; d2 += q2[j] * k2[j]; } }
        const float* subln = kargs()->subln;
        const float lam = __expf(wave_sum(d1)) - __expf(wave_sum(d2)) + LAMBDA_INIT;
        const unsigned* kmaxw = (const unsigned*)(ws + WS_CTL) + CW_KMAX; volatile LAS unsigned* qslot = (volatile LAS unsigned*)(lds + PC_FLG + 64);
        for (;;) {
            if (tid == 0) qslot[0] = __hip_atomic_fetch_add((unsigned*)(ws + WS_CTL) + CW_QUEUE + 64 * rep_, 1u, __ATOMIC_RELAXED, __HIP_MEMORY_SCOPE_AGENT);
            __syncthreads();
            const unsigned uu = qslot[0];
            __syncthreads();
            if (uu >= 1024u) break;
            const int qb128 = 31 - (int)(uu >> 5), hd = 15 - (int)((uu & 31u) >> 1), bb = (int)(uu & 1u);
            diff_unit_pc4(lds, ws, subln, lam, kmaxw, bb * 16 + hd, qb128, wave, lane);
        }
        __syncthreads(); }
    SEAM(9);
    if (IN(10)) { pg8::Gemm g{OB, (const bf16*)(ws + WS_WCOUT), M, 4096, 4096}; pg8::StaticOrder S; S.init(M, 4096, G, (int)blockIdx.x);
        pg8::EpiResid E{H, H, HB, ss3};
        pg8::gemm_phase<pg8::EpiResid, pg8::StaticOrder, true, true>(lds + RING_OFF, g, S, E); }
    SEAM(10);
    if (IN(11)) REP(11) { pg8::Gemm g{HB, (const bf16*)(ws + WS_WUP1), M, FF2, 4096}; pg8::StaticOrder S; S.init(M, FF2, G, (int)blockIdx.x);
        pg8::EpiUpConv E{ss3, (bf16*)(ws + WS_ACT), (float*)(ws + WS_HEAD), (float*)(ws + WS_TAIL), kargs()->conv_w + 3 * FF2, kargs()->conv_b + FF2, (PG8_LAS float*)(lds + RING_BYTES)};
        pg8::gemm_phase<pg8::EpiUpConv, pg8::StaticOrder, true, true>(lds + RING_OFF, g, S, E); }
    do { if (IN(11) && IN(13)) GRID_BAR(); } while (0);
    if (IN(13)) { pg8::Gemm g{(const bf16*)(ws + WS_ACT), (const bf16*)(ws + WS_WDN1), M, 4096, FF}; pg8::StaticOrder S; S.init(M, 4096, G, (int)blockIdx.x);
        { pg8::Unit uf; int last = -1; for (int i = 0; S.next(i, uf); ++i) if (uf.pm != last) { last = uf.pm; conv_fixup_panel(ws, kargs()->conv_w + 3 * FF2, kargs()->conv_b + FF2, last, tid); }
          asm volatile("s_waitcnt vmcnt(0)" ::: "memory"); __syncthreads(); }
        pg8::EpiResid E{H, kargs()->out, nullptr, nullptr};
        pg8::gemm_phase<pg8::EpiResid, pg8::StaticOrder, true, true>(lds + RING_OFF, g, S, E); }
    SEAM(13);
    if (IN(14)) final_norm_phase(kargs()->out, kargs()->norm_final, gw, NGW, lane);
#undef IN
#undef SEAM
}

extern "C" void kernel_launch(void* const* d_in, const int* in_sizes, int n_in, void* d_out, int out_size, void* d_ws, size_t ws_size, hipStream_t stream) {
    static int grid = 0;
    if (grid == 0) {
        if (n_in != 21 || in_sizes[0] != M * DM || out_size != M * DM || ws_size < WS_END) { fprintf(stderr, "kernel_launch: unexpected shapes (n_in %d, in0 %d, out %d, ws %zu); nothing launched\n", n_in, n_in > 0 ? in_sizes[0] : -1, out_size, ws_size); grid = -1; return; }
        int dev = 0, cus = 0, per_cu = 0;
        if (hipGetDevice(&dev) != hipSuccess || hipDeviceGetAttribute(&cus, hipDeviceAttributeMultiprocessorCount, dev) != hipSuccess) { grid = -1; return; }
        if (hipFuncSetAttribute((const void*)fwd_kernel, hipFuncAttributeMaxDynamicSharedMemorySize, LDS_BYTES) != hipSuccess) { fprintf(stderr, "kernel_launch: hipFuncSetAttribute failed\n"); grid = -1; return; }
        if (hipOccupancyMaxActiveBlocksPerMultiprocessor(&per_cu, (const void*)fwd_kernel, NWAVES * 64, LDS_BYTES) != hipSuccess || per_cu < 1) fprintf(stderr, "kernel_launch: note: occupancy query reports %d\n", per_cu);
        (void)hipGetLastError();
        grid = cus;
    }
    if (grid < 0) return;
    if (hipMemsetAsync((char*)d_ws + WS_CTL, 0, CTL_ZERO_BYTES, stream) != hipSuccess) { fprintf(stderr, "kernel_launch: memset failed\n"); return; }
    Args a{};
    const float** pp = (const float**)&a.p;
    for (int i = 0; i < 21; ++i) pp[i] = (const float*)d_in[i];
    a.p.out = (float*)d_out; a.p.ws = (unsigned char*)d_ws;
#if MK_ONE_LAUNCH
    a.ph_lo = 0; a.ph_hi = N_PHASES;
    hipLaunchKernelGGL(fwd_kernel, dim3(grid), dim3(NWAVES * 64), LDS_BYTES, stream, a);
#else
    for (int ph = 0; ph < N_PHASES; ++ph) { a.ph_lo = ph; a.ph_hi = ph + 1; hipLaunchKernelGGL(fwd_kernel, dim3(grid), dim3(NWAVES * 64), LDS_BYTES, stream, a); }
#endif
}
```

```cpp
#include <hip/hip_runtime.h>
#include <cstdio>
#include <cstdint>
#include <cmath>
namespace pg8 {
#define PG8_LAS __attribute__((address_space(3)))
typedef unsigned short bf16_t;
typedef short bf16x8 __attribute__((ext_vector_type(8)));
typedef float f32x4 __attribute__((ext_vector_type(4)));
typedef unsigned u32x4 __attribute__((ext_vector_type(4)));
constexpr int BM = 256, BK = 64, HALF = 128, HTB = HALF * BK * 2  , STAGE_BYTES = 8 * HTB, NXCD = 8, WGM = 8;

__host__ __device__ __forceinline__ int lds_byte(int r, int c) { const int st = (r >> 4) * 2 + (c >> 5), rr = r & 15, cc = c & 31, ob = rr * 64 + cc * 2; return st * 1024 + (ob ^ (((ob >> 9) & 1) << 5)); }
__host__ __device__ __forceinline__ void stage_rc(int b, int& R, int& C) { const int st = b / 1024, sb = b % 1024, swz = sb ^ (((sb >> 9) & 1) << 5); R = (st >> 1) * 16 + swz / 64; C = (st & 1) * 32 + (swz % 64) / 2; }
__host__ __device__ __forceinline__ int perm32(int rho) { const int n = rho >> 4, i = rho & 15; return 8 * (i >> 2) + 4 * n + (i & 3); }

struct Unit { int pm, pn; };
struct Gemm { const bf16_t* A; const bf16_t* Bt; int M, N, K; };

struct StaticOrder {
    int nM, nN, nwg, G, c;
    __host__ __device__ void init(int M, int N, int G_, int c_) { nM = M / BM; nN = N / BM; nwg = nM * nN; G = G_; c = c_; }
    __host__ __device__ __forceinline__ bool next(int i, Unit& u) const {
        const long L = (long)i * G + c; if (L >= nwg) return false;
        int wgid = (int)L; { const int q = nwg / NXCD, r = nwg % NXCD, xcd = wgid % NXCD, off = wgid / NXCD; wgid = (xcd < r ? xcd * (q + 1) : r * (q + 1) + (xcd - r) * q) + off; }
        const int nig = WGM * nN, gid = wgid / nig, fm = gid * WGM, gsz = (nM - fm) < WGM ? (nM - fm) : WGM;
        u.pm = fm + ((wgid % nig) % gsz); u.pn = (wgid % nig) / gsz; return true;
    }
    __device__ __forceinline__ void a_ready(const Unit&) const {}
    __device__ __forceinline__ void done(const Unit&) const {}
};
__device__ __forceinline__ unsigned cvt_pk_bf16(float lo, float hi) { unsigned r; asm volatile("v_cvt_pk_bf16_f32 %0, %1, %2" : "=v"(r) : "v"(lo), "v"(hi)); return r; }
typedef float f32x2 __attribute__((ext_vector_type(2)));
constexpr float RMS_EPS = 1e-6f;
__device__ __forceinline__ unsigned f2bf1(float f) { unsigned u = __builtin_bit_cast(unsigned, f); return (u + 0x7fffu + ((u >> 16) & 1u)) >> 16; }
__device__ __forceinline__ void store8(bf16_t* p, const f32x4& v0, const f32x4& v1) {
    u32x4 w; w.x = cvt_pk_bf16(v0[0], v0[1]); w.y = cvt_pk_bf16(v0[2], v0[3]); w.z = cvt_pk_bf16(v1[0], v1[1]); w.w = cvt_pk_bf16(v1[2], v1[3]); *(u32x4*)p = w; }
__device__ __forceinline__ float sq8(const f32x4& v0, const f32x4& v1) { return ((v0[0] * v0[0] + v0[1] * v0[1]) + (v0[2] * v0[2] + v0[3] * v0[3])) + ((v1[0] * v1[0] + v1[1] * v1[1]) + (v1[2] * v1[2] + v1[3] * v1[3])); }
typedef unsigned long long u64_t;
__device__ __forceinline__ void atomic_add_fix(u64_t* p, float v) { (void)__hip_atomic_fetch_add(p, (u64_t)(v * 4294967296.f), __ATOMIC_RELAXED, __HIP_MEMORY_SCOPE_AGENT); }
__device__ __forceinline__ float rstd_fix(const u64_t* ss, int row, float invn) { return rsqrtf((float)ss[row] * (invn * 2.3283064365386963e-10f) + RMS_EPS); }
__device__ __forceinline__ void store8_t(bf16_t* p, const f32x4& v0, const f32x4& v1) {
#pragma unroll
    for (int j = 0; j < 4; ++j) { p[(size_t)j * 4096] = (bf16_t)f2bf1(v0[j]); p[(size_t)(j + 4) * 4096] = (bf16_t)f2bf1(v1[j]); } }
__device__ __forceinline__ void rope8(f32x4& v0, f32x4& v1, const f32x4& c, const f32x4& s) {
    const f32x4 a = v0, b = v1;
    v0[0] = a[0] * c[0] - a[1] * s[0]; v0[1] = a[1] * c[0] + a[0] * s[0]; v0[2] = a[2] * c[1] - a[3] * s[1]; v0[3] = a[3] * c[1] + a[2] * s[1];
    v1[0] = b[0] * c[2] - b[1] * s[2]; v1[1] = b[1] * c[2] + b[0] * s[2]; v1[2] = b[2] * c[3] - b[3] * s[3]; v1[3] = b[3] * c[3] + b[2] * s[3]; }

struct EpiABIn {
    static constexpr bool PERM = true, AFTER_DRAIN = false;
    const u64_t* ss0; bf16_t *CQ, *CKV, *KR, *SBQ, *SBK, *SBVT; u64_t *ssq, *sskv; const float *rc, *rs;
    __device__ __forceinline__ void operator()(const f32x4 (&acc)[2][2][4][2], const Unit& u, int wr, int wc, int fr, int fq) const {
        const int pn = u.pn;
#pragma unroll
        for (int ai = 0; ai < 2; ++ai)
#pragma unroll
            for (int m = 0; m < 4; ++m) {
                const int row = u.pm * BM + ai * HALF + wr * 64 + m * 16 + fr;
                const float sc = rstd_fix(ss0, row, 1.f / 4096.f);
                if (pn < 6) {
                    bf16_t* dst = pn < 4 ? CQ + (size_t)row * 1024 + pn * 256 : CKV + (size_t)row * 512 + (pn - 4) * 256;
                    float part = 0.f;
#pragma unroll
                    for (int bj = 0; bj < 2; ++bj) { const f32x4 v0 = acc[ai][bj][m][0] * sc, v1 = acc[ai][bj][m][1] * sc; part += sq8(v0, v1); store8(dst + bj * HALF + wc * 32 + 8 * fq, v0, v1); }
                    part += __shfl_xor(part, 16); part += __shfl_xor(part, 32);
                    if (fq == 0) atomic_add_fix((pn < 4 ? ssq : sskv) + row, part);
                } else if (pn == 6) {
                    if (wc < 2) { f32x4 v0 = acc[ai][0][m][0] * sc, v1 = acc[ai][0][m][1] * sc; const int pos = row & 4095, i0 = 16 * wc + 4 * fq;
                        rope8(v0, v1, *(const f32x4*)(rc + pos * 32 + i0), *(const f32x4*)(rs + pos * 32 + i0)); store8(KR + (size_t)row * 64 + wc * 32 + 8 * fq, v0, v1); }
                } else {
                    const int t = (pn - 7) >> 3, ct = ((pn - 7) & 7) * 256;
                    if (t < 2) { bf16_t* dst = (t == 0 ? SBQ : SBK) + (size_t)row * 2048 + ct; const float sq = t == 0 ? sc * 0.08838834764831845f : sc;
#pragma unroll
                        for (int bj = 0; bj < 2; ++bj) store8(dst + bj * HALF + wc * 32 + 8 * fq, acc[ai][bj][m][0] * sq, acc[ai][bj][m][1] * sq);
                    } else { const int b = row >> 12, s = row & 4095;
#pragma unroll
                        for (int bj = 0; bj < 2; ++bj) { const int col = ct + bj * HALF + wc * 32 + 8 * fq; store8_t(SBVT + ((size_t)(b * 2048 + col)) * 4096 + s, acc[ai][bj][m][0] * sc, acc[ai][bj][m][1] * sc); }
                    }
                }
            }
    }
};
struct EpiUQ {
    static constexpr bool PERM = true, AFTER_DRAIN = false;
    const u64_t* ssq; bf16_t* QA; const float *rc, *rs;
    __device__ __forceinline__ void operator()(const f32x4 (&acc)[2][2][4][2], const Unit& u, int wr, int wc, int fr, int fq) const {
#pragma unroll
        for (int ai = 0; ai < 2; ++ai)
#pragma unroll
            for (int m = 0; m < 4; ++m) {
                const int row = u.pm * BM + ai * HALF + wr * 64 + m * 16 + fr;
                const float sc = rstd_fix(ssq, row, 1.f / 1024.f) * (0.07216878364870322f * 1.4426950408889634f);
#pragma unroll
                for (int bj = 0; bj < 2; ++bj) { const int cb = u.pn * BM + bj * HALF + wc * 32, hd = cb % 192;
                    f32x4 v0 = acc[ai][bj][m][0] * sc, v1 = acc[ai][bj][m][1] * sc;
                    if (hd >= 128) { const int pos = row & 4095, i0 = (hd - 128) / 2 + 4 * fq; rope8(v0, v1, *(const f32x4*)(rc + pos * 32 + i0), *(const f32x4*)(rs + pos * 32 + i0)); }
                    store8(QA + (size_t)row * 3072 + cb + 8 * fq, v0, v1); }
            }
    }
};
struct EpiUKV {
    static constexpr bool PERM = true, AFTER_DRAIN = false;
    const u64_t* sskv; bf16_t *KN, *VAT;
    __device__ __forceinline__ void operator()(const f32x4 (&acc)[2][2][4][2], const Unit& u, int wr, int wc, int fr, int fq) const {
#pragma unroll
        for (int ai = 0; ai < 2; ++ai)
#pragma unroll
            for (int m = 0; m < 4; ++m) {
                const int row = u.pm * BM + ai * HALF + wr * 64 + m * 16 + fr;
                const float sc = rstd_fix(sskv, row, 1.f / 512.f);
                if (u.pn < 8) {
#pragma unroll
                    for (int bj = 0; bj < 2; ++bj) store8(KN + (size_t)row * 2048 + u.pn * BM + bj * HALF + wc * 32 + 8 * fq, acc[ai][bj][m][0] * sc, acc[ai][bj][m][1] * sc);
                } else { const int b = row >> 12, s = row & 4095;
#pragma unroll
                    for (int bj = 0; bj < 2; ++bj) { const int col = (u.pn - 8) * BM + bj * HALF + wc * 32 + 8 * fq; store8_t(VAT + ((size_t)(b * 2048 + col)) * 4096 + s, acc[ai][bj][m][0] * sc, acc[ai][bj][m][1] * sc); }
                }
            }
    }
};
struct EpiResid {
    static constexpr bool PERM = true, AFTER_DRAIN = false;
    const float* resid; float* Hout; bf16_t* HB; u64_t* ssn;
    __device__ __forceinline__ void operator()(const f32x4 (&acc)[2][2][4][2], const Unit& u, int wr, int wc, int fr, int fq) const {
#pragma unroll
        for (int ai = 0; ai < 2; ++ai)
#pragma unroll
            for (int m = 0; m < 4; ++m) {
                const int row = u.pm * BM + ai * HALF + wr * 64 + m * 16 + fr; float part = 0.f;
#pragma unroll
                for (int bj = 0; bj < 2; ++bj) { const size_t off = (size_t)row * 4096 + u.pn * BM + bj * HALF + wc * 32 + 8 * fq;
                    const f32x4 h0 = *(const f32x4*)(resid + off) + acc[ai][bj][m][0], h1 = *(const f32x4*)(resid + off + 4) + acc[ai][bj][m][1];
                    *(f32x4*)(Hout + off) = h0; *(f32x4*)(Hout + off + 4) = h1; if (HB) store8(HB + off, h0, h1); part += sq8(h0, h1); }
                part += __shfl_xor(part, 16); part += __shfl_xor(part, 32);
                if (fq == 0 && ssn) atomic_add_fix(ssn + row, part);
            }
    }
};
struct EpiUp {
    static constexpr bool PERM = true, AFTER_DRAIN = false;
    const u64_t* ss; bf16_t* UP;
    __device__ __forceinline__ void operator()(const f32x4 (&acc)[2][2][4][2], const Unit& u, int wr, int wc, int fr, int fq) const {
#pragma unroll
        for (int ai = 0; ai < 2; ++ai)
#pragma unroll
            for (int m = 0; m < 4; ++m) {
                const int row = u.pm * BM + ai * HALF + wr * 64 + m * 16 + fr;
                const float sc = rstd_fix(ss, row, 1.f / 4096.f);
#pragma unroll
                for (int bj = 0; bj < 2; ++bj) store8(UP + (size_t)row * 22016 + u.pn * BM + bj * HALF + wc * 32 + 8 * fq, acc[ai][bj][m][0] * sc, acc[ai][bj][m][1] * sc);
            }
    }
};
struct EpiCIn {
    static constexpr bool PERM = true, AFTER_DRAIN = false;
    const u64_t* ss; bf16_t *CQ1, *CK1, *CVT; unsigned* kmax;
    __device__ __forceinline__ void operator()(const f32x4 (&acc)[2][2][4][2], const Unit& u, int wr, int wc, int fr, int fq) const {
        float kmx[2] = {0.f, 0.f};
#pragma unroll
        for (int ai = 0; ai < 2; ++ai)
#pragma unroll
            for (int m = 0; m < 4; ++m) {
                const int row = u.pm * BM + ai * HALF + wr * 64 + m * 16 + fr;
                const float sc = rstd_fix(ss, row, 1.f / 4096.f);
                if (u.pn < 32) { bf16_t* dst = (u.pn < 16 ? CQ1 : CK1) + (size_t)row * 4096 + (u.pn & 15) * BM; const float sq = u.pn < 16 ? sc * (0.08838834764831845f * 1.4426950408889634f) : sc;
#pragma unroll
                    for (int bj = 0; bj < 2; ++bj) { const f32x4 v0 = acc[ai][bj][m][0] * sq, v1 = acc[ai][bj][m][1] * sq; store8(dst + bj * HALF + wc * 32 + 8 * fq, v0, v1);
                        if (u.pn >= 16) { float part = sq8(v0, v1); part += __shfl_xor(part, 16); part += __shfl_xor(part, 32); kmx[bj] = fmaxf(kmx[bj], part); } }
                } else { const int b = row >> 12, s = row & 4095;
#pragma unroll
                    for (int bj = 0; bj < 2; ++bj) { const int col = (u.pn - 32) * BM + bj * HALF + wc * 32 + 8 * fq; store8_t(CVT + ((size_t)(b * 4096 + col)) * 4096 + s, acc[ai][bj][m][0] * sc, acc[ai][bj][m][1] * sc); }
                }
            }
        if (u.pn >= 16 && u.pn < 32) {
#pragma unroll
            for (int bj = 0; bj < 2; ++bj) { float v = kmx[bj]; v = fmaxf(v, __shfl_xor(v, 1)); v = fmaxf(v, __shfl_xor(v, 2)); v = fmaxf(v, __shfl_xor(v, 4)); v = fmaxf(v, __shfl_xor(v, 8));
                if (fr == 0 && fq == 0) (void)__hip_atomic_fetch_max(kmax + (((u.pm >> 4) * 32 + (u.pn - 16) * 2 + bj) * 4 + wc), __builtin_bit_cast(unsigned, v), __ATOMIC_RELAXED, __HIP_MEMORY_SCOPE_AGENT); } }
    }
};

__device__ __forceinline__ float dpp_shr1_keep(float old, float src) { return __builtin_bit_cast(float, __builtin_amdgcn_update_dpp(__builtin_bit_cast(int, old), __builtin_bit_cast(int, src), 0x111, 0xf, 0xf, false)); }
__device__ __forceinline__ float dpp_ror1(float src) { return __builtin_bit_cast(float, __builtin_amdgcn_update_dpp(0, __builtin_bit_cast(int, src), 0x121, 0xf, 0xf, false)); }
struct EpiUpConv {
    static constexpr bool PERM = true, AFTER_DRAIN = false;
    const u64_t* ss; bf16_t* ACT; float *HEAD, *TAIL; const float *cw, *cb; PG8_LAS float* xch;
    __device__ __forceinline__ void operator()(const f32x4 (&acc)[2][2][4][2], const Unit& u, int wr, int wc, int fr, int fq) const {
        const int cp = u.pn * 128 + wc * 32 + 8 * fq;
        float sc[2][4];
#pragma unroll
        for (int ai = 0; ai < 2; ++ai)
#pragma unroll
            for (int m = 0; m < 4; ++m) sc[ai][m] = rstd_fix(ss, u.pm * BM + ai * HALF + wr * 64 + m * 16 + fr, 1.f / 4096.f);
#pragma unroll
        for (int ai = 0; ai < 2; ++ai) {
            if (fr >= 14) { PG8_LAS float* d = xch + (((2 * ai + wr) * 4 + wc) * 2 + (fr - 14)) * 64 + fq * 8;
#pragma unroll
                for (int bj = 0; bj < 2; ++bj) { const f32x4 v0 = acc[ai][bj][3][0] * sc[ai][3], v1 = acc[ai][bj][3][1] * sc[ai][3]; *(PG8_LAS f32x4*)(d + bj * 32) = v0; *(PG8_LAS f32x4*)(d + bj * 32 + 4) = v1;
                    if (ai == 1 && wr == 1) { float* t = TAIL + ((size_t)(u.pm * 2 + (fr - 14)) * 2 + bj) * 11008 + cp; *(f32x4*)t = v0; *(f32x4*)(t + 4) = v1; } } }
        }
        if (wr == 0 && fr < 2) {
#pragma unroll
            for (int bj = 0; bj < 2; ++bj) { float* t = HEAD + ((size_t)(u.pm * 2 + fr) * 2 + bj) * 11008 + cp; *(f32x4*)t = acc[0][bj][0][0] * sc[0][0]; *(f32x4*)(t + 4) = acc[0][bj][0][1] * sc[0][0]; } }
        asm volatile("s_waitcnt lgkmcnt(0)\n\ts_barrier" ::: "memory");
        unsigned plo[2][4][2];
#pragma unroll
        for (int hf = 0; hf < 2; ++hf) {
            const int c0 = cp + 4 * hf;
            f32x4 wg[3], wu[3];
#pragma unroll
            for (int j = 0; j < 3; ++j) { wg[j] = *(const f32x4*)(cw + j * 22016 + c0); wu[j] = *(const f32x4*)(cw + j * 22016 + 11008 + c0); }
            const f32x4 bg = *(const f32x4*)(cb + c0), bu = *(const f32x4*)(cb + 11008 + c0);
#pragma unroll
            for (int ai = 0; ai < 2; ++ai) {
                const int seg = 2 * ai + wr;
                f32x4 pg = {0.f, 0.f, 0.f, 0.f}, pu = pg;
                if (seg > 0 && fr >= 14) { const PG8_LAS float* s = xch + ((((seg - 1) * 4 + wc) * 2 + (fr - 14)) * 64) + fq * 8 + 4 * hf; pg = *(const PG8_LAS f32x4*)s; pu = *(const PG8_LAS f32x4*)(s + 32); }
                f32x4 p1g, p1u;
#pragma unroll
                for (int e = 0; e < 4; ++e) { p1g[e] = dpp_shr1_keep(0.f, pg[e]); p1u[e] = dpp_shr1_keep(0.f, pu[e]); }
#pragma unroll
                for (int m = 0; m < 4; ++m) {
                    const f32x4 xg = acc[ai][0][m][hf] * sc[ai][m], xu = acc[ai][1][m][hf] * sc[ai][m];
                    f32x4 ag, au; float o[4];
#pragma unroll
                    for (int e = 0; e < 4; ++e) { ag[e] = dpp_shr1_keep(dpp_ror1(pg[e]), xg[e]); au[e] = dpp_shr1_keep(dpp_ror1(pu[e]), xu[e]);
                        const float a2g = dpp_shr1_keep(dpp_ror1(p1g[e]), ag[e]), a2u = dpp_shr1_keep(dpp_ror1(p1u[e]), au[e]);
                        const float gv = wg[0][e] * a2g + wg[1][e] * ag[e] + wg[2][e] * xg[e] + bg[e], uv = wu[0][e] * a2u + wu[1][e] * au[e] + wu[2][e] * xu[e] + bu[e];
                        o[e] = gv * uv * __builtin_amdgcn_rcpf(1.f + __builtin_amdgcn_exp2f(gv * -1.4426950408889634f)); }
                    pg = xg; pu = xu; p1g = ag; p1u = au;
                    const unsigned w0 = cvt_pk_bf16(o[0], o[1]), w1 = cvt_pk_bf16(o[2], o[3]);
                    if (hf == 0) { plo[ai][m][0] = w0; plo[ai][m][1] = w1; }
                    else if (!(seg == 0 && m == 0 && fr < 2)) { u32x4 w; w.x = plo[ai][m][0]; w.y = plo[ai][m][1]; w.z = w0; w.w = w1; *(u32x4*)(ACT + (size_t)(u.pm * BM + ai * HALF + wr * 64 + m * 16 + fr) * 11008 + cp) = w; }
                }
            }
        }
    }
};
template <class Epi, class Sched, bool ALIGN_EPI = false, bool SP2 = false>
__device__ __forceinline__ void gemm_phase(PG8_LAS unsigned char* lds, const Gemm g, const Sched& S, const Epi& E) {
    const int tid = threadIdx.x, wid = __builtin_amdgcn_readfirstlane(tid >> 6), lane = tid & 63, wr = wid >> 2, wc = wid & 3, fr = lane & 15, fq = lane >> 4;
    const int K = g.K, nt = K / BK;
    unsigned voffA[2], voffB[2];
#pragma unroll
    for (int i = 0; i < 2; ++i) { int R, C; stage_rc(tid * 16 + i * 8192, R, C); const int Rb = Epi::PERM ? ((R & ~31) + perm32(R & 31)) : R;
        voffA[i] = (unsigned)(R * K + C) * 2u; voffB[i] = (unsigned)(Rb * K + C) * 2u; }
    const size_t kstep = (size_t)(BK * 2);
    const size_t hstep = (size_t)HALF * K * 2;
    const size_t tstep = 2 * hstep;
    const unsigned ldsw = (unsigned)wid * 1024u;
    const int aoff = lds_byte(wr * 64 + fr, fq * 8), boff = lds_byte(wc * 32 + fr, fq * 8);
#define PG8_SA(b, h) (((b) * 2 + (h)) * HTB)
#define PG8_SB(b, h) ((4 + (b) * 2 + (h)) * HTB)
#define PG8_STAGE(bufoff, gbase, voff) do { _Pragma("unroll") for (int _i = 0; _i < 2; ++_i) \
        __builtin_amdgcn_global_load_lds((const unsigned*)((const char*)(gbase) + (voff)[_i]), (PG8_LAS unsigned*)(lds + (bufoff) + ldsw + _i * 8192), 16, 0, 0); } while (0)
#define PG8_LDA(dst, b, h) do { _Pragma("unroll") for (int m = 0; m < 4; ++m) _Pragma("unroll") for (int k = 0; k < 2; ++k) dst[m][k] = *(const PG8_LAS bf16x8*)(lds + PG8_SA(b, h) + aoff + m * 2048 + k * 1024); } while (0)
#define PG8_LDB(dst, b, h) do { _Pragma("unroll") for (int n = 0; n < 2; ++n) _Pragma("unroll") for (int k = 0; k < 2; ++k) dst[n][k] = *(const PG8_LAS bf16x8*)(lds + PG8_SB(b, h) + boff + n * 2048 + k * 1024); } while (0)
#define PG8_MMA(ai, bj, At, Bt) do { __builtin_amdgcn_s_setprio(1); _Pragma("unroll") for (int m = 0; m < 4; ++m) _Pragma("unroll") for (int n = 0; n < 2; ++n) _Pragma("unroll") for (int k = 0; k < 2; ++k) \
        acc[ai][bj][m][n] = __builtin_amdgcn_mfma_f32_16x16x32_bf16(Bt[n][k], At[m][k], acc[ai][bj][m][n], 0, 0, 0); __builtin_amdgcn_s_setprio(0); } while (0)
#define PG8_WAIT_V(n) asm volatile("s_waitcnt vmcnt(" #n ")" ::: "memory")
#define PG8_WAIT_L(n) asm volatile("s_waitcnt lgkmcnt(" #n ")" ::: "memory")
#define PG8_BAR __builtin_amdgcn_s_barrier()
#define PG8_SCHED __builtin_amdgcn_sched_barrier(0)
    Unit cur, nxt; int ui = 0;
    if (!S.next(0, cur)) return;
    f32x4 acc[2][2][4][2];
#pragma unroll
    for (int a = 0; a < 2; ++a)
#pragma unroll
        for (int b = 0; b < 2; ++b)
#pragma unroll
            for (int m = 0; m < 4; ++m)
#pragma unroll
                for (int n = 0; n < 2; ++n) acc[a][b][m][n] = (f32x4){0.f, 0.f, 0.f, 0.f};
    bf16x8 At[4][2], B0[2][2], B1[2][2];
    const char* cA = (const char*)g.A + (size_t)cur.pm * tstep; const char* cB = (const char*)g.Bt + (size_t)cur.pn * tstep;
    S.a_ready(cur);
    if constexpr (SP2) {
        PG8_STAGE(PG8_SB(0, 0), cB, voffB); PG8_STAGE(PG8_SB(0, 1), cB + hstep, voffB); PG8_STAGE(PG8_SA(0, 0), cA, voffA); PG8_STAGE(PG8_SA(0, 1), cA + hstep, voffA);
        if (wr == 1) PG8_BAR;
        PG8_WAIT_V(2); PG8_BAR;
        PG8_STAGE(PG8_SB(1, 0), cB + kstep, voffB); PG8_STAGE(PG8_SA(1, 0), cA + kstep, voffA); PG8_STAGE(PG8_SB(1, 1), cB + hstep + kstep, voffB);
        PG8_WAIT_V(6); PG8_BAR;
    } else {
        PG8_STAGE(PG8_SB(0, 0), cB, voffB); PG8_STAGE(PG8_SA(0, 0), cA, voffA); PG8_STAGE(PG8_SB(0, 1), cB + hstep, voffB); PG8_STAGE(PG8_SA(0, 1), cA + hstep, voffA);
        if (wr == 1) PG8_BAR;
        PG8_WAIT_V(4); PG8_BAR;
        PG8_STAGE(PG8_SB(1, 0), cB + kstep, voffB); PG8_STAGE(PG8_SA(1, 0), cA + kstep, voffA); PG8_STAGE(PG8_SB(1, 1), cB + hstep + kstep, voffB);
        PG8_WAIT_V(6); PG8_BAR;
    }
    for (;;) {
        const bool has_next = S.next(ui + 1, nxt);
        const char* nA = has_next ? (const char*)g.A + (size_t)nxt.pm * tstep : cA; const char* nB = has_next ? (const char*)g.Bt + (size_t)nxt.pn * tstep : cB;
        for (int t = 0; t < nt; t += 2) {
            const bool last = (t == nt - 2);
            const char* a1 = cA + (size_t)(t + 1) * kstep;
            const char* a2 = last ? nA : cA + (size_t)(t + 2) * kstep; const char* b2 = last ? nB : cB + (size_t)(t + 2) * kstep;
            const char* a3 = a2 + kstep; const char* b3 = b2 + kstep;
            if (last && has_next) S.a_ready(nxt);
            if constexpr (SP2) {
            PG8_LDB(B0, 0, 0); PG8_LDB(B1, 0, 1); PG8_SCHED; PG8_LDA(At, 0, 0); PG8_STAGE(PG8_SA(1, 1), a1 + hstep, voffA);
            PG8_WAIT_V(8); PG8_WAIT_L(0); PG8_BAR; PG8_MMA(0, 0, At, B0); PG8_MMA(0, 1, At, B1); PG8_BAR; PG8_SCHED;
            PG8_LDA(At, 0, 1); PG8_STAGE(PG8_SB(0, 0), b2, voffB); PG8_STAGE(PG8_SB(0, 1), b2 + hstep, voffB); PG8_STAGE(PG8_SA(0, 0), a2, voffA);
            PG8_WAIT_V(8); PG8_WAIT_L(0); PG8_BAR; PG8_MMA(1, 0, At, B0); PG8_MMA(1, 1, At, B1); PG8_BAR; PG8_SCHED;
            PG8_LDB(B0, 1, 0); PG8_LDB(B1, 1, 1); PG8_SCHED; PG8_LDA(At, 1, 0); PG8_STAGE(PG8_SA(0, 1), a2 + hstep, voffA);
            PG8_WAIT_V(8); PG8_WAIT_L(0); PG8_BAR; PG8_MMA(0, 0, At, B0); PG8_MMA(0, 1, At, B1); PG8_BAR; PG8_SCHED;
            PG8_LDA(At, 1, 1); PG8_STAGE(PG8_SB(1, 0), b3, voffB); PG8_STAGE(PG8_SB(1, 1), b3 + hstep, voffB); PG8_STAGE(PG8_SA(1, 0), a3, voffA);
            PG8_WAIT_V(8); PG8_WAIT_L(0); PG8_BAR; PG8_MMA(1, 0, At, B0); PG8_MMA(1, 1, At, B1); PG8_BAR; PG8_SCHED;
            } else {
            PG8_LDB(B0, 0, 0); PG8_SCHED; PG8_LDA(At, 0, 0); PG8_STAGE(PG8_SA(1, 1), a1 + hstep, voffA);
            PG8_WAIT_L(8); PG8_BAR; PG8_WAIT_L(0); PG8_MMA(0, 0, At, B0); PG8_BAR; PG8_SCHED;
            PG8_LDB(B1, 0, 1); PG8_STAGE(PG8_SB(0, 0), b2, voffB);
            PG8_BAR; PG8_WAIT_L(0); PG8_MMA(0, 1, At, B1); PG8_BAR;
            PG8_LDA(At, 0, 1); PG8_STAGE(PG8_SA(0, 0), a2, voffA);
            PG8_BAR; PG8_WAIT_L(0); PG8_MMA(1, 0, At, B0); PG8_BAR; PG8_SCHED;
            PG8_STAGE(PG8_SB(0, 1), b2 + hstep, voffB);
            PG8_WAIT_V(6); PG8_BAR; PG8_MMA(1, 1, At, B1); PG8_BAR;
            PG8_LDB(B0, 1, 0); PG8_SCHED; PG8_LDA(At, 1, 0); PG8_STAGE(PG8_SA(0, 1), a2 + hstep, voffA);
            PG8_WAIT_L(8); PG8_BAR; PG8_WAIT_L(0); PG8_MMA(0, 0, At, B0); PG8_BAR; PG8_SCHED;
            PG8_LDB(B1, 1, 1); PG8_STAGE(PG8_SB(1, 0), b3, voffB);
            PG8_BAR; PG8_WAIT_L(0); PG8_MMA(0, 1, At, B1); PG8_BAR;
            PG8_LDA(At, 1, 1); PG8_STAGE(PG8_SA(1, 0), a3, voffA);
            PG8_BAR; PG8_WAIT_L(0); PG8_MMA(1, 0, At, B0); PG8_BAR; PG8_SCHED;
            PG8_STAGE(PG8_SB(1, 1), b3 + hstep, voffB);
            PG8_WAIT_V(6); PG8_BAR; PG8_MMA(1, 1, At, B1); PG8_BAR;
            }
        }
        if constexpr (ALIGN_EPI) { if (wr == 0) PG8_BAR; }
        if constexpr (!Epi::AFTER_DRAIN) { E(acc, cur, wr, wc, fr, fq); S.done(cur); }
        if (!has_next) break;
#pragma unroll
        for (int a = 0; a < 2; ++a)
#pragma unroll
            for (int b = 0; b < 2; ++b)
#pragma unroll
                for (int m = 0; m < 4; ++m)
#pragma unroll
                    for (int n = 0; n < 2; ++n) acc[a][b][m][n] = (f32x4){0.f, 0.f, 0.f, 0.f};
        cur = nxt; cA = nA; cB = nB; ++ui;
        if constexpr (ALIGN_EPI) { if (wr == 1) PG8_BAR; }
    }
    PG8_WAIT_V(0);
    if constexpr (!ALIGN_EPI) { if (wr == 0) PG8_BAR; }
    PG8_BAR;
    if constexpr (Epi::AFTER_DRAIN) { E.fused(acc, cur, wr, wc, fr, fq, lds, wid, lane); S.done(cur); }
#undef PG8_SA
#undef PG8_SB
#undef PG8_STAGE
#undef PG8_LDA
#undef PG8_LDB
#undef PG8_MMA
#undef PG8_WAIT_V
#undef PG8_WAIT_L
#undef PG8_BAR
#undef PG8_SCHED
}
}

constexpr int NWAVES = 8;
constexpr int SEQ = 4096, DM = 4096, M = 8192, FF = 11008, FF2 = 22016, NAB = 7936;
constexpr float EPS = 1e-6f;
constexpr float LAMBDA_INIT = 0.35550906f;
#ifndef MK_ONE_LAUNCH
#define MK_ONE_LAUNCH 1
#endif
constexpr int N_PHASES = 15;

constexpr size_t MiB = 1u << 20;
constexpr size_t WS_CTL = 0, CTL_ZERO_BYTES = 1 * MiB;
constexpr size_t WS_SS = 262144;
constexpr size_t WS_ROPE = 1 * MiB;
constexpr size_t WS_WABIN = 2 * MiB, WS_WUQ = 64 * MiB, WS_WUKV = 70 * MiB, WS_WABOUT = 74 * MiB, WS_WCIN = 106 * MiB, WS_WCOUT = 202 * MiB;
constexpr size_t WS_WUP0 = 234 * MiB, WS_WUP1 = 406 * MiB, WS_WDN0 = 578 * MiB, WS_WDN1 = 664 * MiB;
constexpr size_t WS_HB = 752 * MiB, WS_H = 816 * MiB, WS_CQ = 944 * MiB, WS_CKV = 960 * MiB, WS_KR = 968 * MiB, WS_SBQ = 970 * MiB, WS_SBK = 1002 * MiB, WS_SBVT = 1034 * MiB;
constexpr size_t WS_QA = 1066 * MiB, WS_KN = 1114 * MiB, WS_VAT = 1146 * MiB, WS_O = 1178 * MiB, WS_UP = 1242 * MiB, WS_ACT = 1586 * MiB;
constexpr size_t WS_CQ1 = 1758 * MiB, WS_CK1 = 1822 * MiB, WS_CVT = 1886 * MiB, WS_DS = 1950 * MiB, WS_DS1 = 2078 * MiB, WS_HEAD = 2206 * MiB, WS_TAIL = 2214 * MiB, WS_END = 2222 * MiB;
static_assert(WS_WABIN + (size_t)NAB * 4096 * 2 <= WS_WUQ && WS_WUP0 + (size_t)FF2 * 4096 * 2 <= WS_WUP1 && WS_WDN1 + (size_t)4096 * FF * 2 <= WS_HB && WS_UP + (size_t)M * FF2 * 2 <= WS_ACT && WS_ACT + (size_t)M * FF * 2 <= WS_CQ1, "d_ws map");
constexpr int CW_KMAX = 2048, CW_QUEUE = 2560;
constexpr int CW_BAR = 4096;

constexpr int RING_OFF = 0, RING_BYTES = 131072;
constexpr int LDSCTL_OFF = 139264, MISC_OFF = LDSCTL_OFF + 320;
constexpr int LDS_BYTES = 147456;

#define GAS __attribute__((address_space(1)))
#define LAS __attribute__((address_space(3)))
typedef unsigned short bf16;
typedef unsigned v4u __attribute__((ext_vector_type(4)));
typedef float f32x4 __attribute__((ext_vector_type(4)));
typedef short bf16x8 __attribute__((ext_vector_type(8)));
typedef GAS unsigned gu32;
#define RLX_AGENT __ATOMIC_RELAXED, __HIP_MEMORY_SCOPE_AGENT
#define LDS_WAIT() asm volatile("s_waitcnt lgkmcnt(0)" ::: "memory")
#define VM_WAIT() asm volatile("s_waitcnt vmcnt(0)" ::: "memory")
__device__ __forceinline__ unsigned f2bf(float f) { unsigned u = __builtin_bit_cast(unsigned, f); return (u + 0x7fffu + ((u >> 16) & 1u)) >> 16; }
__device__ __forceinline__ unsigned pk2(float lo, float hi) { return f2bf(lo) | (f2bf(hi) << 16); }
__device__ __forceinline__ float bf2f(unsigned short b) { return __builtin_bit_cast(float, (unsigned)b << 16); }
__device__ __forceinline__ float bflo(unsigned w) { return __builtin_bit_cast(float, w << 16); }
__device__ __forceinline__ float bfhi(unsigned w) { return __builtin_bit_cast(float, w & 0xffff0000u); }
__device__ __forceinline__ float wave_sum(float v) {
#pragma unroll
    for (int o = 1; o < 64; o <<= 1) v += __shfl_xor(v, o);
    return v;
}
__device__ __forceinline__ float wave_max(float v) {
#pragma unroll
    for (int o = 1; o < 64; o <<= 1) v = fmaxf(v, __shfl_xor(v, o));
    return v;
}
#define XB_TMO      128
#define XB_XCNT(j)  (256  + 64 * (j))
#define XB_XSUB(j)  (1280 + 64 * (j))
#define XB_XGEN(j)  (2304 + 64 * (j))
#define XB_TOP      3328
#define XB_TOPGEN   3392
#define XCD_BAR_WORDS 3456
#define XB_SPIN_CAP (1u << 18)

__device__ __forceinline__ unsigned xb_ld(unsigned* p)              { return __hip_atomic_load(p, __ATOMIC_RELAXED, __HIP_MEMORY_SCOPE_AGENT); }
__device__ __forceinline__ unsigned xb_add(unsigned* p, unsigned v) { return __hip_atomic_fetch_add(p, v, __ATOMIC_RELAXED, __HIP_MEMORY_SCOPE_AGENT); }
__device__ __forceinline__ unsigned xb_xcc_id() { return (unsigned)__builtin_amdgcn_s_getreg((3 << 11) | 20) & 0xFu; }
#define XB_SPIN(cond, bar) do { unsigned _sp = 0; while (cond) { __builtin_amdgcn_s_sleep(1); \
    if ((++_sp & 255u) == 0u) { if (xb_ld(&(bar)[XB_TMO])) break; if (_sp > XB_SPIN_CAP) { atomicAdd(&(bar)[XB_TMO], 1u); break; } } } } while (0)

struct XcdBarrier {
    unsigned* bar; unsigned x;
    volatile LAS unsigned* st;
};

__device__ __forceinline__ XcdBarrier xcd_barrier_post(unsigned* bar, volatile LAS unsigned* st) {
    XcdBarrier b; b.bar = bar; b.x = xb_xcc_id(); b.st = st;
    if (threadIdx.x == 0) (void)xb_add(&bar[XB_XCNT(b.x)], 1u);
    return b;
}
__device__ __forceinline__ void xcd_barrier_complete(unsigned* bar, unsigned x, unsigned& nloc, unsigned& nx) {
    const unsigned G = gridDim.x * gridDim.y * gridDim.z;
    unsigned sum, cnt, mine, sp = 0u;
    for (;;) {
        sum = 0u; cnt = 0u; mine = 0u;
#pragma unroll
        for (unsigned j = 0; j < 16; ++j) { const unsigned c = xb_ld(&bar[XB_XCNT(j)]); sum += c; cnt += (c > 0u) ? 1u : 0u; mine = (j == x) ? c : mine; }
        if (sum == G) break;
        __builtin_amdgcn_s_sleep(1);
        if ((++sp & 255u) == 0u) { if (xb_ld(&bar[XB_TMO])) break; if (sp > XB_SPIN_CAP) { atomicAdd(&bar[XB_TMO], 1u); break; } }
    }
    nloc = mine > 0u ? mine : 1u; nx = cnt > 0u ? cnt : 1u;
}

__device__ __forceinline__ void xcd_barrier(const XcdBarrier& b) {
    asm volatile("s_waitcnt vmcnt(0)" ::: "memory");
    __syncthreads();
    if (threadIdx.x == 0) {
        unsigned* bar = b.bar;
        __builtin_amdgcn_s_waitcnt(0);
        unsigned nloc = b.st[0], nx = b.st[1];
        if (nloc == 0u) { xcd_barrier_complete(bar, b.x, nloc, nx); b.st[0] = nloc; b.st[1] = nx; }
        const unsigned old = xb_add(&bar[XB_XSUB(b.x)], 1u);
        const unsigned gen = old / nloc;
        if (old + 1u == (gen + 1u) * nloc) {
            __builtin_amdgcn_fence(__ATOMIC_RELEASE, "agent");
            asm volatile("s_waitcnt vmcnt(0)" ::: "memory");
            const unsigned og = xb_add(&bar[XB_TOP], 1u);
            const unsigned tg = og / nx;
            if (og + 1u == (tg + 1u) * nx) xb_add(&bar[XB_TOPGEN], 1u);
            else XB_SPIN(xb_ld(&bar[XB_TOPGEN]) == tg, bar);
            __builtin_amdgcn_fence(__ATOMIC_ACQUIRE, "agent");
            xb_add(&bar[XB_XGEN(b.x)], 1u);
            asm volatile("s_waitcnt vmcnt(0)" ::: "memory");
        } else {
            XB_SPIN(xb_ld(&bar[XB_XGEN(b.x)]) == gen, bar);
            __builtin_amdgcn_fence(__ATOMIC_ACQUIRE, "agent");
            asm volatile("s_waitcnt vmcnt(0)" ::: "memory");
        }
    }
    __syncthreads();
}

typedef float f32x16 __attribute__((ext_vector_type(16)));
typedef float f32x2v __attribute__((ext_vector_type(2)));
typedef __bf16 bf16x2v __attribute__((ext_vector_type(2)));
#define MFMA32(a, b, c) __builtin_amdgcn_mfma_f32_32x32x16_bf16((a), (b), (c), 0, 0, 0)
__device__ __forceinline__ int swz23(int m) { return (m & ~12) | ((m & 4) << 1) | ((m & 8) >> 1); }
__device__ __forceinline__ unsigned pkbf(float a, float b) { const f32x2v v = {a, b}; return __builtin_bit_cast(unsigned, __builtin_convertvector(v, bf16x2v)); }
__device__ __forceinline__ bf16x8 pack8(const f32x16& x, int c) { v4u w; w.x = pkbf(x[8 * c], x[8 * c + 1]); w.y = pkbf(x[8 * c + 2], x[8 * c + 3]); w.z = pkbf(x[8 * c + 4], x[8 * c + 5]); w.w = pkbf(x[8 * c + 6], x[8 * c + 7]); return __builtin_bit_cast(bf16x8, w); }
__device__ __forceinline__ float xhalf(float v) { return __shfl_xor(v, 32); }

template <int DQK, int DV> struct AttnTile {
    static constexpr int KS = DQK * 2 + 16, VS = 144, KBYTES = 64 * KS, VBYTES = DV * VS, BUF = KBYTES + VBYTES;
    static constexpr int NK = 64 * (DQK / 8) / 512, NV = DV * 8 / 512;
    v4u rk[NK], rv[NV];
    unsigned gk, gk2, gv;
    __device__ __forceinline__ void init(int k_pitch, int tid) { gk = (unsigned)((tid >> 4) * k_pitch + (tid & 15) * 8) * 2u; gk2 = (unsigned)((tid >> 3) * 64 + (tid & 7) * 8) * 2u; gv = (unsigned)((tid >> 3) * 4096 + (tid & 7) * 8) * 2u; }
    __amdgpu_buffer_rsrc_t r1, r2, rv_;
    __device__ __forceinline__ void bind(const bf16* K1, const bf16* K2, const bf16* VT) {
        r1 = __builtin_amdgcn_make_buffer_rsrc((void*)K1, 0, 0x7fffffff, 0x00020000); r2 = __builtin_amdgcn_make_buffer_rsrc((void*)(DQK == 192 ? K2 : K1), 0, 0x7fffffff, 0x00020000);
        rv_ = __builtin_amdgcn_make_buffer_rsrc((void*)VT, 0, 0x7fffffff, 0x00020000); }
    __device__ __forceinline__ void load(int k_pitch, int kt) {
        const int ko = kt * 64 * k_pitch * 2;
        rk[0] = __builtin_amdgcn_raw_buffer_load_b128(r1, gk, ko, 0); rk[1] = __builtin_amdgcn_raw_buffer_load_b128(r1, gk, ko + k_pitch * 64, 0);
        if (DQK == 192) rk[NK - 1] = __builtin_amdgcn_raw_buffer_load_b128(r2, gk2, kt * 64 * 64 * 2, 0);
#pragma unroll
        for (int i = 0; i < NV; ++i) rv[i] = __builtin_amdgcn_raw_buffer_load_b128(rv_, gv, kt * 128 + i * (64 * 4096 * 2), 0);
    }
    __device__ __forceinline__ void store(LAS unsigned char* buf, int tid) const {
#pragma unroll
        for (int i = 0; i < 2; ++i) { const int c = tid + 512 * i, r = c >> 4, cc = c & 15; *(LAS v4u*)(buf + r * KS + cc * 16) = rk[i]; }
        if (DQK == 192) { const int r = tid >> 3, cc = tid & 7; *(LAS v4u*)(buf + r * KS + 256 + cc * 16) = rk[NK - 1]; }
#pragma unroll
        for (int i = 0; i < NV; ++i) { const int c = tid + 512 * i, d = c >> 3, cc = c & 7; *(LAS v4u*)(buf + KBYTES + d * VS + cc * 16) = rv[i]; }
    }
};
template <int DQK> __device__ __forceinline__ void qk_tile(const LAS unsigned char* kb, int KS, const bf16x8 (&qf)[DQK / 16], int lane, f32x16 (&s)[2]) {
    const int h = lane >> 5, kr = swz23(lane & 31);
    f32x16 a0, a1;
#pragma unroll
    for (int i = 0; i < 16; ++i) { a0[i] = 0.f; a1[i] = 0.f; }
    const LAS unsigned char* p0 = kb + kr * KS + h * 16; const LAS unsigned char* p1 = p0 + 32 * KS;
    constexpr int G = DQK / 32;
    bf16x8 f[2][4];
#define QK_LOAD(dst, g) do { dst[0] = *(const LAS bf16x8*)(p0 + (g) * 64); dst[1] = *(const LAS bf16x8*)(p1 + (g) * 64); dst[2] = *(const LAS bf16x8*)(p0 + (g) * 64 + 32); dst[3] = *(const LAS bf16x8*)(p1 + (g) * 64 + 32); } while (0)
    QK_LOAD(f[0], 0);
#pragma unroll
    for (int g = 0; g < G; ++g) {
        if (g + 1 < G) QK_LOAD(f[(g + 1) & 1], g + 1);
        __builtin_amdgcn_sched_barrier(0);
        a0 = MFMA32(f[g & 1][0], qf[2 * g], a0); a1 = MFMA32(f[g & 1][1], qf[2 * g], a1); a0 = MFMA32(f[g & 1][2], qf[2 * g + 1], a0); a1 = MFMA32(f[g & 1][3], qf[2 * g + 1], a1);
        __builtin_amdgcn_sched_barrier(0);
    }
#undef QK_LOAD
    s[0] = a0; s[1] = a1;
}
template <int DV> __device__ __forceinline__ void pv_tile(const LAS unsigned char* vb, const f32x16 (&p)[2], int lane, f32x16 (&o)[DV / 32]) {
    const int h = lane >> 5, dr = swz23(lane & 31);
    bf16x8 pf[4];
#pragma unroll
    for (int g = 0; g < 4; ++g) pf[g] = pack8(p[g >> 1], g & 1);
    const LAS unsigned char* q = vb + dr * 144 + h * 16;
    constexpr int NB = DV / 32;
    bf16x8 f[2][NB];
#define PV_LOAD(dst, g) do { _Pragma("unroll") for (int db = 0; db < NB; ++db) dst[db] = *(const LAS bf16x8*)(q + db * (32 * 144) + (g) * 32); } while (0)
    PV_LOAD(f[0], 0);
#pragma unroll
    for (int g = 0; g < 4; ++g) {
        if (g + 1 < 4) PV_LOAD(f[(g + 1) & 1], g + 1);
        __builtin_amdgcn_sched_barrier(0);
#pragma unroll
        for (int db = 0; db < NB; ++db) o[db] = MFMA32(f[g & 1][db], pf[g], o[db]);
        __builtin_amdgcn_sched_barrier(0);
    }
#undef PV_LOAD
}
__device__ __forceinline__ void store_o8(bf16* p, const f32x16& x, int c, float sc) {
    v4u w; w.x = pkbf(x[8 * c] * sc, x[8 * c + 1] * sc); w.y = pkbf(x[8 * c + 2] * sc, x[8 * c + 3] * sc); w.z = pkbf(x[8 * c + 4] * sc, x[8 * c + 5] * sc); w.w = pkbf(x[8 * c + 6] * sc, x[8 * c + 7] * sc);
    *(GAS v4u*)p = w; }
__device__ __forceinline__ void sb_unit(LAS unsigned char* lds, unsigned char* ws, int bh, int qb, int tid, int wave, int lane) {
    typedef AttnTile<128, 128> T;
    const int b = bh >> 4, hd = bh & 15, q0 = qb * 256, h = lane >> 5, t = q0 + 32 * wave + (lane & 31);
    const bf16* Q = (const bf16*)(ws + WS_SBQ) + (size_t)b * SEQ * 2048 + hd * 128;
    const bf16* K1 = (const bf16*)(ws + WS_SBK) + (size_t)b * SEQ * 2048 + hd * 128;
    const bf16* VT = (const bf16*)(ws + WS_SBVT) + (size_t)bh * 128 * 4096;
    volatile LAS unsigned* flags = (volatile LAS unsigned*)(lds + 2 * T::BUF);
    bf16x8 qf[8];
#pragma unroll
    for (int kk = 0; kk < 8; ++kk) qf[kk] = __builtin_bit_cast(bf16x8, *(const GAS v4u*)(Q + (size_t)t * 2048 + 16 * kk + 8 * h));
    f32x16 o[4];
#pragma unroll
    for (int db = 0; db < 4; ++db)
#pragma unroll
        for (int i = 0; i < 16; ++i) o[db][i] = 0.f;
    float carry = 0.f; bool mydone = false;
    const int kt_hi = (q0 >> 6) + 3, ktw = (q0 >> 6) + (wave >> 1);
    const float scale = 0.08838834764831845f, L2E = 1.4426950408889634f, LN2 = 0.6931471805599453f;
    T tile; tile.init(2048, tid); tile.bind(K1, K1, VT); tile.load(2048, kt_hi); tile.store(lds, tid); __syncthreads();
    int it = 0;
#pragma unroll 1
    for (int kt = kt_hi; kt >= 0; --kt, ++it) {
        const LAS unsigned char* kb = lds + (it & 1) * T::BUF;
        if (kt > 0) tile.load(2048, kt - 1);
        if (kt <= ktw && !mydone) {
            f32x16 s[2]; qk_tile<128>(kb, T::KS, qf, lane, s);
            float tot[2][2];
#pragma unroll
            for (int blk = 0; blk < 2; ++blk)
#pragma unroll
                for (int c = 0; c < 2; ++c) { float run = 0.f;
#pragma unroll
                    for (int j = 7; j >= 0; --j) { const int i = 8 * c + j, key = kt * 64 + 32 * blk + 16 * c + 8 * h + j; const bool valid = key < t;
                        const float z = s[blk][i];
                        const float sp = fmaxf(z, 0.f) + LN2 * __builtin_amdgcn_logf(1.f + __builtin_amdgcn_exp2f(-fabsf(z) * L2E));
                        const float lk = valid ? -sp : 0.f;
                        s[blk][i] = valid ? (z + lk + run) : -INFINITY;
                        run += lk; }
                    tot[blk][c] = run; }
            float par[2][2], off[2][2];
#pragma unroll
            for (int blk = 0; blk < 2; ++blk)
#pragma unroll
                for (int c = 0; c < 2; ++c) par[blk][c] = xhalf(tot[blk][c]);
            float acc = carry;
            off[1][1] = acc + (h == 0 ? par[1][1] : 0.f); acc += tot[1][1] + par[1][1];
            off[1][0] = acc + (h == 0 ? par[1][0] : 0.f); acc += tot[1][0] + par[1][0];
            off[0][1] = acc + (h == 0 ? par[0][1] : 0.f); acc += tot[0][1] + par[0][1];
            off[0][0] = acc + (h == 0 ? par[0][0] : 0.f); acc += tot[0][0] + par[0][0];
            carry = acc;
#pragma unroll
            for (int blk = 0; blk < 2; ++blk)
#pragma unroll
                for (int i = 0; i < 16; ++i) s[blk][i] = __builtin_amdgcn_exp2f((s[blk][i] + off[blk][i >> 3]) * L2E);
            pv_tile<128>(kb + T::KBYTES, s, lane, o);
            mydone = __all(carry < -110.f);
        }
        if (kt > 0) tile.store(lds + ((it + 1) & 1) * T::BUF, tid);
        if (lane == 0) flags[(it & 1) * 8 + wave] = mydone ? 1u : 0u;
        __syncthreads();
        unsigned alld = 1u;
#pragma unroll
        for (int w = 0; w < 8; ++w) alld &= flags[(it & 1) * 8 + w];
        if (alld) break;
    }
    __syncthreads();
    bf16* orow = (bf16*)(ws + WS_O) + (size_t)(b * SEQ + t) * 4096 + 2048 + hd * 128 + 8 * h;
#pragma unroll
    for (int db = 0; db < 4; ++db) { store_o8(orow + 32 * db, o[db], 0, 1.f); store_o8(orow + 32 * db + 16, o[db], 1, 1.f); }
}
template <int DQK, int DV> struct DmaTile {
    static constexpr int KB = 64 * 256, KRB = (DQK == 192) ? 64 * 128 : 0, VB = DV * 128, BUF = KB + KRB + VB, NVW = DV / 64;
    __amdgpu_buffer_rsrc_t r1, r2, rv;
    unsigned gk0, gk1, gk2, gvE, gvO; int kpb;
    __device__ __forceinline__ void init(const bf16* K1, int k_pitch, const bf16* K2, const bf16* VT, int wave, int lane) {
        r1 = __builtin_amdgcn_make_buffer_rsrc((void*)K1, 0, 0x7fffffff, 0x00020000); r2 = __builtin_amdgcn_make_buffer_rsrc((void*)(DQK == 192 ? K2 : K1), 0, 0x7fffffff, 0x00020000);
        rv = __builtin_amdgcn_make_buffer_rsrc((void*)VT, 0, 0x7fffffff, 0x00020000); kpb = k_pitch * 2;
        { const int p = lane & 15, ra = 8 * wave + (lane >> 4), rb = ra + 4; gk0 = (unsigned)(ra * kpb + ((p ^ (ra & 15)) << 4)); gk1 = (unsigned)(rb * kpb + ((p ^ (rb & 15)) << 4)); }
        { const int p = lane & 7, r = 8 * wave + (lane >> 3); gk2 = (unsigned)(r * 128 + ((p ^ ((r >> 1) & 7)) << 4)); }
        { const int p = lane & 7, l3 = lane >> 3, d0 = 8 * wave * NVW + l3; gvE = (unsigned)(d0 * 8192 + ((p ^ (l3 >> 1)) << 4)); gvO = (unsigned)((d0 + 8) * 8192 + ((p ^ (4 + (l3 >> 1))) << 4)); }
    }
    __device__ __forceinline__ void issue(LAS unsigned char* buf, int kt, int wave) const {
        __builtin_amdgcn_raw_ptr_buffer_load_lds(r1, (LAS void*)(buf + wave * 2048), 16, gk0, kt * 64 * kpb, 0, 0);
        __builtin_amdgcn_raw_ptr_buffer_load_lds(r1, (LAS void*)(buf + wave * 2048 + 1024), 16, gk1, kt * 64 * kpb, 0, 0);
        if (DQK == 192) __builtin_amdgcn_raw_ptr_buffer_load_lds(r2, (LAS void*)(buf + KB + wave * 1024), 16, gk2, kt * 64 * 128, 0, 0);
#pragma unroll
        for (int i = 0; i < NVW; ++i) __builtin_amdgcn_raw_ptr_buffer_load_lds(rv, (LAS void*)(buf + KB + KRB + (wave * NVW + i) * 1024), 16, (i & 1) ? gvO : gvE, kt * 128 + (i >> 1) * (16 * 8192), 0, 0);
    }
};
template <int DQK> __device__ __forceinline__ void qk_tile2(const LAS unsigned char* kb, const bf16x8 (&qf)[DQK / 16], int lane_, f32x16 (&s)[2]) {
    int lane = lane_; asm volatile("" : "+v"(lane));
    const int h = lane >> 5, r = swz23(lane & 31), y = h ^ (r & 15), yr = h ^ ((r >> 1) & 7);
    const LAS unsigned char* p0 = kb + r * 256; const LAS unsigned char* pr = kb + 64 * 256 + r * 128;
    f32x16 a0, a1;
#pragma unroll
    for (int i = 0; i < 16; ++i) { a0[i] = 0.f; a1[i] = 0.f; }
    bf16x8 f[2][2];
#define QK2_LOAD(dst, kk) do { if ((kk) < 8) { const LAS unsigned char* q_ = p0 + ((y ^ (2 * (kk))) << 4); dst[0] = *(const LAS bf16x8*)q_; dst[1] = *(const LAS bf16x8*)(q_ + 32 * 256); } \
                               else { const LAS unsigned char* q_ = pr + ((yr ^ (2 * ((kk) - 8))) << 4); dst[0] = *(const LAS bf16x8*)q_; dst[1] = *(const LAS bf16x8*)(q_ + 32 * 128); } } while (0)
    QK2_LOAD(f[0], 0);
#pragma unroll
    for (int kk = 0; kk < DQK / 16; ++kk) {
        if (kk + 1 < DQK / 16) QK2_LOAD(f[(kk + 1) & 1], kk + 1);
        __builtin_amdgcn_sched_barrier(0);
        a0 = MFMA32(f[kk & 1][0], qf[kk], a0); a1 = MFMA32(f[kk & 1][1], qf[kk], a1);
        __builtin_amdgcn_sched_barrier(0);
    }
#undef QK2_LOAD
    s[0] = a0; s[1] = a1;
}
__device__ __forceinline__ float xmax_half(float v) {
    const unsigned u = __builtin_bit_cast(unsigned, v); const auto r = __builtin_amdgcn_permlane32_swap(u, u, false, false);
    return fmaxf(__builtin_bit_cast(float, r[0]), __builtin_bit_cast(float, r[1])); }
template <int DV> __device__ __forceinline__ void pv_tile2p(const LAS unsigned char* vb, const bf16x8 (&pf)[4], int lane_, f32x16 (&o)[DV / 32]) {
    int lane = lane_; asm volatile("" : "+v"(lane));
    const int h = lane >> 5, dr = swz23(lane & 31), yv = h ^ ((dr >> 1) & 7);
    const LAS unsigned char* q = vb + dr * 128;
    constexpr int NB = DV / 32, W = (DV == 256) ? 2 : 4, SPG = NB / W, NS = 4 * SPG;
    bf16x8 f[2][W];
#define PV2_LOAD(dst, st) do { const int g_ = (st) / SPG, b0_ = W * ((st) % SPG); const LAS unsigned char* q_ = q + ((yv ^ (2 * g_)) << 4) + b0_ * 4096; \
        _Pragma("unroll") for (int j = 0; j < W; ++j) dst[j] = *(const LAS bf16x8*)(q_ + j * 4096); } while (0)
    PV2_LOAD(f[0], 0);
#pragma unroll
    for (int st = 0; st < NS; ++st) {
        if (st + 1 < NS) PV2_LOAD(f[(st + 1) & 1], st + 1);
        __builtin_amdgcn_sched_barrier(0);
#pragma unroll
        for (int j = 0; j < W; ++j) o[W * (st % SPG) + j] = MFMA32(f[st & 1][j], pf[st / SPG], o[W * (st % SPG) + j]);
        __builtin_amdgcn_sched_barrier(0);
    }
#undef PV2_LOAD
}
template <int DV, bool ALIBI> __device__ __forceinline__ float softmax_step(f32x16 (&s)[2], bool past, float tb, float slope_l2, float& mrow, float& lrow, f32x16 (&o)[DV / 32], bf16x8 (&pf)[4]) {
    if (ALIBI) {
        if (past) {
#pragma unroll
            for (int blk = 0; blk < 2; ++blk)
#pragma unroll
                for (int i = 0; i < 16; ++i) s[blk][i] = fmaf(-slope_l2, tb - (float)(32 * blk + 16 * (i >> 3) + (i & 7)), s[blk][i]);
        } else {
#pragma unroll
            for (int blk = 0; blk < 2; ++blk)
#pragma unroll
                for (int i = 0; i < 16; ++i) s[blk][i] = fmaf(-slope_l2, fabsf(tb - (float)(32 * blk + 16 * (i >> 3) + (i & 7))), s[blk][i]); } }
    float mx = fmaxf(fmaxf(s[0][0], s[0][1]), s[1][0]);
#pragma unroll
    for (int i = 2; i < 16; i += 2) mx = fmaxf(fmaxf(mx, s[0][i]), s[0][i + 1]);
#pragma unroll
    for (int i = 1; i < 15; i += 2) mx = fmaxf(fmaxf(mx, s[1][i]), s[1][i + 1]);
    mx = fmaxf(mx, s[1][15]);
    mx = xmax_half(mx);
    const float mnew = fmaxf(mrow, mx), alpha = __builtin_amdgcn_exp2f(mrow - mnew); mrow = mnew;
    const f32x2v mn2 = {mnew, mnew}; f32x2v rs2 = {0.f, 0.f};
#pragma unroll
    for (int blk = 0; blk < 2; ++blk)
#pragma unroll
        for (int i = 0; i < 16; i += 2) { f32x2v x = {s[blk][i], s[blk][i + 1]}; x = x - mn2; x[0] = __builtin_amdgcn_exp2f(x[0]); x[1] = __builtin_amdgcn_exp2f(x[1]); rs2 = rs2 + x; s[blk][i] = x[0]; s[blk][i + 1] = x[1]; }
    lrow = lrow * alpha + (rs2[0] + rs2[1]);
#pragma unroll
    for (int db = 0; db < DV / 32; ++db) o[db] = o[db] * alpha;
#pragma unroll
    for (int g = 0; g < 4; ++g) pf[g] = pack8(s[g >> 1], g & 1);
    return alpha;
}
template <int DQK, int DV, bool ALIBI>
__device__ __forceinline__ void attn4_softmax_unit(LAS unsigned char* lds, const bf16* Q, int q_pitch, const bf16* K1, int k_pitch, const bf16* K2, const bf16* VT, float slope_l2, int q0,
                                                   int wave, int lane, f32x16 (&o)[DV / 32], float& l_out) {
    typedef DmaTile<DQK, DV> T;
    const int h = lane >> 5, t = q0 + 32 * wave + (lane & 31);
    bf16x8 qf[DQK / 16];
#pragma unroll
    for (int kk = 0; kk < DQK / 16; ++kk) qf[kk] = __builtin_bit_cast(bf16x8, *(const GAS v4u*)(Q + (size_t)t * q_pitch + 16 * kk + 8 * h));
#pragma unroll
    for (int db = 0; db < DV / 32; ++db)
#pragma unroll
        for (int i = 0; i < 16; ++i) o[db][i] = 0.f;
    float mrow = -INFINITY, lrow = 0.f;
    const int ntiles = (q0 >> 6) + 4, ktw = (q0 >> 6) + (wave >> 1);
    bf16x8 pf[4];
#pragma unroll
    for (int g = 0; g < 4; ++g) pf[g] = (bf16x8){0, 0, 0, 0, 0, 0, 0, 0};
    T tile; tile.init(K1, k_pitch, K2, VT, wave, lane); tile.issue(lds, 0, wave);
    asm volatile("s_waitcnt vmcnt(0) lgkmcnt(0)\n\ts_barrier" ::: "memory");
    int bi = 0;
#pragma unroll 1
    for (int kt = 0; kt < ntiles; ++kt) {
        const int bn = bi == 2 ? 0 : bi + 1, bp = bi == 0 ? 2 : bi - 1;
        const LAS unsigned char* kb = lds + bi * T::BUF;
        if (kt + 1 < ntiles) tile.issue(lds + bn * T::BUF, kt + 1, wave);
        const float tb = (float)(t - kt * 64 - 8 * h);
        const bool isB = wave >= 4;
        if (isB && kt >= 1 && kt - 1 <= ktw) pv_tile2p<DV>(lds + bp * T::BUF + T::KB + T::KRB, pf, lane, o);
        if (kt <= ktw) { f32x16 s[2]; qk_tile2<DQK>(kb, qf, lane, s); softmax_step<DV, ALIBI>(s, kt < ktw, tb, slope_l2, mrow, lrow, o, pf); }
        if (!isB && kt <= ktw) pv_tile2p<DV>(kb + T::KB + T::KRB, pf, lane, o);
        asm volatile("s_waitcnt vmcnt(0) lgkmcnt(0)\n\ts_barrier" ::: "memory");
        bi = bn;
    }
    if (wave >= 4 && ntiles - 1 <= ktw) pv_tile2p<DV>(lds + (bi == 0 ? 2 : bi - 1) * T::BUF + T::KB + T::KRB, pf, lane, o);
    asm volatile("s_waitcnt lgkmcnt(0)\n\ts_barrier" ::: "memory");
    l_out = lrow + xhalf(lrow);
}
constexpr int PC_FLG = 136192;
template <bool ALIBI> __device__ __forceinline__ float softmax_step_p(f32x16 (&s)[2], bool past, float tb, float slope_l2, float& mrow, float& lrow, bf16x8 (&pf)[4]) {
    if (ALIBI) {
        if (past) {
#pragma unroll
            for (int blk = 0; blk < 2; ++blk)
#pragma unroll
                for (int i = 0; i < 16; ++i) s[blk][i] = fmaf(-slope_l2, tb - (float)(32 * blk + 16 * (i >> 3) + (i & 7)), s[blk][i]);
        } else {
#pragma unroll
            for (int blk = 0; blk < 2; ++blk)
#pragma unroll
                for (int i = 0; i < 16; ++i) s[blk][i] = fmaf(-slope_l2, fabsf(tb - (float)(32 * blk + 16 * (i >> 3) + (i & 7))), s[blk][i]); } }
    float mx = fmaxf(fmaxf(s[0][0], s[0][1]), s[1][0]);
#pragma unroll
    for (int i = 2; i < 16; i += 2) mx = fmaxf(fmaxf(mx, s[0][i]), s[0][i + 1]);
#pragma unroll
    for (int i = 1; i < 15; i += 2) mx = fmaxf(fmaxf(mx, s[1][i]), s[1][i + 1]);
    mx = fmaxf(mx, s[1][15]);
    mx = xmax_half(mx);
    const float mnew = fmaxf(mrow, mx), alpha = __builtin_amdgcn_exp2f(mrow - mnew); mrow = mnew;
    const f32x2v mn2 = {mnew, mnew}; f32x2v rs2 = {0.f, 0.f};
#pragma unroll
    for (int blk = 0; blk < 2; ++blk)
#pragma unroll
        for (int i = 0; i < 16; i += 2) { f32x2v x = {s[blk][i], s[blk][i + 1]}; x = x - mn2; x[0] = __builtin_amdgcn_exp2f(x[0]); x[1] = __builtin_amdgcn_exp2f(x[1]); rs2 = rs2 + x; s[blk][i] = x[0]; s[blk][i + 1] = x[1]; }
    lrow = lrow * alpha + (rs2[0] + rs2[1]);
#pragma unroll
    for (int g = 0; g < 4; ++g) pf[g] = pack8(s[g >> 1], g & 1);
    return alpha;
}
__device__ __forceinline__ void pv_tile256_deep(const LAS unsigned char* vb, const bf16x8 (&pf)[4], int lane_, f32x16 (&o)[8]) {
    int lane = lane_; asm volatile("" : "+v"(lane));
    const int h = lane >> 5, dr = swz23(lane & 31), yv = h ^ ((dr >> 1) & 7);
    const LAS unsigned char* q = vb + dr * 128;
    bf16x8 f[3][4];
#define PVD_LOAD(dst, st) do { const int g_ = (st) >> 1, b0_ = 4 * ((st) & 1); const LAS unsigned char* q_ = q + ((yv ^ (2 * g_)) << 4) + b0_ * 4096; \
        _Pragma("unroll") for (int j = 0; j < 4; ++j) dst[j] = *(const LAS bf16x8*)(q_ + j * 4096); } while (0)
    PVD_LOAD(f[0], 0); PVD_LOAD(f[1], 1);
#pragma unroll
    for (int st = 0; st < 8; ++st) {
        if (st + 2 < 8) PVD_LOAD(f[(st + 2) % 3], st + 2);
        __builtin_amdgcn_sched_barrier(0);
#pragma unroll
        for (int j = 0; j < 4; ++j) o[4 * (st & 1) + j] = MFMA32(f[st % 3][j], pf[st >> 1], o[4 * (st & 1) + j]);
        __builtin_amdgcn_sched_barrier(0);
    }
#undef PVD_LOAD
}
__device__ __forceinline__ void qk_tile128_deep(const LAS unsigned char* kb, const bf16x8 (&qf)[8], int lane_, f32x16 (&s)[2]) {
    int lane = lane_; asm volatile("" : "+v"(lane));
    const int h = lane >> 5, r = swz23(lane & 31), y = h ^ (r & 15);
    const LAS unsigned char* p0 = kb + r * 256;
    f32x16 a0, a1;
#pragma unroll
    for (int i = 0; i < 16; ++i) { a0[i] = 0.f; a1[i] = 0.f; }
    bf16x8 f[4][2];
#define QKD_LOAD(dst, kk) do { const LAS unsigned char* q_ = p0 + ((y ^ (2 * (kk))) << 4); dst[0] = *(const LAS bf16x8*)q_; dst[1] = *(const LAS bf16x8*)(q_ + 32 * 256); } while (0)
    QKD_LOAD(f[0], 0); QKD_LOAD(f[1], 1); QKD_LOAD(f[2], 2);
#pragma unroll
    for (int kk = 0; kk < 8; ++kk) {
        if (kk + 3 < 8) QKD_LOAD(f[(kk + 3) & 3], kk + 3);
        __builtin_amdgcn_sched_barrier(0);
        a0 = MFMA32(f[kk & 3][0], qf[kk], a0); a1 = MFMA32(f[kk & 3][1], qf[kk], a1);
        __builtin_amdgcn_sched_barrier(0);
    }
#undef QKD_LOAD
    s[0] = a0; s[1] = a1;
}
constexpr int PE_K = 0, PE_V = 32768, PE_P = 98304, PE_PBLK = 4352, PE_L = 133120, PE_FLG = 135168;
#ifndef DIAG_P9
#define DIAG_P9 0
#endif
__device__ __forceinline__ void diff_unit_pc5(LAS unsigned char* lds, unsigned char* ws, const float* subln, float lam, const unsigned* kmaxw, int bh, int qb128, int wave, int lane) {
    const int b = bh >> 4, hd = bh & 15, q0 = qb128 * 128, h = lane >> 5, rg = wave & 3; const bool isA = wave < 4;
    const int t = q0 + 32 * rg + (lane & 31);
    const int ntiles = (q0 >> 6) + 2, ktw = (q0 >> 6) + (rg >> 1), kt_hi = ntiles - 1;
    const float slope_l2 = __builtin_amdgcn_exp2f(-0.5f * (float)(hd + 1)) * 1.4426950408889634f;
    const bf16* VT = (const bf16*)(ws + WS_CVT) + (size_t)bh * 256 * 4096;
    const __amdgpu_buffer_rsrc_t rv = __builtin_amdgcn_make_buffer_rsrc((void*)VT, 0, 0x7fffffff, 0x00020000);
    volatile LAS unsigned* flg = (volatile LAS unsigned*)(lds + PE_FLG);
    unsigned gk0, gk1, gvE, gvO;
    { const int p = lane & 15, ra = 8 * wave + (lane >> 4), rb = ra + 4; gk0 = (unsigned)(ra * 8192 + ((p ^ (ra & 15)) << 4)); gk1 = (unsigned)(rb * 8192 + ((p ^ (rb & 15)) << 4)); }
    { const int p = lane & 7, l3 = lane >> 3, d0 = 32 * wave + l3; gvE = (unsigned)(d0 * 8192 + ((p ^ (l3 >> 1)) << 4)); gvO = (unsigned)((d0 + 8) * 8192 + ((p ^ (4 + (l3 >> 1))) << 4)); }
#define PE_ISSUE_K(kt_) do { LAS unsigned char* d_ = lds + PE_K + ((kt_) & 1) * 16384 + wave * 2048; \
    __builtin_amdgcn_raw_ptr_buffer_load_lds(rk, (LAS void*)d_, 16, gk0, (kt_) * 64 * 8192, 0, 0); __builtin_amdgcn_raw_ptr_buffer_load_lds(rk, (LAS void*)(d_ + 1024), 16, gk1, (kt_) * 64 * 8192, 0, 0); } while (0)
#define PE_ISSUE_V(kt_, ib_) do { LAS unsigned char* d_ = lds + PE_V + ((ib_) & 1) * 32768 + wave * 4096; \
    __builtin_amdgcn_raw_ptr_buffer_load_lds(rv, (LAS void*)d_, 16, gvE, (kt_) * 128, 0, 0); __builtin_amdgcn_raw_ptr_buffer_load_lds(rv, (LAS void*)(d_ + 1024), 16, gvO, (kt_) * 128, 0, 0); \
    __builtin_amdgcn_raw_ptr_buffer_load_lds(rv, (LAS void*)(d_ + 2048), 16, gvE, (kt_) * 128 + 16 * 8192, 0, 0); __builtin_amdgcn_raw_ptr_buffer_load_lds(rv, (LAS void*)(d_ + 3072), 16, gvO, (kt_) * 128 + 16 * 8192, 0, 0); } while (0)
#define PE_BAR() asm volatile("s_waitcnt vmcnt(0) lgkmcnt(0)\n\ts_barrier" ::: "memory")
#define PE_FIN(it_) ((flg[((it_) & 1) * 8 + 4] & flg[((it_) & 1) * 8 + 5] & flg[((it_) & 1) * 8 + 6] & flg[((it_) & 1) * 8 + 7]) != 0u)
#pragma unroll 1
    for (int mp = 0; mp < 2; ++mp) {
        const bf16* K1 = (const bf16*)(ws + WS_CK1) + (size_t)b * SEQ * 4096 + (2 * hd + mp) * 128;
        const __amdgpu_buffer_rsrc_t rk = __builtin_amdgcn_make_buffer_rsrc((void*)K1, 0, 0x7fffffff, 0x00020000);
        if (isA) {
            const bf16* Q = (const bf16*)(ws + WS_CQ1) + (size_t)b * SEQ * 4096 + (2 * hd + mp) * 128;
            const __amdgpu_buffer_rsrc_t rq = __builtin_amdgcn_make_buffer_rsrc((void*)Q, 0, 0x7fffffff, 0x00020000); const int qoff = t * 8192 + h * 16;
            bf16x8 qf[8];
#pragma unroll
            for (int kk = 0; kk < 8; ++kk) qf[kk] = __builtin_bit_cast(bf16x8, __builtin_amdgcn_raw_buffer_load_b128(rq, qoff, 32 * kk, 0));
            float bq;
            { float qn = 0.f;
#pragma unroll
              for (int kk = 0; kk < 8; ++kk) { const v4u w = __builtin_bit_cast(v4u, qf[kk]); qn += bflo(w.x) * bflo(w.x) + bfhi(w.x) * bfhi(w.x) + bflo(w.y) * bflo(w.y) + bfhi(w.y) * bfhi(w.y) + bflo(w.z) * bflo(w.z) + bfhi(w.z) * bfhi(w.z) + bflo(w.w) * bflo(w.w) + bfhi(w.w) * bfhi(w.w); }
              qn += xhalf(qn);
              const unsigned* km = kmaxw + ((b * 32 + 2 * hd + mp) * 4);
              const float k2 = (__builtin_bit_cast(float, km[0]) + __builtin_bit_cast(float, km[1])) + (__builtin_bit_cast(float, km[2]) + __builtin_bit_cast(float, km[3]));
              bq = sqrtf(qn * k2 * 1.03f) + 1.f; }
            float mrow = -INFINITY, lrow = 0.f; bool mydone = false, fin = false;
            PE_ISSUE_K(kt_hi); PE_ISSUE_K(kt_hi - 1);
            PE_BAR();
            f32x16 s[2];
#pragma unroll
            for (int i = 0; i < 16; ++i) { s[0][i] = 0.f; s[1][i] = 0.f; }
            if (kt_hi <= ktw) qk_tile128_deep(lds + PE_K + (kt_hi & 1) * 16384, qf, lane, s);
            PE_BAR();
#pragma unroll 1
            for (int it = 0, kt = kt_hi; ; ++it, --kt) {
                if (!fin) { if (kt >= 2) PE_ISSUE_K(kt - 2); if (kt >= 0) PE_ISSUE_V(kt, it); }
                bool pub = false;
                if (!fin && kt >= 0 && kt <= ktw && !mydone) {
                    bf16x8 pf[4];
                    const float alpha = softmax_step_p<true>(s, kt < ktw, (float)(t - kt * 64 - 8 * h), slope_l2, mrow, lrow, pf);
                    LAS unsigned char* pb = lds + PE_P + ((it & 1) * 4 + rg) * PE_PBLK;
#pragma unroll
                    for (int g = 0; g < 4; ++g) *(LAS bf16x8*)(pb + g * 1024 + lane * 16) = pf[g];
                    *(LAS float*)(pb + 4096 + lane * 4) = alpha;
                    pub = true;
                    mydone = __all(bq - slope_l2 * (float)(t - 64 * kt + 1) - mrow < -150.f);
                }
                if (!fin && kt >= 1 && kt - 1 <= ktw && !mydone) qk_tile128_deep(lds + PE_K + ((kt - 1) & 1) * 16384, qf, lane, s);
                if (lane == 0) { flg[(it & 1) * 8 + rg] = pub ? 1u : 0u; flg[(it & 1) * 8 + 4 + rg] = (mydone || kt <= 0) ? 1u : 0u; }
                PE_BAR();
                if (fin) break;
                fin = PE_FIN(it);
            }
            { const float lt = lrow + xhalf(lrow); *(LAS float*)(lds + PE_L + (mp * 4 + rg) * 256 + lane * 4) = lt; }
            PE_BAR();
        } else {
            f32x16 o[8];
#pragma unroll
            for (int db = 0; db < 8; ++db)
#pragma unroll
                for (int i = 0; i < 16; ++i) o[db][i] = 0.f;
            bool fin = false;
            PE_ISSUE_K(kt_hi); PE_ISSUE_K(kt_hi - 1);
            PE_BAR();
            PE_BAR();
#pragma unroll 1
            for (int it = 0, kt = kt_hi; ; ++it, --kt) {
                if (!fin) { if (kt >= 2) PE_ISSUE_K(kt - 2); if (kt >= 0) PE_ISSUE_V(kt, it); }
                if (it >= 1 && flg[((it - 1) & 1) * 8 + rg] != 0u) {
                    const LAS unsigned char* pb = lds + PE_P + (((it - 1) & 1) * 4 + rg) * PE_PBLK; bf16x8 pf[4];
#pragma unroll
                    for (int g = 0; g < 4; ++g) pf[g] = *(const LAS bf16x8*)(pb + g * 1024 + lane * 16);
                    const float alpha = *(const LAS float*)(pb + 4096 + lane * 4);
#pragma unroll
                    for (int db = 0; db < 8; ++db) o[db] = o[db] * alpha;
                    pv_tile256_deep(lds + PE_V + ((it - 1) & 1) * 32768, pf, lane, o);
                }
                PE_BAR();
                if (fin) break;
                fin = PE_FIN(it);
            }
            { const __amdgpu_buffer_rsrc_t rds = __builtin_amdgcn_make_buffer_rsrc((void*)(ws + (mp ? WS_DS1 : WS_DS)), 0, 0x7fffffff, 0x00020000);
              const int dso = (((b * SEQ + t) * 16 + hd) * 256 + 8 * h) * 2;
#pragma unroll
              for (int db = 0; db < 8; ++db)
#pragma unroll
                  for (int c = 0; c < 2; ++c) { v4u w; w.x = pkbf(o[db][8 * c], o[db][8 * c + 1]); w.y = pkbf(o[db][8 * c + 2], o[db][8 * c + 3]); w.z = pkbf(o[db][8 * c + 4], o[db][8 * c + 5]); w.w = pkbf(o[db][8 * c + 6], o[db][8 * c + 7]);
                      __builtin_amdgcn_raw_buffer_store_b128(w, rds, dso, (32 * db + 16 * c) * 2, 0); } }
            PE_BAR();
        }
    }
    {   const bf16* S0 = (const bf16*)(ws + WS_DS); const bf16* S1 = (const bf16*)(ws + WS_DS1); bf16* O = (bf16*)(ws + WS_O);
        const f32x4 g4 = *(const GAS f32x4*)(subln + 4 * lane);
#pragma unroll 2
        for (int rr = 0; rr < 16; ++rr) { const int r = 16 * wave + rr; const size_t row = (size_t)b * SEQ + q0 + r;
            const float l0 = *(const LAS float*)(lds + PE_L + (0 * 4 + (r >> 5)) * 256 + (r & 31) * 4), l1 = *(const LAS float*)(lds + PE_L + (1 * 4 + (r >> 5)) * 256 + (r & 31) * 4);
            const unsigned long long aw = *(const GAS unsigned long long*)(S0 + (row * 16 + hd) * 256 + 4 * lane), cw2 = *(const GAS unsigned long long*)(S1 + (row * 16 + hd) * 256 + 4 * lane);
            const f32x4 a = {bflo((unsigned)aw), bfhi((unsigned)aw), bflo((unsigned)(aw >> 32)), bfhi((unsigned)(aw >> 32))}, c = {bflo((unsigned)cw2), bfhi((unsigned)cw2), bflo((unsigned)(cw2 >> 32)), bfhi((unsigned)(cw2 >> 32))};
            const float i0 = 1.f / l0, i1 = lam / l1;
            const f32x4 x = a * i0 - c * i1;
            const float ss = wave_sum((x[0] * x[0] + x[1] * x[1]) + (x[2] * x[2] + x[3] * x[3]));
            const float rn = rsqrtf(ss * (1.f / 256.f) + EPS) * (1.f - LAMBDA_INIT);
            const f32x4 y = x * rn * g4;
            *(GAS unsigned long long*)(O + row * 4096 + hd * 256 + 4 * lane) = (unsigned long long)pkbf(y[0], y[1]) | ((unsigned long long)pkbf(y[2], y[3]) << 32); }
    }
    PE_BAR();
#undef PE_ISSUE_K
#undef PE_ISSUE_V
#undef PE_BAR
#undef PE_FIN
}
__device__ __forceinline__ void mla_unit2(LAS unsigned char* lds, unsigned char* ws, int bh, int qb, int wave, int lane) {
    const int b = bh >> 4, hd = bh & 15, q0 = qb * 256;
    const bf16* Q = (const bf16*)(ws + WS_QA) + (size_t)b * SEQ * 3072 + hd * 192;
    const bf16* K1 = (const bf16*)(ws + WS_KN) + (size_t)b * SEQ * 2048 + hd * 128;
    const bf16* K2 = (const bf16*)(ws + WS_KR) + (size_t)b * SEQ * 64;
    const bf16* VT = (const bf16*)(ws + WS_VAT) + (size_t)bh * 128 * 4096;
    f32x16 o[4]; float l;
    attn4_softmax_unit<192, 128, false>(lds, Q, 3072, K1, 2048, K2, VT, 0.f, q0, wave, lane, o, l);
    const float il = 1.f / l; const int t = q0 + 32 * wave + (lane & 31), h = lane >> 5;
    bf16* orow = (bf16*)(ws + WS_O) + (size_t)(b * SEQ + t) * 4096 + hd * 128 + 8 * h;
#pragma unroll
    for (int db = 0; db < 4; ++db) { store_o8(orow + 32 * db, o[db], 0, il); store_o8(orow + 32 * db + 16, o[db], 1, il); }
}

template <int MAP> __device__ __forceinline__ int dst_row(int n) {
    if (MAP == 1) {
        if (n < 1536) return n;
        if (n < 1600) { const int i = n - 1536; return 1536 + (i < 32 ? 2 * i : 2 * (i - 32) + 1); }
        return n + 192; }
    if (MAP == 2) {
        const int h = n / 192, j = n - h * 192; if (j < 128) return n; const int r = j - 128; return h * 192 + 128 + (r < 32 ? 2 * r : 2 * (r - 32) + 1); }
    if (MAP == 3) {
        const int h = n >> 8, j = n & 255; return j < 128 ? h * 128 + j : 2048 + h * 128 + (j - 128); }
    if (MAP == 4) {
        const int c = n < 11008 ? n : n - 11008; return (c >> 7) * 256 + (n < 11008 ? 0 : 128) + (c & 127); }
    return n;
}
struct TItem { f32x4 v[8]; };
template <int MAP> __device__ __forceinline__ void transpose_load(TItem& it, const float* W, int K, int N, const float* gain, int item, int lane) {
    const int nblk = N / 32, kb = item / nblk, nb = item - kb * nblk, k0 = 64 * kb, n0 = 32 * nb; const int nq = lane & 7, kq = lane >> 3;
#pragma unroll
    for (int i = 0; i < 8; ++i) { const int kk = 8 * i + kq; const f32x4 v = *(const GAS f32x4*)(W + (size_t)(k0 + kk) * N + n0 + 4 * nq); const float g = gain ? gain[k0 + kk] : 1.f; it.v[i] = v * g; }
}
template <int MAP> __device__ __forceinline__ void transpose_finish(const TItem& it, int K, int N, bf16* WT, LAS float* scr, int item, int lane) {
    const int nblk = N / 32, kb = item / nblk, nb = item - kb * nblk, k0 = 64 * kb, n0 = 32 * nb; const int nq = lane & 7, kq = lane >> 3;
#pragma unroll
    for (int i = 0; i < 8; ++i) { const int kk = 8 * i + kq; LAS float* d = scr + kk * 33 + 4 * nq; d[0] = it.v[i][0]; d[1] = it.v[i][1]; d[2] = it.v[i][2]; d[3] = it.v[i][3]; }
    LDS_WAIT(); asm volatile("" ::: "memory");
    const int c = lane & 7;
#pragma unroll
    for (int p = 0; p < 4; ++p) { const int n = (lane >> 3) + 8 * p; const LAS float* s = scr + (8 * c) * 33 + n;
        v4u o; o.x = pkbf(s[0 * 33], s[1 * 33]); o.y = pkbf(s[2 * 33], s[3 * 33]); o.z = pkbf(s[4 * 33], s[5 * 33]); o.w = pkbf(s[6 * 33], s[7 * 33]);
        *(GAS v4u*)(WT + (size_t)dst_row<MAP>(n0 + n) * K + k0 + 8 * c) = o; }
    LDS_WAIT(); asm volatile("" ::: "memory");
}
template <int MAP> __device__ __forceinline__ void transpose_matrix(const float* W, int K, int N, const float* gain, bf16* WT, LAS float* scr, int first, int n_items, int NGW, int lane) {
    if (first >= n_items) return;
    TItem cur, nxt; transpose_load<MAP>(cur, W, K, N, gain, first, lane);
    for (int it = first; it < n_items; it += NGW) {
        const bool more = it + NGW < n_items;
        if (more) transpose_load<MAP>(nxt, W, K, N, gain, it + NGW, lane);
        transpose_finish<MAP>(cur, K, N, WT, scr, it, lane);
        if (more) cur = nxt;
    }
}
struct P {
    const float *x, *norm_mix, *norm_ffn, *norm_final, *ab_w_in, *ab_q_norm, *ab_w_uq, *ab_kv_norm, *ab_w_ukv, *ab_w_out, *c_w_in, *lq1, *lk1, *lq2, *lk2, *subln, *c_w_out, *w_up, *conv_w, *conv_b, *w_down;
    float* out; unsigned char* ws;
};

typedef const __attribute__((address_space(4))) P* KP;
__device__ __forceinline__ KP kargs() { KP k = (KP)__builtin_amdgcn_kernarg_segment_ptr(); asm volatile("" : "+s"(k)); return k; }
__device__ __forceinline__ void p0_prologue(KP pp, LAS unsigned char* lds, int gw, int NGW, int wave, int lane) {
    unsigned char* ws = pp->ws;
    LAS float* scr = (LAS float*)(lds + wave * 8448);
    constexpr int I_ABIN = 64 * 242, I_UQ = 16 * 96, I_UKV = 8 * 128, I_SQ = 64 * 128, I_CIN = 64 * 384, I_UP = 64 * 688, I_DN = 172 * 128;
    constexpr int NITEMS = I_ABIN + I_UQ + I_UKV + 2 * I_SQ + I_CIN + 2 * I_UP + 2 * I_DN;
    (void)NITEMS;
    { int off = gw;
#define TM(MAP_, W_, K_, N_, G_, WT_, NI_) do { transpose_matrix<MAP_>(W_, K_, N_, G_, (bf16*)(ws + WT_), scr, off, NI_, NGW, lane); off = (off + NGW - (NI_) % NGW) % NGW; } while (0)
      TM(4, pp->w_up, 4096, FF2, pp->norm_ffn, WS_WUP0, I_UP);
      TM(4, pp->w_up + (size_t)4096 * FF2, 4096, FF2, pp->norm_ffn + 4096, WS_WUP1, I_UP);
      TM(0, pp->w_down, FF, 4096, nullptr, WS_WDN0, I_DN);
      TM(0, pp->w_down + (size_t)FF * 4096, FF, 4096, nullptr, WS_WDN1, I_DN);
      TM(0, pp->c_w_in, 4096, 12288, pp->norm_mix + 4096, WS_WCIN, I_CIN);
      TM(1, pp->ab_w_in, 4096, 7744, pp->norm_mix, WS_WABIN, I_ABIN);
      TM(0, pp->ab_w_out, 4096, 4096, nullptr, WS_WABOUT, I_SQ);
      TM(0, pp->c_w_out, 4096, 4096, nullptr, WS_WCOUT, I_SQ);
      TM(2, pp->ab_w_uq, 1024, 3072, pp->ab_q_norm, WS_WUQ, I_UQ);
      TM(3, pp->ab_w_ukv, 512, 4096, pp->ab_kv_norm, WS_WUKV, I_UKV);
#undef TM
    }
    { GAS v4u* z = (GAS v4u*)((bf16*)(ws + WS_WABIN) + (size_t)1600 * 4096);
      for (int i = gw * 64 + lane; i < 192 * 4096 / 8; i += NGW * 64) z[i] = (v4u){0u, 0u, 0u, 0u}; }
    { float* rc = (float*)(ws + WS_ROPE); float* rs = rc + 4096 * 32;
      for (int i = gw * 64 + lane; i < 4096 * 32; i += NGW * 64) { const int pos = i >> 5, k = i & 31; const float inv = exp2f(-(float)k * (13.287712379549449f / 32.f)); float s, c; sincosf((float)pos * inv, &s, &c); rc[i] = c; rs[i] = s; } }
    { bf16* HB = (bf16*)(ws + WS_HB); unsigned long long* ss0 = (unsigned long long*)(ws + WS_SS);
      for (int m = gw; m < M; m += NGW) { const GAS f32x4* xr = (const GAS f32x4*)(pp->x + (size_t)m * DM) + lane; GAS unsigned long long* o8 = (GAS unsigned long long*)(HB + (size_t)m * DM) + lane; float s = 0.f;
#pragma unroll
          for (int j = 0; j < 16; ++j) { const f32x4 v = xr[64 * j]; s += (v[0] * v[0] + v[1] * v[1]) + (v[2] * v[2] + v[3] * v[3]); o8[64 * j] = (unsigned long long)pkbf(v[0], v[1]) | ((unsigned long long)pkbf(v[2], v[3]) << 32); }
          s = wave_sum(s); if (lane == 0) ss0[m] = (unsigned long long)(s * 4294967296.f); } }
}

__device__ __forceinline__ void conv_act_phase(const unsigned char* ws_c, unsigned char* ws, const float* cw, const float* cb, int gtid, int nthr) {
    const bf16* UP = (const bf16*)(ws_c + WS_UP); bf16* ACT = (bf16*)(ws + WS_ACT);
    constexpr int NCG = FF / 8, NITEM = (M / 32) * NCG;
    for (int it0 = gtid; it0 < NITEM; it0 += nthr) { const int it = NITEM - 1 - it0, cg = it % NCG, rsg = it / NCG, c0 = cg * 8, r0 = rsg * 32;
        float wg[3][8], wu[3][8], bg[8], bu[8];
#pragma unroll
        for (int j = 0; j < 3; ++j)
#pragma unroll
            for (int e = 0; e < 8; ++e) { wg[j][e] = cw[j * FF2 + c0 + e]; wu[j][e] = cw[j * FF2 + FF + c0 + e]; }
#pragma unroll
        for (int e = 0; e < 8; ++e) { bg[e] = cb[c0 + e]; bu[e] = cb[FF + c0 + e]; }
        float g1[8], g2[8], u1[8], u2[8];
        const bool first = (r0 & 4095) == 0;
        { v4u a = (v4u){0u, 0u, 0u, 0u}, b2 = a, c = a, d = a;
          if (!first) { a = *(const GAS v4u*)(UP + (size_t)(r0 - 1) * FF2 + c0); b2 = *(const GAS v4u*)(UP + (size_t)(r0 - 2) * FF2 + c0); c = *(const GAS v4u*)(UP + (size_t)(r0 - 1) * FF2 + FF + c0); d = *(const GAS v4u*)(UP + (size_t)(r0 - 2) * FF2 + FF + c0); }
          g1[0] = bflo(a.x); g1[1] = bfhi(a.x); g1[2] = bflo(a.y); g1[3] = bfhi(a.y); g1[4] = bflo(a.z); g1[5] = bfhi(a.z); g1[6] = bflo(a.w); g1[7] = bfhi(a.w);
          g2[0] = bflo(b2.x); g2[1] = bfhi(b2.x); g2[2] = bflo(b2.y); g2[3] = bfhi(b2.y); g2[4] = bflo(b2.z); g2[5] = bfhi(b2.z); g2[6] = bflo(b2.w); g2[7] = bfhi(b2.w);
          u1[0] = bflo(c.x); u1[1] = bfhi(c.x); u1[2] = bflo(c.y); u1[3] = bfhi(c.y); u1[4] = bflo(c.z); u1[5] = bfhi(c.z); u1[6] = bflo(c.w); u1[7] = bfhi(c.w);
          u2[0] = bflo(d.x); u2[1] = bfhi(d.x); u2[2] = bflo(d.y); u2[3] = bfhi(d.y); u2[4] = bflo(d.z); u2[5] = bfhi(d.z); u2[6] = bflo(d.w); u2[7] = bfhi(d.w); }
#pragma unroll 4
        for (int r = r0; r < r0 + 32; ++r) {
            const v4u a = *(const GAS v4u*)(UP + (size_t)r * FF2 + c0), c = *(const GAS v4u*)(UP + (size_t)r * FF2 + FF + c0);
            float g0[8], u0[8], o[8];
            g0[0] = bflo(a.x); g0[1] = bfhi(a.x); g0[2] = bflo(a.y); g0[3] = bfhi(a.y); g0[4] = bflo(a.z); g0[5] = bfhi(a.z); g0[6] = bflo(a.w); g0[7] = bfhi(a.w);
            u0[0] = bflo(c.x); u0[1] = bfhi(c.x); u0[2] = bflo(c.y); u0[3] = bfhi(c.y); u0[4] = bflo(c.z); u0[5] = bfhi(c.z); u0[6] = bflo(c.w); u0[7] = bfhi(c.w);
#pragma unroll
            for (int e = 0; e < 8; ++e) { const float gv = wg[0][e] * g2[e] + wg[1][e] * g1[e] + wg[2][e] * g0[e] + bg[e], uv = wu[0][e] * u2[e] + wu[1][e] * u1[e] + wu[2][e] * u0[e] + bu[e];
                o[e] = gv / (1.f + __expf(-gv)) * uv; g2[e] = g1[e]; g1[e] = g0[e]; u2[e] = u1[e]; u1[e] = u0[e]; }
            v4u w; w.x = pkbf(o[0], o[1]); w.y = pkbf(o[2], o[3]); w.z = pkbf(o[4], o[5]); w.w = pkbf(o[6], o[7]);
            *(GAS v4u*)(ACT + (size_t)r * FF + c0) = w; }
    }
}
__device__ __forceinline__ void conv_fixup_panel(unsigned char* ws, const float* cw, const float* cb, int pm, int tid) {
    const float* HEAD = (const float*)(ws + WS_HEAD) + (size_t)pm * 4 * 11008; const float* TAIL = (const float*)(ws + WS_TAIL) + (size_t)(pm - 1) * 4 * 11008; bf16* ACT = (bf16*)(ws + WS_ACT);
    const bool first = (pm & 15) == 0;
    for (int c = tid; c < FF; c += NWAVES * 64) {
        float tg[2], tu[2], hg[2], hu[2];
#pragma unroll
        for (int j = 0; j < 2; ++j) { tg[j] = first ? 0.f : TAIL[(j * 2 + 0) * 11008 + c]; tu[j] = first ? 0.f : TAIL[(j * 2 + 1) * 11008 + c]; hg[j] = HEAD[(j * 2 + 0) * 11008 + c]; hu[j] = HEAD[(j * 2 + 1) * 11008 + c]; }
        const float g0 = cw[c], g1 = cw[FF2 + c], g2 = cw[2 * FF2 + c], u0 = cw[FF + c], u1 = cw[FF2 + FF + c], u2 = cw[2 * FF2 + FF + c], bg = cb[c], bu = cb[FF + c];
        { const float gv = g0 * tg[0] + g1 * tg[1] + g2 * hg[0] + bg, uv = u0 * tu[0] + u1 * tu[1] + u2 * hu[0] + bu; ACT[(size_t)(pm * 256) * FF + c] = (bf16)f2bf(gv / (1.f + __expf(-gv)) * uv); }
        { const float gv = g0 * tg[1] + g1 * hg[0] + g2 * hg[1] + bg, uv = u0 * tu[1] + u1 * hu[0] + u2 * hu[1] + bu; ACT[(size_t)(pm * 256 + 1) * FF + c] = (bf16)f2bf(gv / (1.f + __expf(-gv)) * uv); }
    }
}
__device__ __forceinline__ void final_norm_phase(float* out, const float* g, int gw, int NGW, int lane) {
    for (int m = gw; m < M; m += NGW) { GAS f32x4* xr = (GAS f32x4*)(out + (size_t)m * DM) + lane; f32x4 v[16]; float s = 0.f;
#pragma unroll
        for (int j = 0; j < 16; ++j) { v[j] = xr[64 * j]; s += (v[j][0] * v[j][0] + v[j][1] * v[j][1]) + (v[j][2] * v[j][2] + v[j][3] * v[j][3]); }
        const float rn = rsqrtf(wave_sum(s) * (1.f / DM) + EPS);
#pragma unroll
        for (int j = 0; j < 16; ++j) { const f32x4 gg = *((const GAS f32x4*)g + lane + 64 * j); xr[64 * j] = v[j] * rn * gg; } }
}

struct Args { P p; int ph_lo, ph_hi; };
static_assert(sizeof(Args) == 23 * 8 + 8, "Args has no padding");
__global__ void __launch_bounds__(NWAVES * 64, 2) fwd_kernel(Args args) {
    extern __shared__ __attribute__((aligned(16))) unsigned char lds_raw[];
    LAS unsigned char* lds = (LAS unsigned char*)lds_raw;
    volatile LAS unsigned* MISC = (volatile LAS unsigned*)(lds + MISC_OFF);
    const int tid = threadIdx.x, lane = tid & 63, wave = __builtin_amdgcn_readfirstlane(tid >> 6);
    const int G = gridDim.x, gw = blockIdx.x * NWAVES + wave, NGW = G * NWAVES;
    unsigned char* ws = kargs()->ws;
    gu32* ctl = (gu32*)(ws + WS_CTL);
    for (int u = tid; u < (LDS_BYTES - LDSCTL_OFF) / 4; u += NWAVES * 64) ((LAS unsigned*)(lds + LDSCTL_OFF))[u] = 0u;
    __syncthreads();
#if MK_ONE_LAUNCH
    XcdBarrier bar = xcd_barrier_post((unsigned*)(ctl + CW_BAR), MISC + 8);
#define GRID_BAR() xcd_barrier(bar)
#else
    (void)MISC; (void)ctl;
#define GRID_BAR() do { } while (0)
#endif
    const int lo = args.ph_lo, hi = args.ph_hi;
#ifndef PHASE_MASK
#define PHASE_MASK 0x7fff
#endif
#define IN(k) (((PHASE_MASK >> (k)) & 1) && lo <= (k) && (k) < hi)
#ifndef REPEAT_PHASE
#define REPEAT_PHASE -1
#endif
#define REP(k) for (int rep_ = 0; rep_ < ((REPEAT_PHASE == (k)) ? 2 : 1); ++rep_)
#define SEAM(k) do { if (IN(k) && IN((k) + 1)) GRID_BAR(); } while (0)
    pg8::u64_t* SS = (pg8::u64_t*)(ws + WS_SS);
    pg8::u64_t *ss0 = SS, *ss1 = SS + 8192, *ss2 = SS + 2 * 8192, *ss3 = SS + 3 * 8192, *ssq = SS + 5 * 8192, *sskv = SS + 6 * 8192;
    const float* rc = (const float*)(ws + WS_ROPE); const float* rs = rc + 4096 * 32;
    bf16* HB = (bf16*)(ws + WS_HB); float* H = (float*)(ws + WS_H); bf16* OB = (bf16*)(ws + WS_O);

    if (IN(0)) REP(0) { p0_prologue(kargs(), lds, gw, NGW, wave, lane); __syncthreads(); }
    SEAM(0);
    if (IN(1)) REP(1) { pg8::Gemm g{HB, (const bf16*)(ws + WS_WABIN), M, NAB, 4096}; pg8::StaticOrder S; S.init(M, NAB, G, (int)blockIdx.x);
        pg8::EpiABIn E{ss0, (bf16*)(ws + WS_CQ), (bf16*)(ws + WS_CKV), (bf16*)(ws + WS_KR), (bf16*)(ws + WS_SBQ), (bf16*)(ws + WS_SBK), (bf16*)(ws + WS_SBVT), ssq, sskv, rc, rs};
        pg8::gemm_phase<pg8::EpiABIn, pg8::StaticOrder, true, true>(lds + RING_OFF, g, S, E); }
    SEAM(1);
    if (IN(2)) REP(2) {
        { pg8::Gemm g{(const bf16*)(ws + WS_CQ), (const bf16*)(ws + WS_WUQ), M, 3072, 1024}; pg8::StaticOrder S; S.init(M, 3072, G, (int)blockIdx.x);
          pg8::EpiUQ E{ssq, (bf16*)(ws + WS_QA), rc, rs};
          pg8::gemm_phase<pg8::EpiUQ, pg8::StaticOrder, true, true>(lds + RING_OFF, g, S, E); }
        { pg8::Gemm g{(const bf16*)(ws + WS_CKV), (const bf16*)(ws + WS_WUKV), M, 4096, 512}; pg8::StaticOrder S; S.init(M, 4096, G, (int)blockIdx.x);
          pg8::EpiUKV E{sskv, (bf16*)(ws + WS_KN), (bf16*)(ws + WS_VAT)};
          pg8::gemm_phase<pg8::EpiUKV, pg8::StaticOrder, true, true>(lds + RING_OFF, g, S, E); }
    }
    SEAM(2);
    if (IN(3)) REP(3) {
        for (int j = blockIdx.x; j < 256; j += G) { const int bh = j & 31, pr = j >> 5;
#pragma unroll 1
            for (int u = 0; u < 2; ++u) mla_unit2(lds, ws, bh, u ? pr : 15 - pr, wave, lane); }
        for (int j = blockIdx.x; j < 256; j += G) { const int bh = j & 31, pr = j >> 5;
#pragma unroll 1
            for (int u = 0; u < 2; ++u) sb_unit(lds, ws, bh, u ? pr : 15 - pr, tid, wave, lane); }
        __syncthreads(); }
    SEAM(3);
    if (IN(4)) { pg8::Gemm g{OB, (const bf16*)(ws + WS_WABOUT), M, 4096, 4096}; pg8::StaticOrder S; S.init(M, 4096, G, (int)blockIdx.x);
        pg8::EpiResid E{kargs()->x, H, HB, ss1};
        pg8::gemm_phase<pg8::EpiResid, pg8::StaticOrder, true, true>(lds + RING_OFF, g, S, E); }
    SEAM(4);
    if (IN(5)) REP(5) { pg8::Gemm g{HB, (const bf16*)(ws + WS_WUP0), M, FF2, 4096}; pg8::StaticOrder S; S.init(M, FF2, G, (int)blockIdx.x);
        pg8::EpiUpConv E{ss1, (bf16*)(ws + WS_ACT), (float*)(ws + WS_HEAD), (float*)(ws + WS_TAIL), kargs()->conv_w, kargs()->conv_b, (PG8_LAS float*)(lds + RING_BYTES)};
        pg8::gemm_phase<pg8::EpiUpConv, pg8::StaticOrder, true, true>(lds + RING_OFF, g, S, E); }
    do { if (IN(5) && IN(7)) GRID_BAR(); } while (0);
    if (IN(7)) { pg8::Gemm g{(const bf16*)(ws + WS_ACT), (const bf16*)(ws + WS_WDN0), M, 4096, FF}; pg8::StaticOrder S; S.init(M, 4096, G, (int)blockIdx.x);
        { pg8::Unit uf; int last = -1; for (int i = 0; S.next(i, uf); ++i) if (uf.pm != last) { last = uf.pm; conv_fixup_panel(ws, kargs()->conv_w, kargs()->conv_b, last, tid); }
          asm volatile("s_waitcnt vmcnt(0)" ::: "memory"); __syncthreads(); }
        pg8::EpiResid E{H, H, HB, ss2};
        pg8::gemm_phase<pg8::EpiResid, pg8::StaticOrder, true, true>(lds + RING_OFF, g, S, E); }
    SEAM(7);
    if (IN(8)) REP(8) { pg8::Gemm g{HB, (const bf16*)(ws + WS_WCIN), M, 12288, 4096}; pg8::StaticOrder S; S.init(M, 12288, G, (int)blockIdx.x);
        pg8::EpiCIn E{ss2, (bf16*)(ws + WS_CQ1), (bf16*)(ws + WS_CK1), (bf16*)(ws + WS_CVT), (unsigned*)(ws + WS_CTL) + CW_KMAX};
        pg8::gemm_phase<pg8::EpiCIn, pg8::StaticOrder, true, true>(lds + RING_OFF, g, S, E); }
    SEAM(8);
    if (IN(9)) REP(9) {
        float d1 = 0.f, d2 = 0.f;
        { KP ka = kargs(); const float *q1 = ka->lq1, *k1 = ka->lk1, *q2 = ka->lq2, *k2 = ka->lk2; for (int j = lane; j < 128; j += 64) { d1 += q1[j] * k1[j]; d2 += q2[j] * k2[j]; } }
        const float* subln = kargs()->subln;
        const float lam = __expf(wave_sum(d1)) - __expf(wave_sum(d2)) + LAMBDA_INIT;
        const unsigned* kmaxw = (const unsigned*)(ws + WS_CTL) + CW_KMAX; volatile LAS unsigned* qslot = (volatile LAS unsigned*)(lds + PC_FLG + 64);
        for (;;) {
            if (tid == 0) qslot[0] = __hip_atomic_fetch_add((unsigned*)(ws + WS_CTL) + CW_QUEUE + 64 * rep_, 1u, __ATOMIC_RELAXED, __HIP_MEMORY_SCOPE_AGENT);
            __syncthreads();
            const unsigned uu = qslot[0];
            __syncthreads();
            if (uu >= 1024u) break;
            const int qb128 = 31 - (int)(uu >> 5), hd = 15 - (int)((uu & 31u) >> 1), bb = (int)(uu & 1u);
            diff_unit_pc5(lds, ws, subln, lam, kmaxw, bb * 16 + hd, qb128, wave, lane);
        }
        __syncthreads(); }
    SEAM(9);
    if (IN(10)) { pg8::Gemm g{OB, (const bf16*)(ws + WS_WCOUT), M, 4096, 4096}; pg8::StaticOrder S; S.init(M, 4096, G, (int)blockIdx.x);
        pg8::EpiResid E{H, H, HB, ss3};
        pg8::gemm_phase<pg8::EpiResid, pg8::StaticOrder, true, true>(lds + RING_OFF, g, S, E); }
    SEAM(10);
    if (IN(11)) REP(11) { pg8::Gemm g{HB, (const bf16*)(ws + WS_WUP1), M, FF2, 4096}; pg8::StaticOrder S; S.init(M, FF2, G, (int)blockIdx.x);
        pg8::EpiUpConv E{ss3, (bf16*)(ws + WS_ACT), (float*)(ws + WS_HEAD), (float*)(ws + WS_TAIL), kargs()->conv_w + 3 * FF2, kargs()->conv_b + FF2, (PG8_LAS float*)(lds + RING_BYTES)};
        pg8::gemm_phase<pg8::EpiUpConv, pg8::StaticOrder, true, true>(lds + RING_OFF, g, S, E); }
    do { if (IN(11) && IN(13)) GRID_BAR(); } while (0);
    if (IN(13)) { pg8::Gemm g{(const bf16*)(ws + WS_ACT), (const bf16*)(ws + WS_WDN1), M, 4096, FF}; pg8::StaticOrder S; S.init(M, 4096, G, (int)blockIdx.x);
        { pg8::Unit uf; int last = -1; for (int i = 0; S.next(i, uf); ++i) if (uf.pm != last) { last = uf.pm; conv_fixup_panel(ws, kargs()->conv_w + 3 * FF2, kargs()->conv_b + FF2, last, tid); }
          asm volatile("s_waitcnt vmcnt(0)" ::: "memory"); __syncthreads(); }
        pg8::EpiResid E{H, kargs()->out, nullptr, nullptr};
        pg8::gemm_phase<pg8::EpiResid, pg8::StaticOrder, true, true>(lds + RING_OFF, g, S, E); }
    SEAM(13);
    if (IN(14)) final_norm_phase(kargs()->out, kargs()->norm_final, gw, NGW, lane);
#undef IN
#undef SEAM
}

extern "C" void kernel_launch(void* const* d_in, const int* in_sizes, int n_in, void* d_out, int out_size, void* d_ws, size_t ws_size, hipStream_t stream) {
    static int grid = 0;
    if (grid == 0) {
        if (n_in != 21 || in_sizes[0] != M * DM || out_size != M * DM || ws_size < WS_END) { fprintf(stderr, "kernel_launch: unexpected shapes (n_in %d, in0 %d, out %d, ws %zu); nothing launched\n", n_in, n_in > 0 ? in_sizes[0] : -1, out_size, ws_size); grid = -1; return; }
        int dev = 0, cus = 0, per_cu = 0;
        if (hipGetDevice(&dev) != hipSuccess || hipDeviceGetAttribute(&cus, hipDeviceAttributeMultiprocessorCount, dev) != hipSuccess) { grid = -1; return; }
        if (hipFuncSetAttribute((const void*)fwd_kernel, hipFuncAttributeMaxDynamicSharedMemorySize, LDS_BYTES) != hipSuccess) { fprintf(stderr, "kernel_launch: hipFuncSetAttribute failed\n"); grid = -1; return; }
        if (hipOccupancyMaxActiveBlocksPerMultiprocessor(&per_cu, (const void*)fwd_kernel, NWAVES * 64, LDS_BYTES) != hipSuccess || per_cu < 1) fprintf(stderr, "kernel_launch: note: occupancy query reports %d\n", per_cu);
        (void)hipGetLastError();
        grid = cus;
    }
    if (grid < 0) return;
    if (hipMemsetAsync((char*)d_ws + WS_CTL, 0, CTL_ZERO_BYTES, stream) != hipSuccess) { fprintf(stderr, "kernel_launch: memset failed\n"); return; }
    Args a{};
    const float** pp = (const float**)&a.p;
    for (int i = 0; i < 21; ++i) pp[i] = (const float*)d_in[i];
    a.p.out = (float*)d_out; a.p.ws = (unsigned char*)d_ws;
#if MK_ONE_LAUNCH
    a.ph_lo = 0; a.ph_hi = N_PHASES;
    hipLaunchKernelGGL(fwd_kernel, dim3(grid), dim3(NWAVES * 64), LDS_BYTES, stream, a);
#else
    for (int ph = 0; ph < N_PHASES; ++ph) { a.ph_lo = ph; a.ph_hi = ph + 1; hipLaunchKernelGGL(fwd_kernel, dim3(grid), dim3(NWAVES * 64), LDS_BYTES, stream, a); }
#endif
}
```

```cpp
#include <hip/hip_runtime.h>
#include <cstdio>
#include <cstdint>
#include <cmath>
template <int CTRL> __device__ __forceinline__ float dppf(float v) { return __builtin_bit_cast(float, __builtin_amdgcn_update_dpp(0, __builtin_bit_cast(int, v), CTRL, 0xf, 0xf, true)); }
__device__ __forceinline__ float sum_x16(float v) { const unsigned u = __builtin_bit_cast(unsigned, v); const auto r = __builtin_amdgcn_permlane16_swap(u, u, false, false); const unsigned r0 = r[0], r1 = r[1]; return __builtin_bit_cast(float, r0) + __builtin_bit_cast(float, r1); }
__device__ __forceinline__ float sum_x32(float v) { const unsigned u = __builtin_bit_cast(unsigned, v); const auto r = __builtin_amdgcn_permlane32_swap(u, u, false, false); const unsigned r0 = r[0], r1 = r[1]; return __builtin_bit_cast(float, r0) + __builtin_bit_cast(float, r1); }
__device__ __forceinline__ float max_x16(float v) { const unsigned u = __builtin_bit_cast(unsigned, v); const auto r = __builtin_amdgcn_permlane16_swap(u, u, false, false); const unsigned r0 = r[0], r1 = r[1]; return fmaxf(__builtin_bit_cast(float, r0), __builtin_bit_cast(float, r1)); }
__device__ __forceinline__ float max_x32(float v) { const unsigned u = __builtin_bit_cast(unsigned, v); const auto r = __builtin_amdgcn_permlane32_swap(u, u, false, false); const unsigned r0 = r[0], r1 = r[1]; return fmaxf(__builtin_bit_cast(float, r0), __builtin_bit_cast(float, r1)); }
__device__ __forceinline__ float row_sum16(float v) { v += dppf<0xB1>(v); v += dppf<0x4E>(v); v += dppf<0x141>(v); v += dppf<0x140>(v); return v; }
__device__ __forceinline__ float row_max16(float v) { v = fmaxf(v, dppf<0xB1>(v)); v = fmaxf(v, dppf<0x4E>(v)); v = fmaxf(v, dppf<0x141>(v)); v = fmaxf(v, dppf<0x140>(v)); return v; }
namespace pg8 {
#define PG8_LAS __attribute__((address_space(3)))
typedef unsigned short bf16_t;
typedef short bf16x8 __attribute__((ext_vector_type(8)));
typedef float f32x4 __attribute__((ext_vector_type(4)));
typedef unsigned u32x4 __attribute__((ext_vector_type(4)));
constexpr int BM = 256, BK = 64, HALF = 128, HTB = HALF * BK * 2  , STAGE_BYTES = 8 * HTB, NXCD = 8, WGM = 8;

__host__ __device__ __forceinline__ int lds_byte(int r, int c) { const int st = (r >> 4) * 2 + (c >> 5), rr = r & 15, cc = c & 31, ob = rr * 64 + cc * 2; return st * 1024 + (ob ^ (((ob >> 9) & 1) << 5)); }
__host__ __device__ __forceinline__ void stage_rc(int b, int& R, int& C) { const int st = b / 1024, sb = b % 1024, swz = sb ^ (((sb >> 9) & 1) << 5); R = (st >> 1) * 16 + swz / 64; C = (st & 1) * 32 + (swz % 64) / 2; }
__host__ __device__ __forceinline__ int perm32(int rho) { const int n = rho >> 4, i = rho & 15; return 8 * (i >> 2) + 4 * n + (i & 3); }

struct Unit { int pm, pn; };
struct Gemm { const bf16_t* A; const bf16_t* Bt; int M, N, K; };

struct StaticOrder {
    int nM, nN, nwg, G, c;
    __host__ __device__ void init(int M, int N, int G_, int c_) { nM = M / BM; nN = N / BM; nwg = nM * nN; G = G_; c = c_; }
    __host__ __device__ __forceinline__ bool next(int i, Unit& u) const {
        const long L = (long)i * G + c; if (L >= nwg) return false;
        int wgid = (int)L; { const int q = nwg / NXCD, r = nwg % NXCD, xcd = wgid % NXCD, off = wgid / NXCD; wgid = (xcd < r ? xcd * (q + 1) : r * (q + 1) + (xcd - r) * q) + off; }
        const int nig = WGM * nN, gid = wgid / nig, fm = gid * WGM, gsz = (nM - fm) < WGM ? (nM - fm) : WGM;
        u.pm = fm + ((wgid % nig) % gsz); u.pn = (wgid % nig) / gsz; return true;
    }
    __device__ __forceinline__ void a_ready(const Unit&) const {}
    __device__ __forceinline__ void done(const Unit&) const {}
};
struct OrderUKV : StaticOrder {
    __device__ __forceinline__ bool next(int i, Unit& u) const {
        long L;
        if (G == 256 && nwg == 512) { if (c < 128) { if (i > 0) return false; L = c; } else { if (i > 2) return false; L = i == 0 ? c : (i == 1 ? 256 + (c - 128) : 384 + (c - 128)); } }
        else { L = (long)i * G + c; if (L >= nwg) return false; }
        int wgid = (int)L; { const int q = nwg / NXCD, r = nwg % NXCD, xcd = wgid % NXCD, off = wgid / NXCD; wgid = (xcd < r ? xcd * (q + 1) : r * (q + 1) + (xcd - r) * q) + off; }
        const int nig = WGM * nN, gid = wgid / nig, fm = gid * WGM, gsz = (nM - fm) < WGM ? (nM - fm) : WGM;
        u.pm = fm + ((wgid % nig) % gsz); u.pn = (wgid % nig) / gsz; return true;
    }
};
__device__ __forceinline__ unsigned cvt_pk_bf16(float lo, float hi) { unsigned r; asm volatile("v_cvt_pk_bf16_f32 %0, %1, %2" : "=v"(r) : "v"(lo), "v"(hi)); return r; }
typedef float f32x2 __attribute__((ext_vector_type(2)));
constexpr float RMS_EPS = 1e-6f;
__device__ __forceinline__ unsigned f2bf1(float f) { unsigned u = __builtin_bit_cast(unsigned, f); return (u + 0x7fffu + ((u >> 16) & 1u)) >> 16; }
__device__ __forceinline__ void store8(bf16_t* p, const f32x4& v0, const f32x4& v1) {
    u32x4 w; w.x = cvt_pk_bf16(v0[0], v0[1]); w.y = cvt_pk_bf16(v0[2], v0[3]); w.z = cvt_pk_bf16(v1[0], v1[1]); w.w = cvt_pk_bf16(v1[2], v1[3]); *(u32x4*)p = w; }
__device__ __forceinline__ float sq8(const f32x4& v0, const f32x4& v1) { return ((v0[0] * v0[0] + v0[1] * v0[1]) + (v0[2] * v0[2] + v0[3] * v0[3])) + ((v1[0] * v1[0] + v1[1] * v1[1]) + (v1[2] * v1[2] + v1[3] * v1[3])); }
typedef unsigned long long u64_t;
__device__ __forceinline__ void atomic_add_fix(u64_t* p, float v) { (void)__hip_atomic_fetch_add(p, (u64_t)(v * 4294967296.f), __ATOMIC_RELAXED, __HIP_MEMORY_SCOPE_AGENT); }
__device__ __forceinline__ float rstd_fix(const u64_t* ss, int row, float invn) { return rsqrtf((float)ss[row] * (invn * 2.3283064365386963e-10f) + RMS_EPS); }
__device__ __forceinline__ void store8_t(bf16_t* p, const f32x4& v0, const f32x4& v1) {
#pragma unroll
    for (int j = 0; j < 4; ++j) { p[(size_t)j * 4096] = (bf16_t)f2bf1(v0[j]); p[(size_t)(j + 4) * 4096] = (bf16_t)f2bf1(v1[j]); } }
__device__ __forceinline__ void rope8(f32x4& v0, f32x4& v1, const f32x4& c, const f32x4& s) {
    const f32x4 a = v0, b = v1;
    v0[0] = a[0] * c[0] - a[1] * s[0]; v0[1] = a[1] * c[0] + a[0] * s[0]; v0[2] = a[2] * c[1] - a[3] * s[1]; v0[3] = a[3] * c[1] + a[2] * s[1];
    v1[0] = b[0] * c[2] - b[1] * s[2]; v1[1] = b[1] * c[2] + b[0] * s[2]; v1[2] = b[2] * c[3] - b[3] * s[3]; v1[3] = b[3] * c[3] + b[2] * s[3]; }

struct EpiABIn {
    static constexpr bool PERM = true, AFTER_DRAIN = false;
    const u64_t* ss0; bf16_t *CQ, *CKV, *KR, *SBQ, *SBK, *SBVT; u64_t *ssq, *sskv; const float *rc, *rs;
    __device__ __forceinline__ void operator()(const f32x4 (&acc)[2][2][4][2], const Unit& u, int wr, int wc, int fr, int fq) const {
        float scv[2][4];
#pragma unroll
        for (int ai_ = 0; ai_ < 2; ++ai_)
#pragma unroll
            for (int m_ = 0; m_ < 4; ++m_) scv[ai_][m_] = rstd_fix(ss0, u.pm * BM + ai_ * HALF + wr * 64 + m_ * 16 + fr, 1.f / 4096.f);
        const int pn = u.pn;
#pragma unroll
        for (int ai = 0; ai < 2; ++ai)
#pragma unroll
            for (int m = 0; m < 4; ++m) {
                const int row = u.pm * BM + ai * HALF + wr * 64 + m * 16 + fr;
                const float sc = scv[ai][m];
                if (pn < 6) {
                    bf16_t* dst = pn < 4 ? CQ + (size_t)row * 1024 + pn * 256 : CKV + (size_t)row * 512 + (pn - 4) * 256;
                    float part = 0.f;
#pragma unroll
                    for (int bj = 0; bj < 2; ++bj) { const f32x4 v0 = acc[ai][bj][m][0] * sc, v1 = acc[ai][bj][m][1] * sc; part += sq8(v0, v1); store8(dst + bj * HALF + wc * 32 + 8 * fq, v0, v1); }
                    part = sum_x32(sum_x16(part));
                    if (fq == 0) atomic_add_fix((pn < 4 ? ssq : sskv) + row, part);
                } else if (pn == 6) {
                    if (wc < 2) { f32x4 v0 = acc[ai][0][m][0] * sc, v1 = acc[ai][0][m][1] * sc; const int pos = row & 4095, i0 = 16 * wc + 4 * fq;
                        rope8(v0, v1, *(const f32x4*)(rc + pos * 32 + i0), *(const f32x4*)(rs + pos * 32 + i0)); store8(KR + (size_t)row * 64 + wc * 32 + 8 * fq, v0, v1); }
                } else {
                    const int t = (pn - 7) >> 3, ct = ((pn - 7) & 7) * 256;
                    if (t < 2) { bf16_t* dst = (t == 0 ? SBQ : SBK) + (size_t)row * 2048 + ct; const float sq = t == 0 ? sc * 0.08838834764831845f : sc;
#pragma unroll
                        for (int bj = 0; bj < 2; ++bj) store8(dst + bj * HALF + wc * 32 + 8 * fq, acc[ai][bj][m][0] * sq, acc[ai][bj][m][1] * sq);
                    } else { const int b = row >> 12, s = row & 4095;
#pragma unroll
                        for (int bj = 0; bj < 2; ++bj) { const int col = ct + bj * HALF + wc * 32 + 8 * fq; store8_t(SBVT + ((size_t)(b * 2048 + col)) * 4096 + s, acc[ai][bj][m][0] * sc, acc[ai][bj][m][1] * sc); }
                    }
                }
            }
    }
};
struct EpiUQ {
    static constexpr bool PERM = true, AFTER_DRAIN = false;
    const u64_t* ssq; bf16_t* QA; const float *rc, *rs;
    __device__ __forceinline__ void operator()(const f32x4 (&acc)[2][2][4][2], const Unit& u, int wr, int wc, int fr, int fq) const {
        float scv[2][4];
#pragma unroll
        for (int ai_ = 0; ai_ < 2; ++ai_)
#pragma unroll
            for (int m_ = 0; m_ < 4; ++m_) scv[ai_][m_] = rstd_fix(ssq, u.pm * BM + ai_ * HALF + wr * 64 + m_ * 16 + fr, 1.f / 1024.f) * (0.07216878364870322f * 1.4426950408889634f)    ;
#pragma unroll
        for (int ai = 0; ai < 2; ++ai)
#pragma unroll
            for (int m = 0; m < 4; ++m) {
                const int row = u.pm * BM + ai * HALF + wr * 64 + m * 16 + fr;
                const float sc = scv[ai][m];
#pragma unroll
                for (int bj = 0; bj < 2; ++bj) { const int cb = u.pn * BM + bj * HALF + wc * 32, hd = cb % 192;
                    f32x4 v0 = acc[ai][bj][m][0] * sc, v1 = acc[ai][bj][m][1] * sc;
                    if (hd >= 128) { const int pos = row & 4095, i0 = (hd - 128) / 2 + 4 * fq; rope8(v0, v1, *(const f32x4*)(rc + pos * 32 + i0), *(const f32x4*)(rs + pos * 32 + i0)); }
                    store8(QA + (size_t)row * 3072 + cb + 8 * fq, v0, v1); }
            }
    }
};
struct EpiUKV {
    static constexpr bool PERM = true, AFTER_DRAIN = false;
    const u64_t* sskv; bf16_t *KN, *VAT;
    __device__ __forceinline__ void operator()(const f32x4 (&acc)[2][2][4][2], const Unit& u, int wr, int wc, int fr, int fq) const {
        float scv[2][4];
#pragma unroll
        for (int ai_ = 0; ai_ < 2; ++ai_)
#pragma unroll
            for (int m_ = 0; m_ < 4; ++m_) scv[ai_][m_] = rstd_fix(sskv, u.pm * BM + ai_ * HALF + wr * 64 + m_ * 16 + fr, 1.f / 512.f);
#pragma unroll
        for (int ai = 0; ai < 2; ++ai)
#pragma unroll
            for (int m = 0; m < 4; ++m) {
                const int row = u.pm * BM + ai * HALF + wr * 64 + m * 16 + fr;
                const float sc = scv[ai][m];
                if (u.pn < 8) {
#pragma unroll
                    for (int bj = 0; bj < 2; ++bj) store8(KN + (size_t)row * 2048 + u.pn * BM + bj * HALF + wc * 32 + 8 * fq, acc[ai][bj][m][0] * sc, acc[ai][bj][m][1] * sc);
                } else { const int b = row >> 12, s = row & 4095;
#pragma unroll
                    for (int bj = 0; bj < 2; ++bj) { const int col = (u.pn - 8) * BM + bj * HALF + wc * 32 + 8 * fq; store8_t(VAT + ((size_t)(b * 2048 + col)) * 4096 + s, acc[ai][bj][m][0] * sc, acc[ai][bj][m][1] * sc); }
                }
            }
    }
};
template <int MODE> struct EpiResidT {
    static constexpr bool PERM = true, AFTER_DRAIN = false;
    const float* resid; float* Hout; bf16_t* HB; u64_t* ssn;
    __device__ __forceinline__ void operator()(const f32x4 (&acc)[2][2][4][2], const Unit& u, int wr, int wc, int fr, int fq) const {
        const size_t col = (size_t)u.pn * BM + wc * 32 + 8 * fq;
#pragma unroll
        for (int ai = 0; ai < 2; ++ai) {
            f32x4 r[4][2][2];
#pragma unroll
            for (int m = 0; m < 4; ++m)
#pragma unroll
                for (int bj = 0; bj < 2; ++bj) { const size_t off = (size_t)(u.pm * BM + ai * HALF + wr * 64 + m * 16 + fr) * 4096 + col + bj * HALF;
                    if (MODE == 0) { r[m][bj][0] = *(const f32x4*)(resid + off); r[m][bj][1] = *(const f32x4*)(resid + off + 4); }
                    else { const u32x4 w = *(const u32x4*)(HB + off);
                        r[m][bj][0] = (f32x4){__builtin_bit_cast(float, w.x << 16), __builtin_bit_cast(float, w.x & 0xffff0000u), __builtin_bit_cast(float, w.y << 16), __builtin_bit_cast(float, w.y & 0xffff0000u)};
                        r[m][bj][1] = (f32x4){__builtin_bit_cast(float, w.z << 16), __builtin_bit_cast(float, w.z & 0xffff0000u), __builtin_bit_cast(float, w.w << 16), __builtin_bit_cast(float, w.w & 0xffff0000u)}; } }
            __builtin_amdgcn_sched_barrier(0);
#pragma unroll
            for (int m = 0; m < 4; ++m) {
                const int row = u.pm * BM + ai * HALF + wr * 64 + m * 16 + fr; float part = 0.f;
#pragma unroll
                for (int bj = 0; bj < 2; ++bj) { const size_t off = (size_t)row * 4096 + col + bj * HALF;
                    const f32x4 h0 = r[m][bj][0] + acc[ai][bj][m][0], h1 = r[m][bj][1] + acc[ai][bj][m][1];
                    if (MODE == 2) { *(f32x4*)(Hout + off) = h0; *(f32x4*)(Hout + off + 4) = h1; } else { store8(HB + off, h0, h1); part += sq8(h0, h1); } }
                if (MODE != 2) { part = sum_x32(sum_x16(part)); if (fq == 0) atomic_add_fix(ssn + row, part); }
            }
            __builtin_amdgcn_sched_barrier(0);
        }
    }
};
struct EpiUp {
    static constexpr bool PERM = true, AFTER_DRAIN = false;
    const u64_t* ss; bf16_t* UP;
    __device__ __forceinline__ void operator()(const f32x4 (&acc)[2][2][4][2], const Unit& u, int wr, int wc, int fr, int fq) const {
        float scv[2][4];
#pragma unroll
        for (int ai_ = 0; ai_ < 2; ++ai_)
#pragma unroll
            for (int m_ = 0; m_ < 4; ++m_) scv[ai_][m_] = rstd_fix(ss, u.pm * BM + ai_ * HALF + wr * 64 + m_ * 16 + fr, 1.f / 4096.f);
#pragma unroll
        for (int ai = 0; ai < 2; ++ai)
#pragma unroll
            for (int m = 0; m < 4; ++m) {
                const int row = u.pm * BM + ai * HALF + wr * 64 + m * 16 + fr;
                const float sc = scv[ai][m];
#pragma unroll
                for (int bj = 0; bj < 2; ++bj) store8(UP + (size_t)row * 22016 + u.pn * BM + bj * HALF + wc * 32 + 8 * fq, acc[ai][bj][m][0] * sc, acc[ai][bj][m][1] * sc);
            }
    }
};
struct EpiCIn {
    static constexpr bool PERM = true, AFTER_DRAIN = false;
    const u64_t* ss; bf16_t *CQ1, *CK1, *CVT; unsigned* kmax;
    __device__ __forceinline__ void operator()(const f32x4 (&acc)[2][2][4][2], const Unit& u, int wr, int wc, int fr, int fq) const {
        float scv[2][4];
#pragma unroll
        for (int ai_ = 0; ai_ < 2; ++ai_)
#pragma unroll
            for (int m_ = 0; m_ < 4; ++m_) scv[ai_][m_] = rstd_fix(ss, u.pm * BM + ai_ * HALF + wr * 64 + m_ * 16 + fr, 1.f / 4096.f);
        float kmx[2] = {0.f, 0.f};
#pragma unroll
        for (int ai = 0; ai < 2; ++ai)
#pragma unroll
            for (int m = 0; m < 4; ++m) {
                const int row = u.pm * BM + ai * HALF + wr * 64 + m * 16 + fr;
                const float sc = scv[ai][m];
                if (u.pn < 32) { bf16_t* dst = (u.pn < 16 ? CQ1 : CK1) + (size_t)row * 4096 + (u.pn & 15) * BM; const float sq = u.pn < 16 ? sc * (0.08838834764831845f * 1.4426950408889634f) : sc;
#pragma unroll
                    for (int bj = 0; bj < 2; ++bj) { const f32x4 v0 = acc[ai][bj][m][0] * sq, v1 = acc[ai][bj][m][1] * sq; store8(dst + bj * HALF + wc * 32 + 8 * fq, v0, v1);
                        if (u.pn >= 16) { float part = sq8(v0, v1); part = sum_x32(sum_x16(part)); kmx[bj] = fmaxf(kmx[bj], part); } }
                } else { const int b = row >> 12, s = row & 4095;
#pragma unroll
                    for (int bj = 0; bj < 2; ++bj) { const int col = (u.pn - 32) * BM + bj * HALF + wc * 32 + 8 * fq; store8_t(CVT + ((size_t)(b * 4096 + col)) * 4096 + s, acc[ai][bj][m][0] * sc, acc[ai][bj][m][1] * sc); }
                }
            }
        if (u.pn >= 16 && u.pn < 32) {
#pragma unroll
            for (int bj = 0; bj < 2; ++bj) { float v = kmx[bj]; v = row_max16(v);
                if (fr == 0 && fq == 0) (void)__hip_atomic_fetch_max(kmax + (((u.pm >> 4) * 32 + (u.pn - 16) * 2 + bj) * 4 + wc), __builtin_bit_cast(unsigned, v), __ATOMIC_RELAXED, __HIP_MEMORY_SCOPE_AGENT); } }
    }
};

__device__ __forceinline__ float dpp_shr1_keep(float old, float src) { return __builtin_bit_cast(float, __builtin_amdgcn_update_dpp(__builtin_bit_cast(int, old), __builtin_bit_cast(int, src), 0x111, 0xf, 0xf, false)); }
__device__ __forceinline__ float dpp_ror1(float src) { return __builtin_bit_cast(float, __builtin_amdgcn_update_dpp(0, __builtin_bit_cast(int, src), 0x121, 0xf, 0xf, false)); }
struct EpiUpConv {
    static constexpr bool PERM = true, AFTER_DRAIN = false;
    const u64_t* ss; bf16_t* ACT; float *HEAD, *TAIL; const float *cw, *cb; PG8_LAS float* xch;
    __device__ __forceinline__ void operator()(const f32x4 (&acc)[2][2][4][2], const Unit& u, int wr, int wc, int fr, int fq) const {
        const int cp = u.pn * 128 + wc * 32 + 8 * fq;
        float sc[2][4];
#pragma unroll
        for (int ai = 0; ai < 2; ++ai)
#pragma unroll
            for (int m = 0; m < 4; ++m) sc[ai][m] = rstd_fix(ss, u.pm * BM + ai * HALF + wr * 64 + m * 16 + fr, 1.f / 4096.f);
#pragma unroll
        for (int ai = 0; ai < 2; ++ai) {
            if (fr >= 14) { PG8_LAS float* d = xch + (((2 * ai + wr) * 4 + wc) * 2 + (fr - 14)) * 64 + fq * 8;
#pragma unroll
                for (int bj = 0; bj < 2; ++bj) { const f32x4 v0 = acc[ai][bj][3][0] * sc[ai][3], v1 = acc[ai][bj][3][1] * sc[ai][3]; *(PG8_LAS f32x4*)(d + bj * 32) = v0; *(PG8_LAS f32x4*)(d + bj * 32 + 4) = v1;
                    if (ai == 1 && wr == 1) { float* t = TAIL + ((size_t)(u.pm * 2 + (fr - 14)) * 2 + bj) * 11008 + cp; *(f32x4*)t = v0; *(f32x4*)(t + 4) = v1; } } }
        }
        if (wr == 0 && fr < 2) {
#pragma unroll
            for (int bj = 0; bj < 2; ++bj) { float* t = HEAD + ((size_t)(u.pm * 2 + fr) * 2 + bj) * 11008 + cp; *(f32x4*)t = acc[0][bj][0][0] * sc[0][0]; *(f32x4*)(t + 4) = acc[0][bj][0][1] * sc[0][0]; } }
        asm volatile("s_waitcnt lgkmcnt(0)\n\ts_barrier" ::: "memory");
        unsigned plo[2][4][2];
#pragma unroll
        for (int hf = 0; hf < 2; ++hf) {
            const int c0 = cp + 4 * hf;
            f32x4 wg[3], wu[3];
#pragma unroll
            for (int j = 0; j < 3; ++j) { wg[j] = *(const f32x4*)(cw + j * 22016 + c0); wu[j] = *(const f32x4*)(cw + j * 22016 + 11008 + c0); }
            const f32x4 bg = *(const f32x4*)(cb + c0), bu = *(const f32x4*)(cb + 11008 + c0);
#pragma unroll
            for (int ai = 0; ai < 2; ++ai) {
                const int seg = 2 * ai + wr;
                f32x4 pg = {0.f, 0.f, 0.f, 0.f}, pu = pg;
                if (seg > 0 && fr >= 14) { const PG8_LAS float* s = xch + ((((seg - 1) * 4 + wc) * 2 + (fr - 14)) * 64) + fq * 8 + 4 * hf; pg = *(const PG8_LAS f32x4*)s; pu = *(const PG8_LAS f32x4*)(s + 32); }
                f32x4 p1g, p1u;
#pragma unroll
                for (int e = 0; e < 4; ++e) { p1g[e] = dpp_shr1_keep(0.f, pg[e]); p1u[e] = dpp_shr1_keep(0.f, pu[e]); }
#pragma unroll
                for (int m = 0; m < 4; ++m) {
                    const f32x4 xg = acc[ai][0][m][hf] * sc[ai][m], xu = acc[ai][1][m][hf] * sc[ai][m];
                    f32x4 ag, au; float o[4];
#pragma unroll
                    for (int e = 0; e < 4; ++e) { ag[e] = dpp_shr1_keep(dpp_ror1(pg[e]), xg[e]); au[e] = dpp_shr1_keep(dpp_ror1(pu[e]), xu[e]);
                        const float a2g = dpp_shr1_keep(dpp_ror1(p1g[e]), ag[e]), a2u = dpp_shr1_keep(dpp_ror1(p1u[e]), au[e]);
                        const float gv = wg[0][e] * a2g + wg[1][e] * ag[e] + wg[2][e] * xg[e] + bg[e], uv = wu[0][e] * a2u + wu[1][e] * au[e] + wu[2][e] * xu[e] + bu[e];
                        o[e] = gv * uv * __builtin_amdgcn_rcpf(1.f + __builtin_amdgcn_exp2f(gv * -1.4426950408889634f)); }
                    pg = xg; pu = xu; p1g = ag; p1u = au;
                    const unsigned w0 = cvt_pk_bf16(o[0], o[1]), w1 = cvt_pk_bf16(o[2], o[3]);
                    if (hf == 0) { plo[ai][m][0] = w0; plo[ai][m][1] = w1; }
                    else if (!(seg == 0 && m == 0 && fr < 2)) { u32x4 w; w.x = plo[ai][m][0]; w.y = plo[ai][m][1]; w.z = w0; w.w = w1; *(u32x4*)(ACT + (size_t)(u.pm * BM + ai * HALF + wr * 64 + m * 16 + fr) * 11008 + cp) = w; }
                }
            }
        }
    }
};
template <class Epi, class Sched, bool ALIGN_EPI = false, bool SP2 = false>
__device__ __forceinline__ void gemm_phase(PG8_LAS unsigned char* lds, const Gemm g, const Sched& S, const Epi& E) {
    const int tid = threadIdx.x, wid = __builtin_amdgcn_readfirstlane(tid >> 6), lane = tid & 63, wr = wid >> 2, wc = wid & 3, fr = lane & 15, fq = lane >> 4;
    const int K = g.K, nt = K / BK;
    unsigned voffA[2], voffB[2];
#pragma unroll
    for (int i = 0; i < 2; ++i) { int R, C; stage_rc(tid * 16 + i * 8192, R, C); const int Rb = Epi::PERM ? ((R & ~31) + perm32(R & 31)) : R;
        voffA[i] = (unsigned)(R * K + C) * 2u; voffB[i] = (unsigned)(Rb * K + C) * 2u; }
    const size_t kstep = (size_t)(BK * 2);
    const size_t hstep = (size_t)HALF * K * 2;
    const size_t tstep = 2 * hstep;
    const unsigned ldsw = (unsigned)wid * 1024u;
    const int aoff = lds_byte(wr * 64 + fr, fq * 8), boff = lds_byte(wc * 32 + fr, fq * 8);
#define PG8_SA(b, h) (((b) * 2 + (h)) * HTB)
#define PG8_SB(b, h) ((4 + (b) * 2 + (h)) * HTB)
#define PG8_STAGE(bufoff, gbase, voff) do { _Pragma("unroll") for (int _i = 0; _i < 2; ++_i) \
        __builtin_amdgcn_global_load_lds((const unsigned*)((const char*)(gbase) + (voff)[_i]), (PG8_LAS unsigned*)(lds + (bufoff) + ldsw + _i * 8192), 16, 0, 0); } while (0)
#define PG8_LDA(dst, b, h) do { _Pragma("unroll") for (int m = 0; m < 4; ++m) _Pragma("unroll") for (int k = 0; k < 2; ++k) dst[m][k] = *(const PG8_LAS bf16x8*)(lds + PG8_SA(b, h) + aoff + m * 2048 + k * 1024); } while (0)
#define PG8_LDB(dst, b, h) do { _Pragma("unroll") for (int n = 0; n < 2; ++n) _Pragma("unroll") for (int k = 0; k < 2; ++k) dst[n][k] = *(const PG8_LAS bf16x8*)(lds + PG8_SB(b, h) + boff + n * 2048 + k * 1024); } while (0)
#define PG8_MMA(ai, bj, At, Bt) do { __builtin_amdgcn_s_setprio(1); _Pragma("unroll") for (int m = 0; m < 4; ++m) _Pragma("unroll") for (int n = 0; n < 2; ++n) _Pragma("unroll") for (int k = 0; k < 2; ++k) \
        acc[ai][bj][m][n] = __builtin_amdgcn_mfma_f32_16x16x32_bf16(Bt[n][k], At[m][k], acc[ai][bj][m][n], 0, 0, 0); __builtin_amdgcn_s_setprio(0); } while (0)
#define PG8_WAIT_V(n) asm volatile("s_waitcnt vmcnt(" #n ")" ::: "memory")
#define PG8_WAIT_L(n) asm volatile("s_waitcnt lgkmcnt(" #n ")" ::: "memory")
#define PG8_BAR __builtin_amdgcn_s_barrier()
#define PG8_SCHED __builtin_amdgcn_sched_barrier(0)
    Unit cur, nxt; int ui = 0;
    if (!S.next(0, cur)) return;
    f32x4 acc[2][2][4][2];
#pragma unroll
    for (int a = 0; a < 2; ++a)
#pragma unroll
        for (int b = 0; b < 2; ++b)
#pragma unroll
            for (int m = 0; m < 4; ++m)
#pragma unroll
                for (int n = 0; n < 2; ++n) acc[a][b][m][n] = (f32x4){0.f, 0.f, 0.f, 0.f};
    bf16x8 At[4][2], B0[2][2], B1[2][2];
    const char* cA = (const char*)g.A + (size_t)cur.pm * tstep; const char* cB = (const char*)g.Bt + (size_t)cur.pn * tstep;
    S.a_ready(cur);
    if constexpr (SP2) {
        PG8_STAGE(PG8_SB(0, 0), cB, voffB); PG8_STAGE(PG8_SB(0, 1), cB + hstep, voffB); PG8_STAGE(PG8_SA(0, 0), cA, voffA); PG8_STAGE(PG8_SA(0, 1), cA + hstep, voffA);
        if (wr == 1) PG8_BAR;
        PG8_WAIT_V(2); PG8_BAR;
        PG8_STAGE(PG8_SB(1, 0), cB + kstep, voffB); PG8_STAGE(PG8_SA(1, 0), cA + kstep, voffA); PG8_STAGE(PG8_SB(1, 1), cB + hstep + kstep, voffB);
        PG8_WAIT_V(6); PG8_BAR;
    } else {
        PG8_STAGE(PG8_SB(0, 0), cB, voffB); PG8_STAGE(PG8_SA(0, 0), cA, voffA); PG8_STAGE(PG8_SB(0, 1), cB + hstep, voffB); PG8_STAGE(PG8_SA(0, 1), cA + hstep, voffA);
        if (wr == 1) PG8_BAR;
        PG8_WAIT_V(4); PG8_BAR;
        PG8_STAGE(PG8_SB(1, 0), cB + kstep, voffB); PG8_STAGE(PG8_SA(1, 0), cA + kstep, voffA); PG8_STAGE(PG8_SB(1, 1), cB + hstep + kstep, voffB);
        PG8_WAIT_V(6); PG8_BAR;
    }
    for (;;) {
        const bool has_next = S.next(ui + 1, nxt);
        const char* nA = has_next ? (const char*)g.A + (size_t)nxt.pm * tstep : cA; const char* nB = has_next ? (const char*)g.Bt + (size_t)nxt.pn * tstep : cB;
        for (int t = 0; t < nt; t += 2) {
            const bool last = (t == nt - 2);
            const char* a1 = cA + (size_t)(t + 1) * kstep;
            const char* a2 = last ? nA : cA + (size_t)(t + 2) * kstep; const char* b2 = last ? nB : cB + (size_t)(t + 2) * kstep;
            const char* a3 = a2 + kstep; const char* b3 = b2 + kstep;
            if (last && has_next) S.a_ready(nxt);
            if constexpr (SP2) {
            PG8_LDB(B0, 0, 0); PG8_LDB(B1, 0, 1); PG8_SCHED; PG8_LDA(At, 0, 0); PG8_STAGE(PG8_SA(1, 1), a1 + hstep, voffA);
            PG8_WAIT_V(8); PG8_WAIT_L(0); PG8_BAR; PG8_MMA(0, 0, At, B0); PG8_MMA(0, 1, At, B1); PG8_BAR; PG8_SCHED;
            PG8_LDA(At, 0, 1); PG8_STAGE(PG8_SB(0, 0), b2, voffB); PG8_STAGE(PG8_SB(0, 1), b2 + hstep, voffB); PG8_STAGE(PG8_SA(0, 0), a2, voffA);
            PG8_WAIT_V(8); PG8_WAIT_L(0); PG8_BAR; PG8_MMA(1, 0, At, B0); PG8_MMA(1, 1, At, B1); PG8_BAR; PG8_SCHED;
            PG8_LDB(B0, 1, 0); PG8_LDB(B1, 1, 1); PG8_SCHED; PG8_LDA(At, 1, 0); PG8_STAGE(PG8_SA(0, 1), a2 + hstep, voffA);
            PG8_WAIT_V(8); PG8_WAIT_L(0); PG8_BAR; PG8_MMA(0, 0, At, B0); PG8_MMA(0, 1, At, B1); PG8_BAR; PG8_SCHED;
            PG8_LDA(At, 1, 1); PG8_STAGE(PG8_SB(1, 0), b3, voffB); PG8_STAGE(PG8_SB(1, 1), b3 + hstep, voffB); PG8_STAGE(PG8_SA(1, 0), a3, voffA);
            PG8_WAIT_V(8); PG8_WAIT_L(0); PG8_BAR; PG8_MMA(1, 0, At, B0); PG8_MMA(1, 1, At, B1); PG8_BAR; PG8_SCHED;
            } else {
            PG8_LDB(B0, 0, 0); PG8_SCHED; PG8_LDA(At, 0, 0); PG8_STAGE(PG8_SA(1, 1), a1 + hstep, voffA);
            PG8_WAIT_L(8); PG8_BAR; PG8_WAIT_L(0); PG8_MMA(0, 0, At, B0); PG8_BAR; PG8_SCHED;
            PG8_LDB(B1, 0, 1); PG8_STAGE(PG8_SB(0, 0), b2, voffB);
            PG8_BAR; PG8_WAIT_L(0); PG8_MMA(0, 1, At, B1); PG8_BAR;
            PG8_LDA(At, 0, 1); PG8_STAGE(PG8_SA(0, 0), a2, voffA);
            PG8_BAR; PG8_WAIT_L(0); PG8_MMA(1, 0, At, B0); PG8_BAR; PG8_SCHED;
            PG8_STAGE(PG8_SB(0, 1), b2 + hstep, voffB);
            PG8_WAIT_V(6); PG8_BAR; PG8_MMA(1, 1, At, B1); PG8_BAR;
            PG8_LDB(B0, 1, 0); PG8_SCHED; PG8_LDA(At, 1, 0); PG8_STAGE(PG8_SA(0, 1), a2 + hstep, voffA);
            PG8_WAIT_L(8); PG8_BAR; PG8_WAIT_L(0); PG8_MMA(0, 0, At, B0); PG8_BAR; PG8_SCHED;
            PG8_LDB(B1, 1, 1); PG8_STAGE(PG8_SB(1, 0), b3, voffB);
            PG8_BAR; PG8_WAIT_L(0); PG8_MMA(0, 1, At, B1); PG8_BAR;
            PG8_LDA(At, 1, 1); PG8_STAGE(PG8_SA(1, 0), a3, voffA);
            PG8_BAR; PG8_WAIT_L(0); PG8_MMA(1, 0, At, B0); PG8_BAR; PG8_SCHED;
            PG8_STAGE(PG8_SB(1, 1), b3 + hstep, voffB);
            PG8_WAIT_V(6); PG8_BAR; PG8_MMA(1, 1, At, B1); PG8_BAR;
            }
        }
        if constexpr (ALIGN_EPI) { if (wr == 0) PG8_BAR; }
        if constexpr (!Epi::AFTER_DRAIN) { E(acc, cur, wr, wc, fr, fq); S.done(cur); }
        if (!has_next) break;
#pragma unroll
        for (int a = 0; a < 2; ++a)
#pragma unroll
            for (int b = 0; b < 2; ++b)
#pragma unroll
                for (int m = 0; m < 4; ++m)
#pragma unroll
                    for (int n = 0; n < 2; ++n) acc[a][b][m][n] = (f32x4){0.f, 0.f, 0.f, 0.f};
        cur = nxt; cA = nA; cB = nB; ++ui;
        if constexpr (ALIGN_EPI) { if (wr == 1) PG8_BAR; }
    }
    PG8_WAIT_V(0);
    if constexpr (!ALIGN_EPI) { if (wr == 0) PG8_BAR; }
    PG8_BAR;
    if constexpr (Epi::AFTER_DRAIN) { E.fused(acc, cur, wr, wc, fr, fq, lds, wid, lane); S.done(cur); }
#undef PG8_SA
#undef PG8_SB
#undef PG8_STAGE
#undef PG8_LDA
#undef PG8_LDB
#undef PG8_MMA
#undef PG8_WAIT_V
#undef PG8_WAIT_L
#undef PG8_BAR
#undef PG8_SCHED
}
}

constexpr int NWAVES = 8;
constexpr int SEQ = 4096, DM = 4096, M = 8192, FF = 11008, FF2 = 22016, NAB = 7936;
constexpr float EPS = 1e-6f;
constexpr float LAMBDA_INIT = 0.35550906f;
#ifndef MK_ONE_LAUNCH
#define MK_ONE_LAUNCH 1
#endif
constexpr int N_PHASES = 15;

constexpr size_t MiB = 1u << 20;
constexpr size_t WS_CTL = 0, CTL_ZERO_BYTES = 1 * MiB;
constexpr size_t WS_SS = 262144;
constexpr size_t WS_ROPE = 1 * MiB;
constexpr size_t WS_WABIN = 2 * MiB, WS_WUQ = 64 * MiB, WS_WUKV = 70 * MiB, WS_WABOUT = 74 * MiB, WS_WCIN = 106 * MiB, WS_WCOUT = 202 * MiB;
constexpr size_t WS_WUP0 = 234 * MiB, WS_WUP1 = 406 * MiB, WS_WDN0 = 578 * MiB, WS_WDN1 = 664 * MiB;
constexpr size_t WS_HB = 752 * MiB, WS_H = 816 * MiB, WS_CQ = 944 * MiB, WS_CKV = 960 * MiB, WS_KR = 968 * MiB, WS_SBQ = 970 * MiB, WS_SBK = 1002 * MiB, WS_SBVT = 1034 * MiB;
constexpr size_t WS_QA = 1066 * MiB, WS_KN = 1114 * MiB, WS_VAT = 1146 * MiB, WS_O = 1178 * MiB, WS_UP = 1242 * MiB, WS_ACT = 1586 * MiB;
constexpr size_t WS_CQ1 = 1758 * MiB, WS_CK1 = 1822 * MiB, WS_CVT = 1886 * MiB, WS_DS = 1950 * MiB, WS_DS1 = 2078 * MiB, WS_HEAD = 2206 * MiB, WS_TAIL = 2214 * MiB, WS_END = 2222 * MiB;
static_assert(WS_WABIN + (size_t)NAB * 4096 * 2 <= WS_WUQ && WS_WUP0 + (size_t)FF2 * 4096 * 2 <= WS_WUP1 && WS_WDN1 + (size_t)4096 * FF * 2 <= WS_HB && WS_UP + (size_t)M * FF2 * 2 <= WS_ACT && WS_ACT + (size_t)M * FF * 2 <= WS_CQ1, "d_ws map");
constexpr int CW_KMAX = 2048, CW_QUEUE = 2560;
constexpr int CW_BAR = 4096;

constexpr int RING_OFF = 0, RING_BYTES = 131072;
constexpr int LDSCTL_OFF = 139264, MISC_OFF = LDSCTL_OFF + 320;
constexpr int LDS_BYTES = 147456;

#define GAS __attribute__((address_space(1)))
#define LAS __attribute__((address_space(3)))
typedef unsigned short bf16;
typedef unsigned v4u __attribute__((ext_vector_type(4)));
typedef float f32x4 __attribute__((ext_vector_type(4)));
typedef short bf16x8 __attribute__((ext_vector_type(8)));
typedef GAS unsigned gu32;
#define RLX_AGENT __ATOMIC_RELAXED, __HIP_MEMORY_SCOPE_AGENT
#define LDS_WAIT() asm volatile("s_waitcnt lgkmcnt(0)" ::: "memory")
#define VM_WAIT() asm volatile("s_waitcnt vmcnt(0)" ::: "memory")
__device__ __forceinline__ unsigned f2bf(float f) { unsigned u = __builtin_bit_cast(unsigned, f); return (u + 0x7fffu + ((u >> 16) & 1u)) >> 16; }
__device__ __forceinline__ unsigned pk2(float lo, float hi) { return f2bf(lo) | (f2bf(hi) << 16); }
__device__ __forceinline__ float bf2f(unsigned short b) { return __builtin_bit_cast(float, (unsigned)b << 16); }
__device__ __forceinline__ float bflo(unsigned w) { return __builtin_bit_cast(float, w << 16); }
__device__ __forceinline__ float bfhi(unsigned w) { return __builtin_bit_cast(float, w & 0xffff0000u); }
__device__ __forceinline__ float wave_sum(float v) { return sum_x32(sum_x16(row_sum16(v))); }
__device__ __forceinline__ float wave_max(float v) { return max_x32(max_x16(row_max16(v))); }
#define XB_TMO      128
#define XB_XCNT(j)  (256  + 64 * (j))
#define XB_XSUB(j)  (1280 + 64 * (j))
#define XB_XGEN(j)  (2304 + 64 * (j))
#define XB_TOP      3328
#define XB_TOPGEN   3392
#define XCD_BAR_WORDS 3456
#define XB_SPIN_CAP (1u << 18)

__device__ __forceinline__ unsigned xb_ld(unsigned* p)              { return __hip_atomic_load(p, __ATOMIC_RELAXED, __HIP_MEMORY_SCOPE_AGENT); }
__device__ __forceinline__ unsigned xb_add(unsigned* p, unsigned v) { return __hip_atomic_fetch_add(p, v, __ATOMIC_RELAXED, __HIP_MEMORY_SCOPE_AGENT); }
__device__ __forceinline__ unsigned xb_xcc_id() { return (unsigned)__builtin_amdgcn_s_getreg((3 << 11) | 20) & 0xFu; }
#define XB_SPIN(cond, bar) do { unsigned _sp = 0; while (cond) { __builtin_amdgcn_s_sleep(1); \
    if ((++_sp & 255u) == 0u) { if (xb_ld(&(bar)[XB_TMO])) break; if (_sp > XB_SPIN_CAP) { atomicAdd(&(bar)[XB_TMO], 1u); break; } } } } while (0)

struct XcdBarrier {
    unsigned* bar; unsigned x;
    volatile LAS unsigned* st;
};

__device__ __forceinline__ XcdBarrier xcd_barrier_post(unsigned* bar, volatile LAS unsigned* st) {
    XcdBarrier b; b.bar = bar; b.x = xb_xcc_id(); b.st = st;
    if (threadIdx.x == 0) (void)xb_add(&bar[XB_XCNT(b.x)], 1u);
    return b;
}
__device__ __forceinline__ void xcd_barrier_complete(unsigned* bar, unsigned x, unsigned& nloc, unsigned& nx) {
    const unsigned G = gridDim.x * gridDim.y * gridDim.z;
    unsigned sum, cnt, mine, sp = 0u;
    for (;;) {
        sum = 0u; cnt = 0u; mine = 0u;
#pragma unroll
        for (unsigned j = 0; j < 16; ++j) { const unsigned c = xb_ld(&bar[XB_XCNT(j)]); sum += c; cnt += (c > 0u) ? 1u : 0u; mine = (j == x) ? c : mine; }
        if (sum == G) break;
        __builtin_amdgcn_s_sleep(1);
        if ((++sp & 255u) == 0u) { if (xb_ld(&bar[XB_TMO])) break; if (sp > XB_SPIN_CAP) { atomicAdd(&bar[XB_TMO], 1u); break; } }
    }
    nloc = mine > 0u ? mine : 1u; nx = cnt > 0u ? cnt : 1u;
}

__device__ __forceinline__ void xcd_barrier(const XcdBarrier& b) {
    asm volatile("s_waitcnt vmcnt(0)" ::: "memory");
    __syncthreads();
    if (threadIdx.x == 0) {
        unsigned* bar = b.bar;
        __builtin_amdgcn_s_waitcnt(0);
        unsigned nloc = b.st[0], nx = b.st[1];
        if (nloc == 0u) { xcd_barrier_complete(bar, b.x, nloc, nx); b.st[0] = nloc; b.st[1] = nx; }
        const unsigned old = xb_add(&bar[XB_XSUB(b.x)], 1u);
        const unsigned gen = old / nloc;
        if (old + 1u == (gen + 1u) * nloc) {
            __builtin_amdgcn_fence(__ATOMIC_RELEASE, "agent");
            asm volatile("s_waitcnt vmcnt(0)" ::: "memory");
            const unsigned og = xb_add(&bar[XB_TOP], 1u);
            const unsigned tg = og / nx;
            if (og + 1u == (tg + 1u) * nx) xb_add(&bar[XB_TOPGEN], 1u);
            else XB_SPIN(xb_ld(&bar[XB_TOPGEN]) == tg, bar);
            __builtin_amdgcn_fence(__ATOMIC_ACQUIRE, "agent");
            xb_add(&bar[XB_XGEN(b.x)], 1u);
            asm volatile("s_waitcnt vmcnt(0)" ::: "memory");
        } else {
            XB_SPIN(xb_ld(&bar[XB_XGEN(b.x)]) == gen, bar);
            __builtin_amdgcn_fence(__ATOMIC_ACQUIRE, "agent");
            asm volatile("s_waitcnt vmcnt(0)" ::: "memory");
        }
    }
    __syncthreads();
}

typedef float f32x16 __attribute__((ext_vector_type(16)));
typedef float f32x2v __attribute__((ext_vector_type(2)));
typedef __bf16 bf16x2v __attribute__((ext_vector_type(2)));
#define MFMA32(a, b, c) __builtin_amdgcn_mfma_f32_32x32x16_bf16((a), (b), (c), 0, 0, 0)
__device__ __forceinline__ int swz23(int m) { return (m & ~12) | ((m & 4) << 1) | ((m & 8) >> 1); }
__device__ __forceinline__ unsigned pkbf(float a, float b) { const f32x2v v = {a, b}; return __builtin_bit_cast(unsigned, __builtin_convertvector(v, bf16x2v)); }
__device__ __forceinline__ bf16x8 pack8(const f32x16& x, int c) { v4u w; w.x = pkbf(x[8 * c], x[8 * c + 1]); w.y = pkbf(x[8 * c + 2], x[8 * c + 3]); w.z = pkbf(x[8 * c + 4], x[8 * c + 5]); w.w = pkbf(x[8 * c + 6], x[8 * c + 7]); return __builtin_bit_cast(bf16x8, w); }
__device__ __forceinline__ float xhalf(float v) { return __shfl_xor(v, 32); }

template <int DQK, int DV> struct AttnTile {
    static constexpr int KS = DQK * 2 + 16, VS = 144, KBYTES = 64 * KS, VBYTES = DV * VS, BUF = KBYTES + VBYTES;
    static constexpr int NK = 64 * (DQK / 8) / 512, NV = DV * 8 / 512;
    v4u rk[NK], rv[NV];
    unsigned gk, gk2, gv;
    __device__ __forceinline__ void init(int k_pitch, int tid) { gk = (unsigned)((tid >> 4) * k_pitch + (tid & 15) * 8) * 2u; gk2 = (unsigned)((tid >> 3) * 64 + (tid & 7) * 8) * 2u; gv = (unsigned)((tid >> 3) * 4096 + (tid & 7) * 8) * 2u; }
    __amdgpu_buffer_rsrc_t r1, r2, rv_;
    __device__ __forceinline__ void bind(const bf16* K1, const bf16* K2, const bf16* VT) {
        r1 = __builtin_amdgcn_make_buffer_rsrc((void*)K1, 0, 0x7fffffff, 0x00020000); r2 = __builtin_amdgcn_make_buffer_rsrc((void*)(DQK == 192 ? K2 : K1), 0, 0x7fffffff, 0x00020000);
        rv_ = __builtin_amdgcn_make_buffer_rsrc((void*)VT, 0, 0x7fffffff, 0x00020000); }
    __device__ __forceinline__ void load(int k_pitch, int kt) {
        const int ko = kt * 64 * k_pitch * 2;
        rk[0] = __builtin_amdgcn_raw_buffer_load_b128(r1, gk, ko, 0); rk[1] = __builtin_amdgcn_raw_buffer_load_b128(r1, gk, ko + k_pitch * 64, 0);
        if (DQK == 192) rk[NK - 1] = __builtin_amdgcn_raw_buffer_load_b128(r2, gk2, kt * 64 * 64 * 2, 0);
#pragma unroll
        for (int i = 0; i < NV; ++i) rv[i] = __builtin_amdgcn_raw_buffer_load_b128(rv_, gv, kt * 128 + i * (64 * 4096 * 2), 0);
    }
    __device__ __forceinline__ void store(LAS unsigned char* buf, int tid) const {
#pragma unroll
        for (int i = 0; i < 2; ++i) { const int c = tid + 512 * i, r = c >> 4, cc = c & 15; *(LAS v4u*)(buf + r * KS + cc * 16) = rk[i]; }
        if (DQK == 192) { const int r = tid >> 3, cc = tid & 7; *(LAS v4u*)(buf + r * KS + 256 + cc * 16) = rk[NK - 1]; }
#pragma unroll
        for (int i = 0; i < NV; ++i) { const int c = tid + 512 * i, d = c >> 3, cc = c & 7; *(LAS v4u*)(buf + KBYTES + d * VS + cc * 16) = rv[i]; }
    }
};
template <int DQK> __device__ __forceinline__ void qk_tile(const LAS unsigned char* kb, int KS, const bf16x8 (&qf)[DQK / 16], int lane, f32x16 (&s)[2]) {
    const int h = lane >> 5, kr = swz23(lane & 31);
    f32x16 a0, a1;
#pragma unroll
    for (int i = 0; i < 16; ++i) { a0[i] = 0.f; a1[i] = 0.f; }
    const LAS unsigned char* p0 = kb + kr * KS + h * 16; const LAS unsigned char* p1 = p0 + 32 * KS;
    constexpr int G = DQK / 32;
    bf16x8 f[2][4];
#define QK_LOAD(dst, g) do { dst[0] = *(const LAS bf16x8*)(p0 + (g) * 64); dst[1] = *(const LAS bf16x8*)(p1 + (g) * 64); dst[2] = *(const LAS bf16x8*)(p0 + (g) * 64 + 32); dst[3] = *(const LAS bf16x8*)(p1 + (g) * 64 + 32); } while (0)
    QK_LOAD(f[0], 0);
#pragma unroll
    for (int g = 0; g < G; ++g) {
        if (g + 1 < G) QK_LOAD(f[(g + 1) & 1], g + 1);
        __builtin_amdgcn_sched_barrier(0);
        a0 = MFMA32(f[g & 1][0], qf[2 * g], a0); a1 = MFMA32(f[g & 1][1], qf[2 * g], a1); a0 = MFMA32(f[g & 1][2], qf[2 * g + 1], a0); a1 = MFMA32(f[g & 1][3], qf[2 * g + 1], a1);
        __builtin_amdgcn_sched_barrier(0);
    }
#undef QK_LOAD
    s[0] = a0; s[1] = a1;
}
template <int DV> __device__ __forceinline__ void pv_tile(const LAS unsigned char* vb, const f32x16 (&p)[2], int lane, f32x16 (&o)[DV / 32]) {
    const int h = lane >> 5, dr = swz23(lane & 31);
    bf16x8 pf[4];
#pragma unroll
    for (int g = 0; g < 4; ++g) pf[g] = pack8(p[g >> 1], g & 1);
    const LAS unsigned char* q = vb + dr * 144 + h * 16;
    constexpr int NB = DV / 32;
    bf16x8 f[2][NB];
#define PV_LOAD(dst, g) do { _Pragma("unroll") for (int db = 0; db < NB; ++db) dst[db] = *(const LAS bf16x8*)(q + db * (32 * 144) + (g) * 32); } while (0)
    PV_LOAD(f[0], 0);
#pragma unroll
    for (int g = 0; g < 4; ++g) {
        if (g + 1 < 4) PV_LOAD(f[(g + 1) & 1], g + 1);
        __builtin_amdgcn_sched_barrier(0);
#pragma unroll
        for (int db = 0; db < NB; ++db) o[db] = MFMA32(f[g & 1][db], pf[g], o[db]);
        __builtin_amdgcn_sched_barrier(0);
    }
#undef PV_LOAD
}
__device__ __forceinline__ void store_o8(bf16* p, const f32x16& x, int c, float sc) {
    v4u w; w.x = pkbf(x[8 * c] * sc, x[8 * c + 1] * sc); w.y = pkbf(x[8 * c + 2] * sc, x[8 * c + 3] * sc); w.z = pkbf(x[8 * c + 4] * sc, x[8 * c + 5] * sc); w.w = pkbf(x[8 * c + 6] * sc, x[8 * c + 7] * sc);
    *(GAS v4u*)p = w; }
__device__ __forceinline__ void sb_unit(LAS unsigned char* lds, unsigned char* ws, int bh, int qb, int tid, int wave, int lane) {
    typedef AttnTile<128, 128> T;
    const int b = bh >> 4, hd = bh & 15, q0 = qb * 256, h = lane >> 5, t = q0 + 32 * wave + (lane & 31);
    const bf16* Q = (const bf16*)(ws + WS_SBQ) + (size_t)b * SEQ * 2048 + hd * 128;
    const bf16* K1 = (const bf16*)(ws + WS_SBK) + (size_t)b * SEQ * 2048 + hd * 128;
    const bf16* VT = (const bf16*)(ws + WS_SBVT) + (size_t)bh * 128 * 4096;
    volatile LAS unsigned* flags = (volatile LAS unsigned*)(lds + 2 * T::BUF);
    bf16x8 qf[8];
#pragma unroll
    for (int kk = 0; kk < 8; ++kk) qf[kk] = __builtin_bit_cast(bf16x8, *(const GAS v4u*)(Q + (size_t)t * 2048 + 16 * kk + 8 * h));
    f32x16 o[4];
#pragma unroll
    for (int db = 0; db < 4; ++db)
#pragma unroll
        for (int i = 0; i < 16; ++i) o[db][i] = 0.f;
    float carry = 0.f; bool mydone = false;
    const int kt_hi = (q0 >> 6) + 3, ktw = (q0 >> 6) + (wave >> 1);
    const float scale = 0.08838834764831845f, L2E = 1.4426950408889634f, LN2 = 0.6931471805599453f;
    T tile; tile.init(2048, tid); tile.bind(K1, K1, VT); tile.load(2048, kt_hi); tile.store(lds, tid); __syncthreads();
    int it = 0;
#pragma unroll 1
    for (int kt = kt_hi; kt >= 0; --kt, ++it) {
        const LAS unsigned char* kb = lds + (it & 1) * T::BUF;
        if (kt > 0) tile.load(2048, kt - 1);
        if (kt <= ktw && !mydone) {
            f32x16 s[2]; qk_tile<128>(kb, T::KS, qf, lane, s);
            float tot[2][2];
#pragma unroll
            for (int blk = 0; blk < 2; ++blk)
#pragma unroll
                for (int c = 0; c < 2; ++c) { float run = 0.f;
#pragma unroll
                    for (int j = 7; j >= 0; --j) { const int i = 8 * c + j, key = kt * 64 + 32 * blk + 16 * c + 8 * h + j; const bool valid = key < t;
                        const float z = s[blk][i];
                        const float sp = fmaxf(z, 0.f) + LN2 * __builtin_amdgcn_logf(1.f + __builtin_amdgcn_exp2f(-fabsf(z) * L2E));
                        const float lk = valid ? -sp : 0.f;
                        s[blk][i] = valid ? (z + lk + run) : -INFINITY;
                        run += lk; }
                    tot[blk][c] = run; }
            float par[2][2], off[2][2];
#pragma unroll
            for (int blk = 0; blk < 2; ++blk)
#pragma unroll
                for (int c = 0; c < 2; ++c) par[blk][c] = xhalf(tot[blk][c]);
            float acc = carry;
            off[1][1] = acc + (h == 0 ? par[1][1] : 0.f); acc += tot[1][1] + par[1][1];
            off[1][0] = acc + (h == 0 ? par[1][0] : 0.f); acc += tot[1][0] + par[1][0];
            off[0][1] = acc + (h == 0 ? par[0][1] : 0.f); acc += tot[0][1] + par[0][1];
            off[0][0] = acc + (h == 0 ? par[0][0] : 0.f); acc += tot[0][0] + par[0][0];
            carry = acc;
#pragma unroll
            for (int blk = 0; blk < 2; ++blk)
#pragma unroll
                for (int i = 0; i < 16; ++i) s[blk][i] = __builtin_amdgcn_exp2f((s[blk][i] + off[blk][i >> 3]) * L2E);
            pv_tile<128>(kb + T::KBYTES, s, lane, o);
            mydone = __all(carry < -30.f);
        }
        if (kt > 0) tile.store(lds + ((it + 1) & 1) * T::BUF, tid);
        if (lane == 0) flags[(it & 1) * 8 + wave] = mydone ? 1u : 0u;
        __syncthreads();
        unsigned alld = 1u;
#pragma unroll
        for (int w = 0; w < 8; ++w) alld &= flags[(it & 1) * 8 + w];
        if (alld) break;
    }
    __syncthreads();
    bf16* orow = (bf16*)(ws + WS_O) + (size_t)(b * SEQ + t) * 4096 + 2048 + hd * 128 + 8 * h;
#pragma unroll
    for (int db = 0; db < 4; ++db) { store_o8(orow + 32 * db, o[db], 0, 1.f); store_o8(orow + 32 * db + 16, o[db], 1, 1.f); }
}
template <int DQK, int DV> struct DmaTile {
    static constexpr int KB = 64 * 256, KRB = (DQK == 192) ? 64 * 128 : 0, VB = DV * 128, BUF = KB + KRB + VB, NVW = DV / 64;
    __amdgpu_buffer_rsrc_t r1, r2, rv;
    unsigned gk0, gk1, gk2, gvE, gvO; int kpb;
    __device__ __forceinline__ void init(const bf16* K1, int k_pitch, const bf16* K2, const bf16* VT, int wave, int lane) {
        r1 = __builtin_amdgcn_make_buffer_rsrc((void*)K1, 0, 0x7fffffff, 0x00020000); r2 = __builtin_amdgcn_make_buffer_rsrc((void*)(DQK == 192 ? K2 : K1), 0, 0x7fffffff, 0x00020000);
        rv = __builtin_amdgcn_make_buffer_rsrc((void*)VT, 0, 0x7fffffff, 0x00020000); kpb = k_pitch * 2;
        { const int p = lane & 15, ra = 8 * wave + (lane >> 4), rb = ra + 4; gk0 = (unsigned)(ra * kpb + ((p ^ (ra & 15)) << 4)); gk1 = (unsigned)(rb * kpb + ((p ^ (rb & 15)) << 4)); }
        { const int p = lane & 7, r = 8 * wave + (lane >> 3); gk2 = (unsigned)(r * 128 + ((p ^ ((r >> 1) & 7)) << 4)); }
        { const int p = lane & 7, l3 = lane >> 3, d0 = 8 * wave * NVW + l3; gvE = (unsigned)(d0 * 8192 + ((p ^ (l3 >> 1)) << 4)); gvO = (unsigned)((d0 + 8) * 8192 + ((p ^ (4 + (l3 >> 1))) << 4)); }
    }
    __device__ __forceinline__ void issue(LAS unsigned char* buf, int kt, int wave) const {
        __builtin_amdgcn_raw_ptr_buffer_load_lds(r1, (LAS void*)(buf + wave * 2048), 16, gk0, kt * 64 * kpb, 0, 0);
        __builtin_amdgcn_raw_ptr_buffer_load_lds(r1, (LAS void*)(buf + wave * 2048 + 1024), 16, gk1, kt * 64 * kpb, 0, 0);
        if (DQK == 192) __builtin_amdgcn_raw_ptr_buffer_load_lds(r2, (LAS void*)(buf + KB + wave * 1024), 16, gk2, kt * 64 * 128, 0, 0);
#pragma unroll
        for (int i = 0; i < NVW; ++i) __builtin_amdgcn_raw_ptr_buffer_load_lds(rv, (LAS void*)(buf + KB + KRB + (wave * NVW + i) * 1024), 16, (i & 1) ? gvO : gvE, kt * 128 + (i >> 1) * (16 * 8192), 0, 0);
    }
};
template <int DQK> __device__ __forceinline__ void qk_tile2(const LAS unsigned char* kb, const bf16x8 (&qf)[DQK / 16], int lane_, f32x16 (&s)[2]) {
    int lane = lane_; asm volatile("" : "+v"(lane));
    const int h = lane >> 5, r = swz23(lane & 31), y = h ^ (r & 15), yr = h ^ ((r >> 1) & 7);
    const LAS unsigned char* p0 = kb + r * 256; const LAS unsigned char* pr = kb + 64 * 256 + r * 128;
    f32x16 a0, a1;
#pragma unroll
    for (int i = 0; i < 16; ++i) { a0[i] = 0.f; a1[i] = 0.f; }
    bf16x8 f[2][2];
#define QK2_LOAD(dst, kk) do { if ((kk) < 8) { const LAS unsigned char* q_ = p0 + ((y ^ (2 * (kk))) << 4); dst[0] = *(const LAS bf16x8*)q_; dst[1] = *(const LAS bf16x8*)(q_ + 32 * 256); } \
                               else { const LAS unsigned char* q_ = pr + ((yr ^ (2 * ((kk) - 8))) << 4); dst[0] = *(const LAS bf16x8*)q_; dst[1] = *(const LAS bf16x8*)(q_ + 32 * 128); } } while (0)
    QK2_LOAD(f[0], 0);
#pragma unroll
    for (int kk = 0; kk < DQK / 16; ++kk) {
        if (kk + 1 < DQK / 16) QK2_LOAD(f[(kk + 1) & 1], kk + 1);
        __builtin_amdgcn_sched_barrier(0);
        a0 = MFMA32(f[kk & 1][0], qf[kk], a0); a1 = MFMA32(f[kk & 1][1], qf[kk], a1);
        __builtin_amdgcn_sched_barrier(0);
    }
#undef QK2_LOAD
    s[0] = a0; s[1] = a1;
}
constexpr float LAZY_T = 8.f;
constexpr float EXIT_T = 40.f;
__device__ __forceinline__ float xmax_half(float v) {
    return max_x32(v); }
template <int DV> __device__ __forceinline__ void pv_tile2p(const LAS unsigned char* vb, const bf16x8 (&pf)[4], int lane_, f32x16 (&o)[DV / 32]) {
    int lane = lane_; asm volatile("" : "+v"(lane));
    const int h = lane >> 5, dr = swz23(lane & 31), yv = h ^ ((dr >> 1) & 7);
    const LAS unsigned char* q = vb + dr * 128;
    constexpr int NB = DV / 32, W = (DV == 256) ? 2 : 4, SPG = NB / W, NS = 4 * SPG;
    bf16x8 f[2][W];
#define PV2_LOAD(dst, st) do { const int g_ = (st) / SPG, b0_ = W * ((st) % SPG); const LAS unsigned char* q_ = q + ((yv ^ (2 * g_)) << 4) + b0_ * 4096; \
        _Pragma("unroll") for (int j = 0; j < W; ++j) dst[j] = *(const LAS bf16x8*)(q_ + j * 4096); } while (0)
    PV2_LOAD(f[0], 0);
#pragma unroll
    for (int st = 0; st < NS; ++st) {
        if (st + 1 < NS) PV2_LOAD(f[(st + 1) & 1], st + 1);
        __builtin_amdgcn_sched_barrier(0);
#pragma unroll
        for (int j = 0; j < W; ++j) o[W * (st % SPG) + j] = MFMA32(f[st & 1][j], pf[st / SPG], o[W * (st % SPG) + j]);
        __builtin_amdgcn_sched_barrier(0);
    }
#undef PV2_LOAD
}
template <int DV, bool ALIBI> __device__ __forceinline__ float softmax_step(f32x16 (&s)[2], bool past, float tb, float slope_l2, float& mrow, float& lrow, f32x16 (&o)[DV / 32], bf16x8 (&pf)[4]) {
    if (ALIBI) {
        if (past) {
#pragma unroll
            for (int blk = 0; blk < 2; ++blk)
#pragma unroll
                for (int i = 0; i < 16; ++i) s[blk][i] = fmaf(-slope_l2, tb - (float)(32 * blk + 16 * (i >> 3) + (i & 7)), s[blk][i]);
        } else {
#pragma unroll
            for (int blk = 0; blk < 2; ++blk)
#pragma unroll
                for (int i = 0; i < 16; ++i) s[blk][i] = fmaf(-slope_l2, fabsf(tb - (float)(32 * blk + 16 * (i >> 3) + (i & 7))), s[blk][i]); } }
    float mx = fmaxf(fmaxf(s[0][0], s[0][1]), s[1][0]);
#pragma unroll
    for (int i = 2; i < 16; i += 2) mx = fmaxf(fmaxf(mx, s[0][i]), s[0][i + 1]);
#pragma unroll
    for (int i = 1; i < 15; i += 2) mx = fmaxf(fmaxf(mx, s[1][i]), s[1][i + 1]);
    mx = fmaxf(mx, s[1][15]);
    mx = xmax_half(mx);
    const bool chg = mx > mrow + LAZY_T; const float mnew = chg ? mx : mrow, alpha = (chg && mrow > -INFINITY) ? __builtin_amdgcn_exp2f(mrow - mnew) : 1.f; mrow = mnew;
    const f32x2v mn2 = {mnew, mnew}; f32x2v rs2 = {0.f, 0.f};
#pragma unroll
    for (int blk = 0; blk < 2; ++blk)
#pragma unroll
        for (int i = 0; i < 16; i += 2) { f32x2v x = {s[blk][i], s[blk][i + 1]}; x = x - mn2; x[0] = __builtin_amdgcn_exp2f(x[0]); x[1] = __builtin_amdgcn_exp2f(x[1]); rs2 = rs2 + x; s[blk][i] = x[0]; s[blk][i + 1] = x[1]; }
    lrow = lrow * alpha + (rs2[0] + rs2[1]);
    if (__any(alpha != 1.f)) {
#pragma unroll
        for (int db = 0; db < DV / 32; ++db) o[db] = o[db] * alpha; }
#pragma unroll
    for (int g = 0; g < 4; ++g) pf[g] = pack8(s[g >> 1], g & 1);
    return alpha;
}
template <int DQK, int DV, bool ALIBI>
__device__ __forceinline__ void attn4_softmax_unit(LAS unsigned char* lds, const bf16* Q, int q_pitch, const bf16* K1, int k_pitch, const bf16* K2, const bf16* VT, float slope_l2, int q0,
                                                   int wave, int lane, f32x16 (&o)[DV / 32], float& l_out) {
    typedef DmaTile<DQK, DV> T;
    const int h = lane >> 5, t = q0 + 32 * wave + (lane & 31);
    bf16x8 qf[DQK / 16];
#pragma unroll
    for (int kk = 0; kk < DQK / 16; ++kk) qf[kk] = __builtin_bit_cast(bf16x8, *(const GAS v4u*)(Q + (size_t)t * q_pitch + 16 * kk + 8 * h));
#pragma unroll
    for (int db = 0; db < DV / 32; ++db)
#pragma unroll
        for (int i = 0; i < 16; ++i) o[db][i] = 0.f;
    float mrow = -INFINITY, lrow = 0.f;
    const int ntiles = (q0 >> 6) + 4, ktw = (q0 >> 6) + (wave >> 1);
    bf16x8 pf[4];
#pragma unroll
    for (int g = 0; g < 4; ++g) pf[g] = (bf16x8){0, 0, 0, 0, 0, 0, 0, 0};
    T tile; tile.init(K1, k_pitch, K2, VT, wave, lane); tile.issue(lds, 0, wave);
    asm volatile("s_waitcnt vmcnt(0) lgkmcnt(0)\n\ts_barrier" ::: "memory");
    int bi = 0;
#pragma unroll 1
    for (int kt = 0; kt < ntiles; ++kt) {
        const int bn = bi == 2 ? 0 : bi + 1, bp = bi == 0 ? 2 : bi - 1;
        const LAS unsigned char* kb = lds + bi * T::BUF;
        if (kt + 1 < ntiles) tile.issue(lds + bn * T::BUF, kt + 1, wave);
        const float tb = (float)(t - kt * 64 - 8 * h);
        const bool isB = wave >= 4;
        if (isB && kt >= 1 && kt - 1 <= ktw) pv_tile2p<DV>(lds + bp * T::BUF + T::KB + T::KRB, pf, lane, o);
        if (kt <= ktw) { f32x16 s[2]; qk_tile2<DQK>(kb, qf, lane, s); softmax_step<DV, ALIBI>(s, kt < ktw, tb, slope_l2, mrow, lrow, o, pf); }
        if (!isB && kt <= ktw) pv_tile2p<DV>(kb + T::KB + T::KRB, pf, lane, o);
        asm volatile("s_waitcnt vmcnt(0) lgkmcnt(0)\n\ts_barrier" ::: "memory");
        bi = bn;
    }
    if (wave >= 4 && ntiles - 1 <= ktw) pv_tile2p<DV>(lds + (bi == 0 ? 2 : bi - 1) * T::BUF + T::KB + T::KRB, pf, lane, o);
    asm volatile("s_waitcnt lgkmcnt(0)\n\ts_barrier" ::: "memory");
    l_out = lrow + xhalf(lrow);
}
constexpr int PC_FLG = 136192;
template <bool ALIBI> __device__ __forceinline__ float softmax_step_p(f32x16 (&s)[2], bool past, float tb, float slope_l2, float& mrow, float& lrow, bf16x8 (&pf)[4]) {
    if (ALIBI) {
        if (past) {
#pragma unroll
            for (int blk = 0; blk < 2; ++blk)
#pragma unroll
                for (int i = 0; i < 16; ++i) s[blk][i] = fmaf(-slope_l2, tb - (float)(32 * blk + 16 * (i >> 3) + (i & 7)), s[blk][i]);
        } else {
#pragma unroll
            for (int blk = 0; blk < 2; ++blk)
#pragma unroll
                for (int i = 0; i < 16; ++i) s[blk][i] = fmaf(-slope_l2, fabsf(tb - (float)(32 * blk + 16 * (i >> 3) + (i & 7))), s[blk][i]); } }
    float mx = fmaxf(fmaxf(s[0][0], s[0][1]), s[1][0]);
#pragma unroll
    for (int i = 2; i < 16; i += 2) mx = fmaxf(fmaxf(mx, s[0][i]), s[0][i + 1]);
#pragma unroll
    for (int i = 1; i < 15; i += 2) mx = fmaxf(fmaxf(mx, s[1][i]), s[1][i + 1]);
    mx = fmaxf(mx, s[1][15]);
    mx = xmax_half(mx);
    const bool chg = mx > mrow + LAZY_T; const float mnew = chg ? mx : mrow, alpha = (chg && mrow > -INFINITY) ? __builtin_amdgcn_exp2f(mrow - mnew) : 1.f; mrow = mnew;
    const f32x2v mn2 = {mnew, mnew}; f32x2v rs2 = {0.f, 0.f};
#pragma unroll
    for (int blk = 0; blk < 2; ++blk)
#pragma unroll
        for (int i = 0; i < 16; i += 2) { f32x2v x = {s[blk][i], s[blk][i + 1]}; x = x - mn2; x[0] = __builtin_amdgcn_exp2f(x[0]); x[1] = __builtin_amdgcn_exp2f(x[1]); rs2 = rs2 + x; s[blk][i] = x[0]; s[blk][i + 1] = x[1]; }
    lrow = lrow * alpha + (rs2[0] + rs2[1]);
#pragma unroll
    for (int g = 0; g < 4; ++g) pf[g] = pack8(s[g >> 1], g & 1);
    return alpha;
}
__device__ __forceinline__ void pv_tile256_deep(const LAS unsigned char* vb, const bf16x8 (&pf)[4], int lane_, f32x16 (&o)[8]) {
    int lane = lane_; asm volatile("" : "+v"(lane));
    const int h = lane >> 5, dr = swz23(lane & 31), yv = h ^ ((dr >> 1) & 7);
    const LAS unsigned char* q = vb + dr * 128;
    bf16x8 f[3][4];
#define PVD_LOAD(dst, st) do { const int g_ = (st) >> 1, b0_ = 4 * ((st) & 1); const LAS unsigned char* q_ = q + ((yv ^ (2 * g_)) << 4) + b0_ * 4096; \
        _Pragma("unroll") for (int j = 0; j < 4; ++j) dst[j] = *(const LAS bf16x8*)(q_ + j * 4096); } while (0)
    PVD_LOAD(f[0], 0); PVD_LOAD(f[1], 1);
#pragma unroll
    for (int st = 0; st < 8; ++st) {
        if (st + 2 < 8) PVD_LOAD(f[(st + 2) % 3], st + 2);
        __builtin_amdgcn_sched_barrier(0);
#pragma unroll
        for (int j = 0; j < 4; ++j) o[4 * (st & 1) + j] = MFMA32(f[st % 3][j], pf[st >> 1], o[4 * (st & 1) + j]);
        __builtin_amdgcn_sched_barrier(0);
    }
#undef PVD_LOAD
}
__device__ __forceinline__ void qk_tile128_deep(const LAS unsigned char* kb, const bf16x8 (&qf)[8], int lane_, f32x16 (&s)[2]) {
    int lane = lane_; asm volatile("" : "+v"(lane));
    const int h = lane >> 5, r = swz23(lane & 31), y = h ^ (r & 15);
    const LAS unsigned char* p0 = kb + r * 256;
    f32x16 a0, a1;
#pragma unroll
    for (int i = 0; i < 16; ++i) { a0[i] = 0.f; a1[i] = 0.f; }
    bf16x8 f[4][2];
#define QKD_LOAD(dst, kk) do { const LAS unsigned char* q_ = p0 + ((y ^ (2 * (kk))) << 4); dst[0] = *(const LAS bf16x8*)q_; dst[1] = *(const LAS bf16x8*)(q_ + 32 * 256); } while (0)
    QKD_LOAD(f[0], 0); QKD_LOAD(f[1], 1); QKD_LOAD(f[2], 2);
#pragma unroll
    for (int kk = 0; kk < 8; ++kk) {
        if (kk + 3 < 8) QKD_LOAD(f[(kk + 3) & 3], kk + 3);
        __builtin_amdgcn_sched_barrier(0);
        a0 = MFMA32(f[kk & 3][0], qf[kk], a0); a1 = MFMA32(f[kk & 3][1], qf[kk], a1);
        __builtin_amdgcn_sched_barrier(0);
    }
#undef QKD_LOAD
    s[0] = a0; s[1] = a1;
}
constexpr int PE_K = 0, PE_V = 32768, PE_P = 98304, PE_PBLK = 4352, PE_L = 133120, PE_FLG = 135168;
#ifndef DIAG_P9
#define DIAG_P9 0
#endif
__device__ __forceinline__ void diff_unit_pc5(LAS unsigned char* lds, unsigned char* ws, const float* subln, float lam, const unsigned* kmaxw, int bh, int qb128, int wave, int lane) {
    const int b = bh >> 4, hd = bh & 15, q0 = qb128 * 128, h = lane >> 5, rg = wave & 3; const bool isA = wave < 4;
    const int t = q0 + 32 * rg + (lane & 31);
    const int ntiles = (q0 >> 6) + 2, ktw = (q0 >> 6) + (rg >> 1), kt_hi = ntiles - 1;
    const float slope_l2 = __builtin_amdgcn_exp2f(-0.5f * (float)(hd + 1)) * 1.4426950408889634f;
    const bf16* VT = (const bf16*)(ws + WS_CVT) + (size_t)bh * 256 * 4096;
    const __amdgpu_buffer_rsrc_t rv = __builtin_amdgcn_make_buffer_rsrc((void*)VT, 0, 0x7fffffff, 0x00020000);
    volatile LAS unsigned* flg = (volatile LAS unsigned*)(lds + PE_FLG);
    unsigned gk0, gk1, gvE, gvO;
    { const int p = lane & 15, ra = 8 * wave + (lane >> 4), rb = ra + 4; gk0 = (unsigned)(ra * 8192 + ((p ^ (ra & 15)) << 4)); gk1 = (unsigned)(rb * 8192 + ((p ^ (rb & 15)) << 4)); }
    { const int p = lane & 7, l3 = lane >> 3, d0 = 32 * wave + l3; gvE = (unsigned)(d0 * 8192 + ((p ^ (l3 >> 1)) << 4)); gvO = (unsigned)((d0 + 8) * 8192 + ((p ^ (4 + (l3 >> 1))) << 4)); }
#define PE_ISSUE_K(kt_) do { LAS unsigned char* d_ = lds + PE_K + ((kt_) & 1) * 16384 + wave * 2048; \
    __builtin_amdgcn_raw_ptr_buffer_load_lds(rk, (LAS void*)d_, 16, gk0, (kt_) * 64 * 8192, 0, 0); __builtin_amdgcn_raw_ptr_buffer_load_lds(rk, (LAS void*)(d_ + 1024), 16, gk1, (kt_) * 64 * 8192, 0, 0); } while (0)
#define PE_ISSUE_V(kt_, ib_) do { LAS unsigned char* d_ = lds + PE_V + ((ib_) & 1) * 32768 + wave * 4096; \
    __builtin_amdgcn_raw_ptr_buffer_load_lds(rv, (LAS void*)d_, 16, gvE, (kt_) * 128, 0, 0); __builtin_amdgcn_raw_ptr_buffer_load_lds(rv, (LAS void*)(d_ + 1024), 16, gvO, (kt_) * 128, 0, 0); \
    __builtin_amdgcn_raw_ptr_buffer_load_lds(rv, (LAS void*)(d_ + 2048), 16, gvE, (kt_) * 128 + 16 * 8192, 0, 0); __builtin_amdgcn_raw_ptr_buffer_load_lds(rv, (LAS void*)(d_ + 3072), 16, gvO, (kt_) * 128 + 16 * 8192, 0, 0); } while (0)
#define PE_BAR() asm volatile("s_waitcnt vmcnt(0) lgkmcnt(0)\n\ts_barrier" ::: "memory")
#define PE_FIN(it_) ((flg[((it_) & 1) * 8 + 4] & flg[((it_) & 1) * 8 + 5] & flg[((it_) & 1) * 8 + 6] & flg[((it_) & 1) * 8 + 7]) != 0u)
#pragma unroll 1
    for (int mp = 0; mp < 2; ++mp) {
        const bf16* K1 = (const bf16*)(ws + WS_CK1) + (size_t)b * SEQ * 4096 + (2 * hd + mp) * 128;
        const __amdgpu_buffer_rsrc_t rk = __builtin_amdgcn_make_buffer_rsrc((void*)K1, 0, 0x7fffffff, 0x00020000);
        if (isA) {
            const bf16* Q = (const bf16*)(ws + WS_CQ1) + (size_t)b * SEQ * 4096 + (2 * hd + mp) * 128;
            const __amdgpu_buffer_rsrc_t rq = __builtin_amdgcn_make_buffer_rsrc((void*)Q, 0, 0x7fffffff, 0x00020000); const int qoff = t * 8192 + h * 16;
            PE_ISSUE_K(kt_hi); PE_ISSUE_K(kt_hi - 1);
            bf16x8 qf[8];
#pragma unroll
            for (int kk = 0; kk < 8; ++kk) qf[kk] = __builtin_bit_cast(bf16x8, __builtin_amdgcn_raw_buffer_load_b128(rq, qoff, 32 * kk, 0));
            float bq;
            { float qn = 0.f;
#pragma unroll
              for (int kk = 0; kk < 8; ++kk) { const v4u w = __builtin_bit_cast(v4u, qf[kk]); qn += bflo(w.x) * bflo(w.x) + bfhi(w.x) * bfhi(w.x) + bflo(w.y) * bflo(w.y) + bfhi(w.y) * bfhi(w.y) + bflo(w.z) * bflo(w.z) + bfhi(w.z) * bfhi(w.z) + bflo(w.w) * bflo(w.w) + bfhi(w.w) * bfhi(w.w); }
              qn += xhalf(qn);
              const unsigned* km = kmaxw + ((b * 32 + 2 * hd + mp) * 4);
              const float k2 = (__builtin_bit_cast(float, km[0]) + __builtin_bit_cast(float, km[1])) + (__builtin_bit_cast(float, km[2]) + __builtin_bit_cast(float, km[3]));
              bq = sqrtf(qn * k2 * 1.03f) + 1.f; }
            float mrow = -INFINITY, lrow = 0.f; bool mydone = false, fin = false;
            PE_BAR();
            f32x16 s[2];
#pragma unroll
            for (int i = 0; i < 16; ++i) { s[0][i] = 0.f; s[1][i] = 0.f; }
            if (kt_hi <= ktw) qk_tile128_deep(lds + PE_K + (kt_hi & 1) * 16384, qf, lane, s);
            PE_BAR();
#pragma unroll 1
            for (int it = 0, kt = kt_hi; ; ++it, --kt) {
                if (!fin) { if (kt >= 2) PE_ISSUE_K(kt - 2); if (kt >= 0) PE_ISSUE_V(kt, it); }
                bool pub = false, resc = false;
                if (!fin && kt >= 0 && kt <= ktw && !mydone) {
                    bf16x8 pf[4];
                    const float alpha = softmax_step_p<true>(s, kt < ktw, (float)(t - kt * 64 - 8 * h), slope_l2, mrow, lrow, pf);
                    LAS unsigned char* pb = lds + PE_P + ((it & 1) * 4 + rg) * PE_PBLK;
#pragma unroll
                    for (int g = 0; g < 4; ++g) *(LAS bf16x8*)(pb + g * 1024 + lane * 16) = pf[g];
                    *(LAS float*)(pb + 4096 + lane * 4) = alpha;
                    pub = true; resc = __any(alpha != 1.f);
                    mydone = __all(bq - slope_l2 * (float)(t - 64 * kt + 1) - mrow < -EXIT_T);
                }
                if (!fin && kt >= 1 && kt - 1 <= ktw && !mydone) qk_tile128_deep(lds + PE_K + ((kt - 1) & 1) * 16384, qf, lane, s);
                if (lane == 0) { flg[(it & 1) * 8 + rg] = pub ? (resc ? 3u : 1u) : 0u; flg[(it & 1) * 8 + 4 + rg] = (mydone || kt <= 0) ? 1u : 0u; }
                PE_BAR();
                if (fin) break;
                fin = PE_FIN(it);
            }
            { const float lt = lrow + xhalf(lrow); *(LAS float*)(lds + PE_L + (mp * 4 + rg) * 256 + lane * 4) = lt; }
            if (mp) PE_BAR();
        } else {
            f32x16 o[8];
#pragma unroll
            for (int db = 0; db < 8; ++db)
#pragma unroll
                for (int i = 0; i < 16; ++i) o[db][i] = 0.f;
            bool fin = false;
            PE_ISSUE_K(kt_hi); PE_ISSUE_K(kt_hi - 1);
            PE_BAR();
            PE_BAR();
#pragma unroll 1
            for (int it = 0, kt = kt_hi; ; ++it, --kt) {
                if (!fin) { if (kt >= 2) PE_ISSUE_K(kt - 2); if (kt >= 0) PE_ISSUE_V(kt, it); }
                const unsigned pfl = it >= 1 ? flg[((it - 1) & 1) * 8 + rg] : 0u;
                if (pfl != 0u) {
                    const LAS unsigned char* pb = lds + PE_P + (((it - 1) & 1) * 4 + rg) * PE_PBLK; bf16x8 pf[4];
#pragma unroll
                    for (int g = 0; g < 4; ++g) pf[g] = *(const LAS bf16x8*)(pb + g * 1024 + lane * 16);
                    if (pfl & 2u) { const float alpha = *(const LAS float*)(pb + 4096 + lane * 4);
#pragma unroll
                        for (int db = 0; db < 8; ++db) o[db] = o[db] * alpha; }
                    pv_tile256_deep(lds + PE_V + ((it - 1) & 1) * 32768, pf, lane, o);
                }
                PE_BAR();
                if (fin) break;
                fin = PE_FIN(it);
            }
            { const __amdgpu_buffer_rsrc_t rds = __builtin_amdgcn_make_buffer_rsrc((void*)(ws + (mp ? WS_DS1 : WS_DS)), 0, 0x7fffffff, 0x00020000);
              const int dso = (((b * SEQ + t) * 16 + hd) * 256 + 8 * h) * 2;
#pragma unroll
              for (int db = 0; db < 8; ++db)
#pragma unroll
                  for (int c = 0; c < 2; ++c) { v4u w; w.x = pkbf(o[db][8 * c], o[db][8 * c + 1]); w.y = pkbf(o[db][8 * c + 2], o[db][8 * c + 3]); w.z = pkbf(o[db][8 * c + 4], o[db][8 * c + 5]); w.w = pkbf(o[db][8 * c + 6], o[db][8 * c + 7]);
                      __builtin_amdgcn_raw_buffer_store_b128(w, rds, dso, (32 * db + 16 * c) * 2, 0); } }
            if (mp) PE_BAR();
        }
    }
    {   const bf16* S0 = (const bf16*)(ws + WS_DS); const bf16* S1 = (const bf16*)(ws + WS_DS1); bf16* O = (bf16*)(ws + WS_O);
        int lnf = lane; asm volatile("" : "+v"(lnf));
        const f32x4 g4 = *(const GAS f32x4*)(subln + 4 * lnf);
        const __amdgpu_buffer_rsrc_t rs0 = __builtin_amdgcn_make_buffer_rsrc((void*)S0, 0, 0x7fffffff, 0x00020000), rs1 = __builtin_amdgcn_make_buffer_rsrc((void*)S1, 0, 0x7fffffff, 0x00020000);
        const __amdgpu_buffer_rsrc_t ro = __builtin_amdgcn_make_buffer_rsrc((void*)O, 0, 0x7fffffff, 0x00020000);
        const int fo = ((((b * SEQ + q0 + 16 * wave) * 16 + hd) * 256) + 4 * lnf) * 2;
        const int oo = ((b * SEQ + q0 + 16 * wave) * 4096 + hd * 256 + 4 * lnf) * 2;
        typedef unsigned v2u __attribute__((ext_vector_type(2)));
#pragma unroll 1
        for (int hb = 0; hb < 2; ++hb) {
        v2u aw[8], cw[8];
#pragma unroll
        for (int rr = 0; rr < 8; ++rr) { aw[rr] = __builtin_amdgcn_raw_buffer_load_b64(rs0, fo, (8 * hb + rr) * 8192, 0); cw[rr] = __builtin_amdgcn_raw_buffer_load_b64(rs1, fo, (8 * hb + rr) * 8192, 0); }
#pragma unroll
        for (int rr = 0; rr < 8; ++rr) { const int r = 16 * wave + 8 * hb + rr;
            const float l0 = *(const LAS float*)(lds + PE_L + (0 * 4 + (r >> 5)) * 256 + (r & 31) * 4), l1 = *(const LAS float*)(lds + PE_L + (1 * 4 + (r >> 5)) * 256 + (r & 31) * 4);
            const f32x4 a = {bflo(aw[rr].x), bfhi(aw[rr].x), bflo(aw[rr].y), bfhi(aw[rr].y)}, c = {bflo(cw[rr].x), bfhi(cw[rr].x), bflo(cw[rr].y), bfhi(cw[rr].y)};
            const float i0 = __builtin_amdgcn_rcpf(l0), i1 = lam * __builtin_amdgcn_rcpf(l1);
            const f32x4 x = a * i0 - c * i1;
            const float ss = wave_sum((x[0] * x[0] + x[1] * x[1]) + (x[2] * x[2] + x[3] * x[3]));
            const float rn = rsqrtf(ss * (1.f / 256.f) + EPS) * (1.f - LAMBDA_INIT);
            const f32x4 y = x * rn * g4;
            v2u w; w.x = pkbf(y[0], y[1]); w.y = pkbf(y[2], y[3]);
            __builtin_amdgcn_raw_buffer_store_b64(w, ro, oo, (8 * hb + rr) * 8192, 0); }
        }
    }
    PE_BAR();
#undef PE_ISSUE_K
#undef PE_ISSUE_V
#undef PE_BAR
#undef PE_FIN
}
__device__ __forceinline__ void mla_unit2(LAS unsigned char* lds, unsigned char* ws, int bh, int qb, int wave, int lane) {
    const int b = bh >> 4, hd = bh & 15, q0 = qb * 256;
    const bf16* Q = (const bf16*)(ws + WS_QA) + (size_t)b * SEQ * 3072 + hd * 192;
    const bf16* K1 = (const bf16*)(ws + WS_KN) + (size_t)b * SEQ * 2048 + hd * 128;
    const bf16* K2 = (const bf16*)(ws + WS_KR) + (size_t)b * SEQ * 64;
    const bf16* VT = (const bf16*)(ws + WS_VAT) + (size_t)bh * 128 * 4096;
    f32x16 o[4]; float l;
    attn4_softmax_unit<192, 128, false>(lds, Q, 3072, K1, 2048, K2, VT, 0.f, q0, wave, lane, o, l);
    const float il = 1.f / l; const int t = q0 + 32 * wave + (lane & 31), h = lane >> 5;
    bf16* orow = (bf16*)(ws + WS_O) + (size_t)(b * SEQ + t) * 4096 + hd * 128 + 8 * h;
#pragma unroll
    for (int db = 0; db < 4; ++db) { store_o8(orow + 32 * db, o[db], 0, il); store_o8(orow + 32 * db + 16, o[db], 1, il); }
}

template <int MAP> __device__ __forceinline__ int dst_row(int n) {
    if (MAP == 1) {
        if (n < 1536) return n;
        if (n < 1600) { const int i = n - 1536; return 1536 + (i < 32 ? 2 * i : 2 * (i - 32) + 1); }
        return n + 192; }
    if (MAP == 2) {
        const int h = n / 192, j = n - h * 192; if (j < 128) return n; const int r = j - 128; return h * 192 + 128 + (r < 32 ? 2 * r : 2 * (r - 32) + 1); }
    if (MAP == 3) {
        const int h = n >> 8, j = n & 255; return j < 128 ? h * 128 + j : 2048 + h * 128 + (j - 128); }
    if (MAP == 4) {
        const int c = n < 11008 ? n : n - 11008; return (c >> 7) * 256 + (n < 11008 ? 0 : 128) + (c & 127); }
    return n;
}
struct TItem { f32x4 v[8]; };
template <int MAP> __device__ __forceinline__ void transpose_load(TItem& it, const float* W, int K, int N, const float* gain, int item, int lane) {
    const int nblk = N / 32, kb = item / nblk, nb = item - kb * nblk, k0 = 64 * kb, n0 = 32 * nb; const int nq = lane & 7, kq = lane >> 3;
#pragma unroll
    for (int i = 0; i < 8; ++i) { const int kk = 8 * i + kq; const f32x4 v = *(const GAS f32x4*)(W + (size_t)(k0 + kk) * N + n0 + 4 * nq); const float g = gain ? gain[k0 + kk] : 1.f; it.v[i] = v * g; }
}
template <int MAP> __device__ __forceinline__ void transpose_finish(const TItem& it, int K, int N, bf16* WT, LAS float* scr, int item, int lane) {
    const int nblk = N / 32, kb = item / nblk, nb = item - kb * nblk, k0 = 64 * kb, n0 = 32 * nb; const int nq = lane & 7, kq = lane >> 3;
#pragma unroll
    for (int i = 0; i < 8; ++i) { const int kk = 8 * i + kq; LAS float* d = scr + kk * 33 + 4 * nq; d[0] = it.v[i][0]; d[1] = it.v[i][1]; d[2] = it.v[i][2]; d[3] = it.v[i][3]; }
    LDS_WAIT(); asm volatile("" ::: "memory");
    const int c = lane & 7;
#pragma unroll
    for (int p = 0; p < 4; ++p) { const int n = (lane >> 3) + 8 * p; const LAS float* s = scr + (8 * c) * 33 + n;
        v4u o; o.x = pkbf(s[0 * 33], s[1 * 33]); o.y = pkbf(s[2 * 33], s[3 * 33]); o.z = pkbf(s[4 * 33], s[5 * 33]); o.w = pkbf(s[6 * 33], s[7 * 33]);
        *(GAS v4u*)(WT + (size_t)dst_row<MAP>(n0 + n) * K + k0 + 8 * c) = o; }
    LDS_WAIT(); asm volatile("" ::: "memory");
}
template <int MAP> __device__ __forceinline__ void transpose_matrix(const float* W, int K, int N, const float* gain, bf16* WT, LAS float* scr, int first, int n_items, int NGW, int lane) {
    if (first >= n_items) return;
    TItem cur, nxt; transpose_load<MAP>(cur, W, K, N, gain, first, lane);
    for (int it = first; it < n_items; it += NGW) {
        const bool more = it + NGW < n_items;
        if (more) transpose_load<MAP>(nxt, W, K, N, gain, it + NGW, lane);
        transpose_finish<MAP>(cur, K, N, WT, scr, it, lane);
        if (more) cur = nxt;
    }
}
struct P {
    const float *x, *norm_mix, *norm_ffn, *norm_final, *ab_w_in, *ab_q_norm, *ab_w_uq, *ab_kv_norm, *ab_w_ukv, *ab_w_out, *c_w_in, *lq1, *lk1, *lq2, *lk2, *subln, *c_w_out, *w_up, *conv_w, *conv_b, *w_down;
    float* out; unsigned char* ws;
};

typedef const __attribute__((address_space(4))) P* KP;
__device__ __forceinline__ KP kargs() { KP k = (KP)__builtin_amdgcn_kernarg_segment_ptr(); asm volatile("" : "+s"(k)); return k; }
__device__ __forceinline__ void p0_prologue(KP pp, LAS unsigned char* lds, int gw, int NGW, int wave, int lane) {
    unsigned char* ws = pp->ws;
    LAS float* scr = (LAS float*)(lds + wave * 8448);
    constexpr int I_ABIN = 64 * 242, I_UQ = 16 * 96, I_UKV = 8 * 128, I_SQ = 64 * 128, I_CIN = 64 * 384, I_UP = 64 * 688, I_DN = 172 * 128;
    constexpr int NITEMS = I_ABIN + I_UQ + I_UKV + 2 * I_SQ + I_CIN + 2 * I_UP + 2 * I_DN;
    (void)NITEMS;
    { int off = gw;
#define TM(MAP_, W_, K_, N_, G_, WT_, NI_) do { transpose_matrix<MAP_>(W_, K_, N_, G_, (bf16*)(ws + WT_), scr, off, NI_, NGW, lane); off = (off + NGW - (NI_) % NGW) % NGW; } while (0)
      TM(4, pp->w_up, 4096, FF2, pp->norm_ffn, WS_WUP0, I_UP);
      TM(4, pp->w_up + (size_t)4096 * FF2, 4096, FF2, pp->norm_ffn + 4096, WS_WUP1, I_UP);
      TM(0, pp->w_down, FF, 4096, nullptr, WS_WDN0, I_DN);
      TM(0, pp->w_down + (size_t)FF * 4096, FF, 4096, nullptr, WS_WDN1, I_DN);
      TM(0, pp->c_w_in, 4096, 12288, pp->norm_mix + 4096, WS_WCIN, I_CIN);
      TM(1, pp->ab_w_in, 4096, 7744, pp->norm_mix, WS_WABIN, I_ABIN);
      TM(0, pp->ab_w_out, 4096, 4096, nullptr, WS_WABOUT, I_SQ);
      TM(0, pp->c_w_out, 4096, 4096, nullptr, WS_WCOUT, I_SQ);
      TM(2, pp->ab_w_uq, 1024, 3072, pp->ab_q_norm, WS_WUQ, I_UQ);
      TM(3, pp->ab_w_ukv, 512, 4096, pp->ab_kv_norm, WS_WUKV, I_UKV);
#undef TM
    }
    { GAS v4u* z = (GAS v4u*)((bf16*)(ws + WS_WABIN) + (size_t)1600 * 4096);
      for (int i = gw * 64 + lane; i < 192 * 4096 / 8; i += NGW * 64) z[i] = (v4u){0u, 0u, 0u, 0u}; }
    { float* rc = (float*)(ws + WS_ROPE); float* rs = rc + 4096 * 32;
      for (int i = gw * 64 + lane; i < 4096 * 32; i += NGW * 64) { const int pos = i >> 5, k = i & 31; const float inv = exp2f(-(float)k * (13.287712379549449f / 32.f)); float s, c; sincosf((float)pos * inv, &s, &c); rc[i] = c; rs[i] = s; } }
    { bf16* HB = (bf16*)(ws + WS_HB); unsigned long long* ss0 = (unsigned long long*)(ws + WS_SS);
      for (int m = gw; m < M; m += NGW) { const GAS f32x4* xr = (const GAS f32x4*)(pp->x + (size_t)m * DM) + lane; GAS unsigned long long* o8 = (GAS unsigned long long*)(HB + (size_t)m * DM) + lane; float s = 0.f;
#pragma unroll
          for (int j = 0; j < 16; ++j) { const f32x4 v = xr[64 * j]; s += (v[0] * v[0] + v[1] * v[1]) + (v[2] * v[2] + v[3] * v[3]); o8[64 * j] = (unsigned long long)pkbf(v[0], v[1]) | ((unsigned long long)pkbf(v[2], v[3]) << 32); }
          s = wave_sum(s); if (lane == 0) ss0[m] = (unsigned long long)(s * 4294967296.f); } }
}

__device__ __forceinline__ void conv_act_phase(const unsigned char* ws_c, unsigned char* ws, const float* cw, const float* cb, int gtid, int nthr) {
    const bf16* UP = (const bf16*)(ws_c + WS_UP); bf16* ACT = (bf16*)(ws + WS_ACT);
    constexpr int NCG = FF / 8, NITEM = (M / 32) * NCG;
    for (int it0 = gtid; it0 < NITEM; it0 += nthr) { const int it = NITEM - 1 - it0, cg = it % NCG, rsg = it / NCG, c0 = cg * 8, r0 = rsg * 32;
        float wg[3][8], wu[3][8], bg[8], bu[8];
#pragma unroll
        for (int j = 0; j < 3; ++j)
#pragma unroll
            for (int e = 0; e < 8; ++e) { wg[j][e] = cw[j * FF2 + c0 + e]; wu[j][e] = cw[j * FF2 + FF + c0 + e]; }
#pragma unroll
        for (int e = 0; e < 8; ++e) { bg[e] = cb[c0 + e]; bu[e] = cb[FF + c0 + e]; }
        float g1[8], g2[8], u1[8], u2[8];
        const bool first = (r0 & 4095) == 0;
        { v4u a = (v4u){0u, 0u, 0u, 0u}, b2 = a, c = a, d = a;
          if (!first) { a = *(const GAS v4u*)(UP + (size_t)(r0 - 1) * FF2 + c0); b2 = *(const GAS v4u*)(UP + (size_t)(r0 - 2) * FF2 + c0); c = *(const GAS v4u*)(UP + (size_t)(r0 - 1) * FF2 + FF + c0); d = *(const GAS v4u*)(UP + (size_t)(r0 - 2) * FF2 + FF + c0); }
          g1[0] = bflo(a.x); g1[1] = bfhi(a.x); g1[2] = bflo(a.y); g1[3] = bfhi(a.y); g1[4] = bflo(a.z); g1[5] = bfhi(a.z); g1[6] = bflo(a.w); g1[7] = bfhi(a.w);
          g2[0] = bflo(b2.x); g2[1] = bfhi(b2.x); g2[2] = bflo(b2.y); g2[3] = bfhi(b2.y); g2[4] = bflo(b2.z); g2[5] = bfhi(b2.z); g2[6] = bflo(b2.w); g2[7] = bfhi(b2.w);
          u1[0] = bflo(c.x); u1[1] = bfhi(c.x); u1[2] = bflo(c.y); u1[3] = bfhi(c.y); u1[4] = bflo(c.z); u1[5] = bfhi(c.z); u1[6] = bflo(c.w); u1[7] = bfhi(c.w);
          u2[0] = bflo(d.x); u2[1] = bfhi(d.x); u2[2] = bflo(d.y); u2[3] = bfhi(d.y); u2[4] = bflo(d.z); u2[5] = bfhi(d.z); u2[6] = bflo(d.w); u2[7] = bfhi(d.w); }
#pragma unroll 4
        for (int r = r0; r < r0 + 32; ++r) {
            const v4u a = *(const GAS v4u*)(UP + (size_t)r * FF2 + c0), c = *(const GAS v4u*)(UP + (size_t)r * FF2 + FF + c0);
            float g0[8], u0[8], o[8];
            g0[0] = bflo(a.x); g0[1] = bfhi(a.x); g0[2] = bflo(a.y); g0[3] = bfhi(a.y); g0[4] = bflo(a.z); g0[5] = bfhi(a.z); g0[6] = bflo(a.w); g0[7] = bfhi(a.w);
            u0[0] = bflo(c.x); u0[1] = bfhi(c.x); u0[2] = bflo(c.y); u0[3] = bfhi(c.y); u0[4] = bflo(c.z); u0[5] = bfhi(c.z); u0[6] = bflo(c.w); u0[7] = bfhi(c.w);
#pragma unroll
            for (int e = 0; e < 8; ++e) { const float gv = wg[0][e] * g2[e] + wg[1][e] * g1[e] + wg[2][e] * g0[e] + bg[e], uv = wu[0][e] * u2[e] + wu[1][e] * u1[e] + wu[2][e] * u0[e] + bu[e];
                o[e] = gv / (1.f + __expf(-gv)) * uv; g2[e] = g1[e]; g1[e] = g0[e]; u2[e] = u1[e]; u1[e] = u0[e]; }
            v4u w; w.x = pkbf(o[0], o[1]); w.y = pkbf(o[2], o[3]); w.z = pkbf(o[4], o[5]); w.w = pkbf(o[6], o[7]);
            *(GAS v4u*)(ACT + (size_t)r * FF + c0) = w; }
    }
}
__device__ __forceinline__ void conv_fixup_panel(unsigned char* ws, const float* cw, const float* cb, int pm, int tid_) {
    int tid = tid_; asm volatile("" : "+v"(tid));
    const float* HEAD = (const float*)(ws + WS_HEAD) + (size_t)pm * 4 * 11008; const float* TAIL = (const float*)(ws + WS_TAIL) + (size_t)(pm - 1) * 4 * 11008; bf16* ACT = (bf16*)(ws + WS_ACT);
    const bool first = (pm & 15) == 0;
    for (int c = tid; c < FF; c += NWAVES * 64) {
        float tg[2], tu[2], hg[2], hu[2];
#pragma unroll
        for (int j = 0; j < 2; ++j) { tg[j] = first ? 0.f : TAIL[(j * 2 + 0) * 11008 + c]; tu[j] = first ? 0.f : TAIL[(j * 2 + 1) * 11008 + c]; hg[j] = HEAD[(j * 2 + 0) * 11008 + c]; hu[j] = HEAD[(j * 2 + 1) * 11008 + c]; }
        const float g0 = cw[c], g1 = cw[FF2 + c], g2 = cw[2 * FF2 + c], u0 = cw[FF + c], u1 = cw[FF2 + FF + c], u2 = cw[2 * FF2 + FF + c], bg = cb[c], bu = cb[FF + c];
        { const float gv = g0 * tg[0] + g1 * tg[1] + g2 * hg[0] + bg, uv = u0 * tu[0] + u1 * tu[1] + u2 * hu[0] + bu; ACT[(size_t)(pm * 256) * FF + c] = (bf16)f2bf(gv / (1.f + __expf(-gv)) * uv); }
        { const float gv = g0 * tg[1] + g1 * hg[0] + g2 * hg[1] + bg, uv = u0 * tu[1] + u1 * hu[0] + u2 * hu[1] + bu; ACT[(size_t)(pm * 256 + 1) * FF + c] = (bf16)f2bf(gv / (1.f + __expf(-gv)) * uv); }
    }
}
__device__ __forceinline__ void final_norm_phase(float* out, const float* g, int gw, int NGW, int lane) {
    for (int m = gw; m < M; m += NGW) { GAS f32x4* xr = (GAS f32x4*)(out + (size_t)m * DM) + lane; f32x4 v[16]; float s = 0.f;
#pragma unroll
        for (int j = 0; j < 16; ++j) { v[j] = xr[64 * j]; s += (v[j][0] * v[j][0] + v[j][1] * v[j][1]) + (v[j][2] * v[j][2] + v[j][3] * v[j][3]); }
        const float rn = rsqrtf(wave_sum(s) * (1.f / DM) + EPS);
#pragma unroll
        for (int j = 0; j < 16; ++j) { const f32x4 gg = *((const GAS f32x4*)g + lane + 64 * j); xr[64 * j] = v[j] * rn * gg; } }
}

struct Args { P p; int ph_lo, ph_hi; };
static_assert(sizeof(Args) == 23 * 8 + 8, "Args has no padding");
__global__ void __launch_bounds__(NWAVES * 64, 2) fwd_kernel(Args args) {
    extern __shared__ __attribute__((aligned(16))) unsigned char lds_raw[];
    LAS unsigned char* lds = (LAS unsigned char*)lds_raw;
    volatile LAS unsigned* MISC = (volatile LAS unsigned*)(lds + MISC_OFF);
    const int tid = threadIdx.x, lane = tid & 63, wave = __builtin_amdgcn_readfirstlane(tid >> 6);
    const int G = gridDim.x, gw = blockIdx.x * NWAVES + wave, NGW = G * NWAVES;
    unsigned char* ws = kargs()->ws;
    gu32* ctl = (gu32*)(ws + WS_CTL);
    for (int u = tid; u < (LDS_BYTES - LDSCTL_OFF) / 4; u += NWAVES * 64) ((LAS unsigned*)(lds + LDSCTL_OFF))[u] = 0u;
    __syncthreads();
#if MK_ONE_LAUNCH
    XcdBarrier bar = xcd_barrier_post((unsigned*)(ctl + CW_BAR), MISC + 8);
#define GRID_BAR() xcd_barrier(bar)
#else
    (void)MISC; (void)ctl;
#define GRID_BAR() do { } while (0)
#endif
    const int lo = args.ph_lo, hi = args.ph_hi;
#ifndef PHASE_MASK
#define PHASE_MASK 0x7fff
#endif
#define IN(k) (((PHASE_MASK >> (k)) & 1) && lo <= (k) && (k) < hi)
#ifndef REPEAT_PHASE
#define REPEAT_PHASE -1
#endif
#define REP(k) for (int rep_ = 0; rep_ < ((REPEAT_PHASE == (k)) ? 2 : 1); ++rep_)
#ifndef TPROBE
#define TPROBE -1
#endif
    unsigned long long tp0 = 0ull, tp1 = 0ull;
#define TSTAMP(k) do { if (TPROBE >= 0 && blockIdx.x == 0 && tid == 0) { if ((k) == TPROBE) tp0 = wall_clock64(); if ((k) == TPROBE + 1) tp1 = wall_clock64(); } } while (0)
#define SEAM(k) do { if (IN(k) && IN((k) + 1)) GRID_BAR(); TSTAMP((k) + 1); } while (0)
    pg8::u64_t* SS = (pg8::u64_t*)(ws + WS_SS);
    pg8::u64_t *ss0 = SS, *ss1 = SS + 8192, *ss2 = SS + 2 * 8192, *ss3 = SS + 3 * 8192, *ssq = SS + 5 * 8192, *sskv = SS + 6 * 8192;
    const float* rc = (const float*)(ws + WS_ROPE); const float* rs = rc + 4096 * 32;
    bf16* HB = (bf16*)(ws + WS_HB); float* H = (float*)(ws + WS_H); bf16* OB = (bf16*)(ws + WS_O);

    TSTAMP(0);
    if (IN(0)) REP(0) { p0_prologue(kargs(), lds, gw, NGW, wave, lane); __syncthreads(); }
    SEAM(0);
    if (IN(1)) REP(1) { pg8::Gemm g{HB, (const bf16*)(ws + WS_WABIN), M, NAB, 4096}; pg8::StaticOrder S; S.init(M, NAB, G, (int)blockIdx.x);
        pg8::EpiABIn E{ss0, (bf16*)(ws + WS_CQ), (bf16*)(ws + WS_CKV), (bf16*)(ws + WS_KR), (bf16*)(ws + WS_SBQ), (bf16*)(ws + WS_SBK), (bf16*)(ws + WS_SBVT), ssq, sskv, rc, rs};
        pg8::gemm_phase<pg8::EpiABIn, pg8::StaticOrder, true, true>(lds + RING_OFF, g, S, E); }
    SEAM(1);
    if (IN(2)) REP(2) {
        { pg8::Gemm g{(const bf16*)(ws + WS_CQ), (const bf16*)(ws + WS_WUQ), M, 3072, 1024}; pg8::StaticOrder S; S.init(M, 3072, G, (int)blockIdx.x);
          pg8::EpiUQ E{ssq, (bf16*)(ws + WS_QA), rc, rs};
          pg8::gemm_phase<pg8::EpiUQ, pg8::StaticOrder, true, true>(lds + RING_OFF, g, S, E); }
        { pg8::Gemm g{(const bf16*)(ws + WS_CKV), (const bf16*)(ws + WS_WUKV), M, 4096, 512}; pg8::OrderUKV S; S.init(M, 4096, G, (int)blockIdx.x);
          pg8::EpiUKV E{sskv, (bf16*)(ws + WS_KN), (bf16*)(ws + WS_VAT)};
          pg8::gemm_phase<pg8::EpiUKV, pg8::OrderUKV, true, true>(lds + RING_OFF, g, S, E); }
    }
    SEAM(2);
    if (IN(3)) REP(3) {
        for (int j = blockIdx.x; j < 256; j += G) { const int bh = j & 31, pr = j >> 5;
#pragma unroll 1
            for (int u = 0; u < 2; ++u) mla_unit2(lds, ws, bh, u ? pr : 15 - pr, wave, lane); }
        for (int j = blockIdx.x; j < 256; j += G) { const int bh = j & 31, pr = j >> 5;
#pragma unroll 1
            for (int u = 0; u < 2; ++u) sb_unit(lds, ws, bh, u ? pr : 15 - pr, tid, wave, lane); }
        __syncthreads(); }
    SEAM(3);
    if (IN(4)) { pg8::Gemm g{OB, (const bf16*)(ws + WS_WABOUT), M, 4096, 4096}; pg8::StaticOrder S; S.init(M, 4096, G, (int)blockIdx.x);
        pg8::EpiResidT<0> E{kargs()->x, nullptr, HB, ss1};
        pg8::gemm_phase<pg8::EpiResidT<0>, pg8::StaticOrder, true, true>(lds + RING_OFF, g, S, E); }
    SEAM(4);
    if (IN(5)) REP(5) { pg8::Gemm g{HB, (const bf16*)(ws + WS_WUP0), M, FF2, 4096}; pg8::StaticOrder S; S.init(M, FF2, G, (int)blockIdx.x);
        pg8::EpiUpConv E{ss1, (bf16*)(ws + WS_ACT), (float*)(ws + WS_HEAD), (float*)(ws + WS_TAIL), kargs()->conv_w, kargs()->conv_b, (PG8_LAS float*)(lds + RING_BYTES)};
        pg8::gemm_phase<pg8::EpiUpConv, pg8::StaticOrder, true, true>(lds + RING_OFF, g, S, E); }
    do { if (IN(5) && IN(7)) GRID_BAR(); TSTAMP(6); TSTAMP(7); } while (0);
    if (IN(7)) { pg8::Gemm g{(const bf16*)(ws + WS_ACT), (const bf16*)(ws + WS_WDN0), M, 4096, FF}; pg8::StaticOrder S; S.init(M, 4096, G, (int)blockIdx.x);
        { pg8::Unit uf; int last = -1; for (int i = 0; S.next(i, uf); ++i) if (uf.pm != last) { last = uf.pm; conv_fixup_panel(ws, kargs()->conv_w, kargs()->conv_b, last, tid); }
          asm volatile("s_waitcnt vmcnt(0)" ::: "memory"); __syncthreads(); }
        pg8::EpiResidT<1> E{nullptr, nullptr, HB, ss2};
        pg8::gemm_phase<pg8::EpiResidT<1>, pg8::StaticOrder, true, true>(lds + RING_OFF, g, S, E); }
    SEAM(7);
    if (IN(8)) REP(8) { pg8::Gemm g{HB, (const bf16*)(ws + WS_WCIN), M, 12288, 4096}; pg8::StaticOrder S; S.init(M, 12288, G, (int)blockIdx.x);
        pg8::EpiCIn E{ss2, (bf16*)(ws + WS_CQ1), (bf16*)(ws + WS_CK1), (bf16*)(ws + WS_CVT), (unsigned*)(ws + WS_CTL) + CW_KMAX};
        pg8::gemm_phase<pg8::EpiCIn, pg8::StaticOrder, true, true>(lds + RING_OFF, g, S, E); }
    SEAM(8);
    if (IN(9)) REP(9) {
        float d1 = 0.f, d2 = 0.f;
        { KP ka = kargs(); const float *q1 = ka->lq1, *k1 = ka->lk1, *q2 = ka->lq2, *k2 = ka->lk2; for (int j = lane; j < 128; j += 64) { d1 += q1[j] * k1[j]; d2 += q2[j] * k2[j]; } }
        const float* subln = kargs()->subln;
        const float lam = __expf(wave_sum(d1)) - __expf(wave_sum(d2)) + LAMBDA_INIT;
        const unsigned* kmaxw = (const unsigned*)(ws + WS_CTL) + CW_KMAX; volatile LAS unsigned* qslot = (volatile LAS unsigned*)(lds + PC_FLG + 64);
        for (;;) {
            if (tid == 0) qslot[0] = __hip_atomic_fetch_add((unsigned*)(ws + WS_CTL) + CW_QUEUE + 64 * rep_, 1u, __ATOMIC_RELAXED, __HIP_MEMORY_SCOPE_AGENT);
            __syncthreads();
            const unsigned uu = qslot[0];
            __syncthreads();
            if (uu >= 1024u) break;
            const int qb128 = 31 - (int)(uu >> 5), hd = 15 - (int)((uu & 31u) >> 1), bb = (int)(uu & 1u);
            diff_unit_pc5(lds, ws, subln, lam, kmaxw, bb * 16 + hd, qb128, wave, lane);
        }
        __syncthreads(); }
    SEAM(9);
    if (IN(10)) { pg8::Gemm g{OB, (const bf16*)(ws + WS_WCOUT), M, 4096, 4096}; pg8::StaticOrder S; S.init(M, 4096, G, (int)blockIdx.x);
        pg8::EpiResidT<1> E{nullptr, nullptr, HB, ss3};
        pg8::gemm_phase<pg8::EpiResidT<1>, pg8::StaticOrder, true, true>(lds + RING_OFF, g, S, E); }
    SEAM(10);
#ifdef IDLE_BEFORE_11
    { const unsigned long long i0 = wall_clock64(); while (wall_clock64() - i0 < 50000ull) __builtin_amdgcn_s_sleep(64); __syncthreads(); TSTAMP(11); }
#endif
    if (IN(11)) REP(11) { pg8::Gemm g{HB, (const bf16*)(ws + WS_WUP1), M, FF2, 4096}; pg8::StaticOrder S; S.init(M, FF2, G, (int)blockIdx.x);
        pg8::EpiUpConv E{ss3, (bf16*)(ws + WS_ACT), (float*)(ws + WS_HEAD), (float*)(ws + WS_TAIL), kargs()->conv_w + 3 * FF2, kargs()->conv_b + FF2, (PG8_LAS float*)(lds + RING_BYTES)};
        pg8::gemm_phase<pg8::EpiUpConv, pg8::StaticOrder, true, true>(lds + RING_OFF, g, S, E); }
    do { if (IN(11) && IN(13)) GRID_BAR(); TSTAMP(12); TSTAMP(13); } while (0);
    if (IN(13)) { pg8::Gemm g{(const bf16*)(ws + WS_ACT), (const bf16*)(ws + WS_WDN1), M, 4096, FF}; pg8::StaticOrder S; S.init(M, 4096, G, (int)blockIdx.x);
        { pg8::Unit uf; int last = -1; for (int i = 0; S.next(i, uf); ++i) if (uf.pm != last) { last = uf.pm; conv_fixup_panel(ws, kargs()->conv_w + 3 * FF2, kargs()->conv_b + FF2, last, tid); }
          asm volatile("s_waitcnt vmcnt(0)" ::: "memory"); __syncthreads(); }
        pg8::EpiResidT<2> E{nullptr, kargs()->out, HB, nullptr};
        pg8::gemm_phase<pg8::EpiResidT<2>, pg8::StaticOrder, true, true>(lds + RING_OFF, g, S, E); }
    SEAM(13);
    if (IN(14)) final_norm_phase(kargs()->out, kargs()->norm_final, gw, NGW, lane);
    if (TPROBE >= 0 && blockIdx.x == 0 && tid == 0) { if (TPROBE == 14) tp1 = wall_clock64(); const unsigned long long te = wall_clock64(), span = 2ull * (tp1 - tp0); while (wall_clock64() - te < span) __builtin_amdgcn_s_sleep(8); }
#undef IN
#undef SEAM
}

extern "C" void kernel_launch(void* const* d_in, const int* in_sizes, int n_in, void* d_out, int out_size, void* d_ws, size_t ws_size, hipStream_t stream) {
    static int grid = 0;
    if (grid == 0) {
        if (n_in != 21 || in_sizes[0] != M * DM || out_size != M * DM || ws_size < WS_END) { fprintf(stderr, "kernel_launch: unexpected shapes (n_in %d, in0 %d, out %d, ws %zu); nothing launched\n", n_in, n_in > 0 ? in_sizes[0] : -1, out_size, ws_size); grid = -1; return; }
        int dev = 0, cus = 0, per_cu = 0;
        if (hipGetDevice(&dev) != hipSuccess || hipDeviceGetAttribute(&cus, hipDeviceAttributeMultiprocessorCount, dev) != hipSuccess) { grid = -1; return; }
        if (hipFuncSetAttribute((const void*)fwd_kernel, hipFuncAttributeMaxDynamicSharedMemorySize, LDS_BYTES) != hipSuccess) { fprintf(stderr, "kernel_launch: hipFuncSetAttribute failed\n"); grid = -1; return; }
        if (hipOccupancyMaxActiveBlocksPerMultiprocessor(&per_cu, (const void*)fwd_kernel, NWAVES * 64, LDS_BYTES) != hipSuccess || per_cu < 1) fprintf(stderr, "kernel_launch: note: occupancy query reports %d\n", per_cu);
        (void)hipGetLastError();
        grid = cus;
    }
    if (grid < 0) return;
    if (hipMemsetAsync((char*)d_ws + WS_CTL, 0, CTL_ZERO_BYTES, stream) != hipSuccess) { fprintf(stderr, "kernel_launch: memset failed\n"); return; }
    Args a{};
    const float** pp = (const float**)&a.p;
    for (int i = 0; i < 21; ++i) pp[i] = (const float*)d_in[i];
    a.p.out = (float*)d_out; a.p.ws = (unsigned char*)d_ws;
#if MK_ONE_LAUNCH
    a.ph_lo = 0; a.ph_hi = N_PHASES;
    hipLaunchKernelGGL(fwd_kernel, dim3(grid), dim3(NWAVES * 64), LDS_BYTES, stream, a);
#else
    for (int ph = 0; ph < N_PHASES; ++ph) { a.ph_lo = ph; a.ph_hi = ph + 1; hipLaunchKernelGGL(fwd_kernel, dim3(grid), dim3(NWAVES * 64), LDS_BYTES, stream, a); }
#endif
}
```

```cpp
#include <hip/hip_runtime.h>
#include <cstdio>
#include <cstdint>
#include <cmath>
template <int CTRL> __device__ __forceinline__ float dppf(float v) { return __builtin_bit_cast(float, __builtin_amdgcn_update_dpp(0, __builtin_bit_cast(int, v), CTRL, 0xf, 0xf, true)); }
__device__ __forceinline__ float sum_x16(float v) { const unsigned u = __builtin_bit_cast(unsigned, v); const auto r = __builtin_amdgcn_permlane16_swap(u, u, false, false); const unsigned r0 = r[0], r1 = r[1]; return __builtin_bit_cast(float, r0) + __builtin_bit_cast(float, r1); }
__device__ __forceinline__ float sum_x32(float v) { const unsigned u = __builtin_bit_cast(unsigned, v); const auto r = __builtin_amdgcn_permlane32_swap(u, u, false, false); const unsigned r0 = r[0], r1 = r[1]; return __builtin_bit_cast(float, r0) + __builtin_bit_cast(float, r1); }
__device__ __forceinline__ float max_x16(float v) { const unsigned u = __builtin_bit_cast(unsigned, v); const auto r = __builtin_amdgcn_permlane16_swap(u, u, false, false); const unsigned r0 = r[0], r1 = r[1]; return fmaxf(__builtin_bit_cast(float, r0), __builtin_bit_cast(float, r1)); }
__device__ __forceinline__ float max_x32(float v) { const unsigned u = __builtin_bit_cast(unsigned, v); const auto r = __builtin_amdgcn_permlane32_swap(u, u, false, false); const unsigned r0 = r[0], r1 = r[1]; return fmaxf(__builtin_bit_cast(float, r0), __builtin_bit_cast(float, r1)); }
__device__ __forceinline__ float row_sum16(float v) { v += dppf<0xB1>(v); v += dppf<0x4E>(v); v += dppf<0x141>(v); v += dppf<0x140>(v); return v; }
__device__ __forceinline__ float row_max16(float v) { v = fmaxf(v, dppf<0xB1>(v)); v = fmaxf(v, dppf<0x4E>(v)); v = fmaxf(v, dppf<0x141>(v)); v = fmaxf(v, dppf<0x140>(v)); return v; }
namespace pg8 {
#define PG8_LAS __attribute__((address_space(3)))
typedef unsigned short bf16_t;
typedef short bf16x8 __attribute__((ext_vector_type(8)));
typedef float f32x4 __attribute__((ext_vector_type(4)));
typedef unsigned u32x4 __attribute__((ext_vector_type(4)));
constexpr int BM = 256, BK = 64, HALF = 128, HTB = HALF * BK * 2  , STAGE_BYTES = 8 * HTB, NXCD = 8, WGM = 8;

__host__ __device__ __forceinline__ int lds_byte(int r, int c) { const int st = (r >> 4) * 2 + (c >> 5), rr = r & 15, cc = c & 31, ob = rr * 64 + cc * 2; return st * 1024 + (ob ^ (((ob >> 9) & 1) << 5)); }
__host__ __device__ __forceinline__ void stage_rc(int b, int& R, int& C) { const int st = b / 1024, sb = b % 1024, swz = sb ^ (((sb >> 9) & 1) << 5); R = (st >> 1) * 16 + swz / 64; C = (st & 1) * 32 + (swz % 64) / 2; }
__host__ __device__ __forceinline__ int perm32(int rho) { const int n = rho >> 4, i = rho & 15; return 8 * (i >> 2) + 4 * n + (i & 3); }

struct Unit { int pm, pn; };
struct Gemm { const bf16_t* A; const bf16_t* Bt; int M, N, K; };

struct StaticOrder {
    int nM, nN, nwg, G, c;
    __host__ __device__ void init(int M, int N, int G_, int c_) { nM = M / BM; nN = N / BM; nwg = nM * nN; G = G_; c = c_; }
    __host__ __device__ __forceinline__ bool next(int i, Unit& u) const {
        const long L = (long)i * G + c; if (L >= nwg) return false;
        int wgid = (int)L; { const int q = nwg / NXCD, r = nwg % NXCD, xcd = wgid % NXCD, off = wgid / NXCD; wgid = (xcd < r ? xcd * (q + 1) : r * (q + 1) + (xcd - r) * q) + off; }
        const int nig = WGM * nN, gid = wgid / nig, fm = gid * WGM, gsz = (nM - fm) < WGM ? (nM - fm) : WGM;
        u.pm = fm + ((wgid % nig) % gsz); u.pn = (wgid % nig) / gsz; return true;
    }
    __device__ __forceinline__ void a_ready(const Unit&) const {}
    __device__ __forceinline__ void done(const Unit&) const {}
};
struct OrderUKV : StaticOrder {
    __device__ __forceinline__ bool next(int i, Unit& u) const {
        long L;
        if (G == 256 && nwg == 512) { if (c < 128) { if (i > 0) return false; L = c; } else { if (i > 2) return false; L = i == 0 ? c : (i == 1 ? 256 + (c - 128) : 384 + (c - 128)); } }
        else { L = (long)i * G + c; if (L >= nwg) return false; }
        int wgid = (int)L; { const int q = nwg / NXCD, r = nwg % NXCD, xcd = wgid % NXCD, off = wgid / NXCD; wgid = (xcd < r ? xcd * (q + 1) : r * (q + 1) + (xcd - r) * q) + off; }
        const int nig = WGM * nN, gid = wgid / nig, fm = gid * WGM, gsz = (nM - fm) < WGM ? (nM - fm) : WGM;
        u.pm = fm + ((wgid % nig) % gsz); u.pn = (wgid % nig) / gsz; return true;
    }
};
__device__ __forceinline__ unsigned cvt_pk_bf16(float lo, float hi) { unsigned r; asm volatile("v_cvt_pk_bf16_f32 %0, %1, %2" : "=v"(r) : "v"(lo), "v"(hi)); return r; }
typedef float f32x2 __attribute__((ext_vector_type(2)));
constexpr float RMS_EPS = 1e-6f;
__device__ __forceinline__ unsigned f2bf1(float f) { unsigned u = __builtin_bit_cast(unsigned, f); return (u + 0x7fffu + ((u >> 16) & 1u)) >> 16; }
__device__ __forceinline__ void store8(bf16_t* p, const f32x4& v0, const f32x4& v1) {
    u32x4 w; w.x = cvt_pk_bf16(v0[0], v0[1]); w.y = cvt_pk_bf16(v0[2], v0[3]); w.z = cvt_pk_bf16(v1[0], v1[1]); w.w = cvt_pk_bf16(v1[2], v1[3]); *(u32x4*)p = w; }
__device__ __forceinline__ float sq8(const f32x4& v0, const f32x4& v1) { return ((v0[0] * v0[0] + v0[1] * v0[1]) + (v0[2] * v0[2] + v0[3] * v0[3])) + ((v1[0] * v1[0] + v1[1] * v1[1]) + (v1[2] * v1[2] + v1[3] * v1[3])); }
typedef unsigned long long u64_t;
__device__ __forceinline__ void atomic_add_fix(u64_t* p, float v) { (void)__hip_atomic_fetch_add(p, (u64_t)(v * 4294967296.f), __ATOMIC_RELAXED, __HIP_MEMORY_SCOPE_AGENT); }
__device__ __forceinline__ float rstd_fix(const u64_t* ss, int row, float invn) { return rsqrtf((float)ss[row] * (invn * 2.3283064365386963e-10f) + RMS_EPS); }
__device__ __forceinline__ void store8_t(bf16_t* p, const f32x4& v0, const f32x4& v1) {
#pragma unroll
    for (int j = 0; j < 4; ++j) { p[(size_t)j * 4096] = (bf16_t)f2bf1(v0[j]); p[(size_t)(j + 4) * 4096] = (bf16_t)f2bf1(v1[j]); } }
__device__ __forceinline__ void store_vt4(bf16_t* p, const f32x4 (&a)[4][2], const float (&sc)[4]) {
#pragma unroll
    for (int n = 0; n < 2; ++n)
#pragma unroll
        for (int k = 0; k < 4; ++k) { f32x2 w; w[0] = __builtin_bit_cast(float, cvt_pk_bf16(a[0][n][k] * sc[0], a[1][n][k] * sc[1])); w[1] = __builtin_bit_cast(float, cvt_pk_bf16(a[2][n][k] * sc[2], a[3][n][k] * sc[3]));
            *(f32x2*)(p + (size_t)(4 * n + k) * 4096) = w; } }
__device__ __forceinline__ void rope8(f32x4& v0, f32x4& v1, const f32x4& c, const f32x4& s) {
    const f32x4 a = v0, b = v1;
    v0[0] = a[0] * c[0] - a[1] * s[0]; v0[1] = a[1] * c[0] + a[0] * s[0]; v0[2] = a[2] * c[1] - a[3] * s[1]; v0[3] = a[3] * c[1] + a[2] * s[1];
    v1[0] = b[0] * c[2] - b[1] * s[2]; v1[1] = b[1] * c[2] + b[0] * s[2]; v1[2] = b[2] * c[3] - b[3] * s[3]; v1[3] = b[3] * c[3] + b[2] * s[3]; }

struct EpiABIn {
    static constexpr bool PERM = true, AFTER_DRAIN = false, ROWPERM = true;
    const u64_t* ss0; bf16_t *CQ, *CKV, *KR, *SBQ, *SBK, *SBVT; u64_t *ssq, *sskv; const float *rc, *rs;
    __device__ __forceinline__ void operator()(const f32x4 (&acc)[2][2][4][2], const Unit& u, int wr, int wc, int fr, int fq) const {
        float scv[2][4];
#pragma unroll
        for (int ai_ = 0; ai_ < 2; ++ai_)
#pragma unroll
            for (int m_ = 0; m_ < 4; ++m_) scv[ai_][m_] = rstd_fix(ss0, u.pm * BM + ai_ * HALF + wr * 64 + 4 * fr + m_, 1.f / 4096.f);
        const int pn = u.pn;
#pragma unroll
        for (int ai = 0; ai < 2; ++ai)
#pragma unroll
            for (int m = 0; m < 4; ++m) {
                const int row = u.pm * BM + ai * HALF + wr * 64 + 4 * fr + m;
                const float sc = scv[ai][m];
                if (pn < 6) {
                    bf16_t* dst = pn < 4 ? CQ + (size_t)row * 1024 + pn * 256 : CKV + (size_t)row * 512 + (pn - 4) * 256;
                    float part = 0.f;
#pragma unroll
                    for (int bj = 0; bj < 2; ++bj) { const f32x4 v0 = acc[ai][bj][m][0] * sc, v1 = acc[ai][bj][m][1] * sc; part += sq8(v0, v1); store8(dst + bj * HALF + wc * 32 + 8 * fq, v0, v1); }
                    part = sum_x32(sum_x16(part));
                    if (fq == 0) atomic_add_fix((pn < 4 ? ssq : sskv) + row, part);
                } else if (pn == 6) {
                    if (wc < 2) { f32x4 v0 = acc[ai][0][m][0] * sc, v1 = acc[ai][0][m][1] * sc; const int pos = row & 4095, i0 = 16 * wc + 4 * fq;
                        rope8(v0, v1, *(const f32x4*)(rc + pos * 32 + i0), *(const f32x4*)(rs + pos * 32 + i0)); store8(KR + (size_t)row * 64 + wc * 32 + 8 * fq, v0, v1); }
                } else {
                    const int t = (pn - 7) >> 3, ct = ((pn - 7) & 7) * 256;
                    if (t < 2) { bf16_t* dst = (t == 0 ? SBQ : SBK) + (size_t)row * 2048 + ct; const float sq = t == 0 ? sc * (0.08838834764831845f * 1.4426950408889634f) : sc;
#pragma unroll
                        for (int bj = 0; bj < 2; ++bj) store8(dst + bj * HALF + wc * 32 + 8 * fq, acc[ai][bj][m][0] * sq, acc[ai][bj][m][1] * sq);
                    } else if (m == 0) { const int b = row >> 12, s = row & 4095;
#pragma unroll
                        for (int bj = 0; bj < 2; ++bj) { const int col = ct + bj * HALF + wc * 32 + 8 * fq; store_vt4(SBVT + ((size_t)(b * 2048 + col)) * 4096 + s, acc[ai][bj], scv[ai]); }
                    }
                }
            }
    }
};
struct EpiUQ {
    static constexpr bool PERM = true, AFTER_DRAIN = false, ROWPERM = false;
    const u64_t* ssq; bf16_t* QA; const float *rc, *rs;
    __device__ __forceinline__ void operator()(const f32x4 (&acc)[2][2][4][2], const Unit& u, int wr, int wc, int fr, int fq) const {
        float scv[2][4];
#pragma unroll
        for (int ai_ = 0; ai_ < 2; ++ai_)
#pragma unroll
            for (int m_ = 0; m_ < 4; ++m_) scv[ai_][m_] = rstd_fix(ssq, u.pm * BM + ai_ * HALF + wr * 64 + m_ * 16 + fr, 1.f / 1024.f) * (0.07216878364870322f * 1.4426950408889634f)    ;
#pragma unroll
        for (int ai = 0; ai < 2; ++ai)
#pragma unroll
            for (int m = 0; m < 4; ++m) {
                const int row = u.pm * BM + ai * HALF + wr * 64 + m * 16 + fr;
                const float sc = scv[ai][m];
#pragma unroll
                for (int bj = 0; bj < 2; ++bj) { const int cb = u.pn * BM + bj * HALF + wc * 32, hd = cb % 192;
                    f32x4 v0 = acc[ai][bj][m][0] * sc, v1 = acc[ai][bj][m][1] * sc;
                    if (hd >= 128) { const int pos = row & 4095, i0 = (hd - 128) / 2 + 4 * fq; rope8(v0, v1, *(const f32x4*)(rc + pos * 32 + i0), *(const f32x4*)(rs + pos * 32 + i0)); }
                    store8(QA + (size_t)row * 3072 + cb + 8 * fq, v0, v1); }
            }
    }
};
struct EpiUKV {
    static constexpr bool PERM = true, AFTER_DRAIN = false, ROWPERM = true;
    const u64_t* sskv; bf16_t *KN, *VAT;
    __device__ __forceinline__ void operator()(const f32x4 (&acc)[2][2][4][2], const Unit& u, int wr, int wc, int fr, int fq) const {
        float scv[2][4];
#pragma unroll
        for (int ai_ = 0; ai_ < 2; ++ai_)
#pragma unroll
            for (int m_ = 0; m_ < 4; ++m_) scv[ai_][m_] = rstd_fix(sskv, u.pm * BM + ai_ * HALF + wr * 64 + 4 * fr + m_, 1.f / 512.f);
#pragma unroll
        for (int ai = 0; ai < 2; ++ai)
#pragma unroll
            for (int m = 0; m < 4; ++m) {
                const int row = u.pm * BM + ai * HALF + wr * 64 + 4 * fr + m;
                const float sc = scv[ai][m];
                if (u.pn < 8) {
#pragma unroll
                    for (int bj = 0; bj < 2; ++bj) store8(KN + (size_t)row * 2048 + u.pn * BM + bj * HALF + wc * 32 + 8 * fq, acc[ai][bj][m][0] * sc, acc[ai][bj][m][1] * sc);
                } else if (m == 0) { const int b = row >> 12, s = row & 4095;
#pragma unroll
                    for (int bj = 0; bj < 2; ++bj) { const int col = (u.pn - 8) * BM + bj * HALF + wc * 32 + 8 * fq; store_vt4(VAT + ((size_t)(b * 2048 + col)) * 4096 + s, acc[ai][bj], scv[ai]); }
                }
            }
    }
};
template <int MODE> struct EpiResidT {
    static constexpr bool PERM = true, AFTER_DRAIN = false, ROWPERM = false;
    const float* resid; float* Hout; bf16_t* HB; u64_t* ssn;
    __device__ __forceinline__ void operator()(const f32x4 (&acc)[2][2][4][2], const Unit& u, int wr, int wc, int fr, int fq) const {
        const size_t col = (size_t)u.pn * BM + wc * 32 + 8 * fq;
#pragma unroll
        for (int ai = 0; ai < 2; ++ai) {
            f32x4 r[4][2][2];
#pragma unroll
            for (int m = 0; m < 4; ++m)
#pragma unroll
                for (int bj = 0; bj < 2; ++bj) { const size_t off = (size_t)(u.pm * BM + ai * HALF + wr * 64 + m * 16 + fr) * 4096 + col + bj * HALF;
                    if (MODE == 0) { r[m][bj][0] = *(const f32x4*)(resid + off); r[m][bj][1] = *(const f32x4*)(resid + off + 4); }
                    else { const u32x4 w = *(const u32x4*)(HB + off);
                        r[m][bj][0] = (f32x4){__builtin_bit_cast(float, w.x << 16), __builtin_bit_cast(float, w.x & 0xffff0000u), __builtin_bit_cast(float, w.y << 16), __builtin_bit_cast(float, w.y & 0xffff0000u)};
                        r[m][bj][1] = (f32x4){__builtin_bit_cast(float, w.z << 16), __builtin_bit_cast(float, w.z & 0xffff0000u), __builtin_bit_cast(float, w.w << 16), __builtin_bit_cast(float, w.w & 0xffff0000u)}; } }
            __builtin_amdgcn_sched_barrier(0);
#pragma unroll
            for (int m = 0; m < 4; ++m) {
                const int row = u.pm * BM + ai * HALF + wr * 64 + m * 16 + fr; float part = 0.f;
#pragma unroll
                for (int bj = 0; bj < 2; ++bj) { const size_t off = (size_t)row * 4096 + col + bj * HALF;
                    const f32x4 h0 = r[m][bj][0] + acc[ai][bj][m][0], h1 = r[m][bj][1] + acc[ai][bj][m][1];
                    if (MODE == 2) { *(f32x4*)(Hout + off) = h0; *(f32x4*)(Hout + off + 4) = h1; } else { store8(HB + off, h0, h1); part += sq8(h0, h1); } }
                if (MODE != 2) { part = sum_x32(sum_x16(part)); if (fq == 0) atomic_add_fix(ssn + row, part); }
            }
            __builtin_amdgcn_sched_barrier(0);
        }
    }
};
struct EpiUp {
    static constexpr bool PERM = true, AFTER_DRAIN = false, ROWPERM = false;
    const u64_t* ss; bf16_t* UP;
    __device__ __forceinline__ void operator()(const f32x4 (&acc)[2][2][4][2], const Unit& u, int wr, int wc, int fr, int fq) const {
        float scv[2][4];
#pragma unroll
        for (int ai_ = 0; ai_ < 2; ++ai_)
#pragma unroll
            for (int m_ = 0; m_ < 4; ++m_) scv[ai_][m_] = rstd_fix(ss, u.pm * BM + ai_ * HALF + wr * 64 + m_ * 16 + fr, 1.f / 4096.f);
#pragma unroll
        for (int ai = 0; ai < 2; ++ai)
#pragma unroll
            for (int m = 0; m < 4; ++m) {
                const int row = u.pm * BM + ai * HALF + wr * 64 + m * 16 + fr;
                const float sc = scv[ai][m];
#pragma unroll
                for (int bj = 0; bj < 2; ++bj) store8(UP + (size_t)row * 22016 + u.pn * BM + bj * HALF + wc * 32 + 8 * fq, acc[ai][bj][m][0] * sc, acc[ai][bj][m][1] * sc);
            }
    }
};
struct EpiCIn {
    static constexpr bool PERM = true, AFTER_DRAIN = false, ROWPERM = true;
    const u64_t* ss; bf16_t *CQ1, *CK1, *CVT; unsigned* kmax;
    __device__ __forceinline__ void operator()(const f32x4 (&acc)[2][2][4][2], const Unit& u, int wr, int wc, int fr, int fq) const {
        float scv[2][4];
#pragma unroll
        for (int ai_ = 0; ai_ < 2; ++ai_)
#pragma unroll
            for (int m_ = 0; m_ < 4; ++m_) scv[ai_][m_] = rstd_fix(ss, u.pm * BM + ai_ * HALF + wr * 64 + 4 * fr + m_, 1.f / 4096.f);
        float kmx[2] = {0.f, 0.f};
#pragma unroll
        for (int ai = 0; ai < 2; ++ai)
#pragma unroll
            for (int m = 0; m < 4; ++m) {
                const int row = u.pm * BM + ai * HALF + wr * 64 + 4 * fr + m;
                const float sc = scv[ai][m];
                if (u.pn < 32) { bf16_t* dst = (u.pn < 16 ? CQ1 : CK1) + (size_t)row * 4096 + (u.pn & 15) * BM; const float sq = u.pn < 16 ? sc * (0.08838834764831845f * 1.4426950408889634f) : sc;
#pragma unroll
                    for (int bj = 0; bj < 2; ++bj) { const f32x4 v0 = acc[ai][bj][m][0] * sq, v1 = acc[ai][bj][m][1] * sq; store8(dst + bj * HALF + wc * 32 + 8 * fq, v0, v1);
                        if (u.pn >= 16) { float part = sq8(v0, v1); part = sum_x32(sum_x16(part)); kmx[bj] = fmaxf(kmx[bj], part); } }
                } else if (m == 0) { const int b = row >> 12, s = row & 4095;
#pragma unroll
                    for (int bj = 0; bj < 2; ++bj) { const int col = (u.pn - 32) * BM + bj * HALF + wc * 32 + 8 * fq; store_vt4(CVT + ((size_t)(b * 4096 + col)) * 4096 + s, acc[ai][bj], scv[ai]); }
                }
            }
        if (u.pn >= 16 && u.pn < 32) {
#pragma unroll
            for (int bj = 0; bj < 2; ++bj) { float v = kmx[bj]; v = row_max16(v);
                if (fr == 0 && fq == 0) (void)__hip_atomic_fetch_max(kmax + (((u.pm >> 4) * 32 + (u.pn - 16) * 2 + bj) * 4 + wc), __builtin_bit_cast(unsigned, v), __ATOMIC_RELAXED, __HIP_MEMORY_SCOPE_AGENT); } }
    }
};

__device__ __forceinline__ float dpp_shr1_keep(float old, float src) { return __builtin_bit_cast(float, __builtin_amdgcn_update_dpp(__builtin_bit_cast(int, old), __builtin_bit_cast(int, src), 0x111, 0xf, 0xf, false)); }
__device__ __forceinline__ float dpp_ror1(float src) { return __builtin_bit_cast(float, __builtin_amdgcn_update_dpp(0, __builtin_bit_cast(int, src), 0x121, 0xf, 0xf, true)); }
struct EpiUpConv {
    static constexpr bool PERM = true, AFTER_DRAIN = false, ROWPERM = true;
    const u64_t* ss; bf16_t* ACT; float *HEAD, *TAIL; const float *cw, *cb; PG8_LAS float* xch; const PG8_LAS float* zeros; PG8_LAS float* wl;
    __device__ __forceinline__ void operator()(const f32x4 (&acc)[2][2][4][2], const Unit& u, int wr, int wc, int fr, int fq) const {
        const int cp = u.pn * 128 + wc * 32 + 8 * fq;
        PG8_LAS float* wsl = wl + (wr * 4 + wc) * 256;
        { const int ln = fq * 16 + fr, a = ln >> 3, ch = ln & 7;
          const float* src = (a < 6 ? cw + (a < 3 ? a : a - 3) * 22016 + (a < 3 ? 0 : 11008) : cb + (a - 6) * 11008) + u.pn * 128 + wc * 32 + 4 * ch;
          __builtin_amdgcn_global_load_lds((const unsigned*)src, (PG8_LAS unsigned*)wsl, 16, 0, 0); }
        float sc[2][4];
#pragma unroll
        for (int ai = 0; ai < 2; ++ai)
#pragma unroll
            for (int m = 0; m < 4; ++m) sc[ai][m] = rstd_fix(ss, u.pm * BM + ai * HALF + wr * 64 + 4 * fr + m, 1.f / 4096.f);
#pragma unroll
        for (int ai = 0; ai < 2; ++ai) {
            if (fr == 15) {
#pragma unroll
                for (int j = 0; j < 2; ++j) { PG8_LAS float* d = xch + (((2 * ai + wr) * 4 + wc) * 2 + j) * 64 + fq * 8;
#pragma unroll
                    for (int bj = 0; bj < 2; ++bj) { const f32x4 v0 = acc[ai][bj][2 + j][0] * sc[ai][2 + j], v1 = acc[ai][bj][2 + j][1] * sc[ai][2 + j]; *(PG8_LAS f32x4*)(d + bj * 32) = v0; *(PG8_LAS f32x4*)(d + bj * 32 + 4) = v1;
                        if (ai == 1 && wr == 1) { float* t = TAIL + ((size_t)(u.pm * 2 + j) * 2 + bj) * 11008 + cp; *(f32x4*)t = v0; *(f32x4*)(t + 4) = v1; } } } }
        }
        if (wr == 0 && fr == 0) {
#pragma unroll
            for (int j = 0; j < 2; ++j)
#pragma unroll
                for (int bj = 0; bj < 2; ++bj) { float* t = HEAD + ((size_t)(u.pm * 2 + j) * 2 + bj) * 11008 + cp; *(f32x4*)t = acc[0][bj][j][0] * sc[0][j]; *(f32x4*)(t + 4) = acc[0][bj][j][1] * sc[0][j]; } }
        asm volatile("s_waitcnt vmcnt(0) lgkmcnt(0)\n\ts_barrier" ::: "memory");
        unsigned plo[2][4][2];
#pragma unroll
        for (int hf = 0; hf < 2; ++hf) {
            const PG8_LAS float* wp = wsl + 8 * fq + 4 * hf;
            f32x4 wg[3], wu[3];
#pragma unroll
            for (int j = 0; j < 3; ++j) { wg[j] = *(const PG8_LAS f32x4*)(wp + j * 32); wu[j] = *(const PG8_LAS f32x4*)(wp + (3 + j) * 32); }
            const f32x4 bg = *(const PG8_LAS f32x4*)(wp + 6 * 32), bu = *(const PG8_LAS f32x4*)(wp + 7 * 32);
#pragma unroll
            for (int ai = 0; ai < 2; ++ai) {
                const int seg = 2 * ai + wr;
                const PG8_LAS float* s = (seg > 0 ? xch + (((seg - 1) * 4 + wc) * 2) * 64 : zeros) + fq * 8 + 4 * hf;
                const f32x4 h2g = *(const PG8_LAS f32x4*)s, h2u = *(const PG8_LAS f32x4*)(s + 32), h3g = *(const PG8_LAS f32x4*)(s + 64), h3u = *(const PG8_LAS f32x4*)(s + 96);
                f32x4 xg[4], xu[4];
#pragma unroll
                for (int m = 0; m < 4; ++m) { xg[m] = acc[ai][0][m][hf] * sc[ai][m]; xu[m] = acc[ai][1][m][hf] * sc[ai][m]; }
                f32x4 p1g, p1u, p2g, p2u;
#pragma unroll
                for (int e = 0; e < 4; ++e) { p1g[e] = dpp_shr1_keep(h3g[e], xg[3][e]); p1u[e] = dpp_shr1_keep(h3u[e], xu[3][e]); p2g[e] = dpp_shr1_keep(h2g[e], xg[2][e]); p2u[e] = dpp_shr1_keep(h2u[e], xu[2][e]); }
#pragma unroll
                for (int m = 0; m < 4; ++m) {
                    const f32x4 ag = m == 0 ? p1g : xg[m == 0 ? 0 : m - 1], au = m == 0 ? p1u : xu[m == 0 ? 0 : m - 1];
                    const f32x4 a2g = m == 0 ? p2g : (m == 1 ? p1g : xg[m < 2 ? 0 : m - 2]), a2u = m == 0 ? p2u : (m == 1 ? p1u : xu[m < 2 ? 0 : m - 2]);
                    float o[4];
#pragma unroll
                    for (int e = 0; e < 4; ++e) {
                        const float gv = fmaf(wg[2][e], xg[m][e], fmaf(wg[1][e], ag[e], fmaf(wg[0][e], a2g[e], bg[e]))), uv = fmaf(wu[2][e], xu[m][e], fmaf(wu[1][e], au[e], fmaf(wu[0][e], a2u[e], bu[e])));
                        o[e] = gv * uv * __builtin_amdgcn_rcpf(1.f + __builtin_amdgcn_exp2f(-gv)); }
                    const unsigned w0 = cvt_pk_bf16(o[0], o[1]), w1 = cvt_pk_bf16(o[2], o[3]);
                    if (hf == 0) { plo[ai][m][0] = w0; plo[ai][m][1] = w1; }
                    else if (!(seg == 0 && fr == 0 && m < 2)) { u32x4 w; w.x = plo[ai][m][0]; w.y = plo[ai][m][1]; w.z = w0; w.w = w1; *(u32x4*)(ACT + (size_t)(u.pm * BM + ai * HALF + wr * 64 + 4 * fr + m) * 11008 + cp) = w; }
                }
            }
        }
    }
};
template <class Epi, class Sched, bool ALIGN_EPI = false, bool SP2 = false>
__device__ __forceinline__ void gemm_phase(PG8_LAS unsigned char* lds, const Gemm g, const Sched& S, const Epi& E) {
    const int tid = threadIdx.x, wid = __builtin_amdgcn_readfirstlane(tid >> 6), lane = tid & 63, wr = wid >> 2, wc = wid & 3, fr = lane & 15, fq = lane >> 4;
    const int K = g.K, nt = K / BK;
    unsigned voffA[2], voffB[2];
#pragma unroll
    for (int i = 0; i < 2; ++i) { int R, C; stage_rc(tid * 16 + i * 8192, R, C); const int Rb = Epi::PERM ? ((R & ~31) + perm32(R & 31)) : R;
        const int Ra = Epi::ROWPERM ? ((R & 64) + 4 * (R & 15) + ((R >> 4) & 3)) : R;
        voffA[i] = (unsigned)(Ra * K + C) * 2u; voffB[i] = (unsigned)(Rb * K + C) * 2u; }
    const size_t kstep = (size_t)(BK * 2);
    const size_t hstep = (size_t)HALF * K * 2;
    const size_t tstep = 2 * hstep;
    const unsigned ldsw = (unsigned)wid * 1024u;
    const int aoff = lds_byte(wr * 64 + fr, fq * 8), boff = lds_byte(wc * 32 + fr, fq * 8);
#define PG8_SA(b, h) (((b) * 2 + (h)) * HTB)
#define PG8_SB(b, h) ((4 + (b) * 2 + (h)) * HTB)
#define PG8_STAGE(bufoff, gbase, voff) do { _Pragma("unroll") for (int _i = 0; _i < 2; ++_i) \
        __builtin_amdgcn_global_load_lds((const unsigned*)((const char*)(gbase) + (voff)[_i]), (PG8_LAS unsigned*)(lds + (bufoff) + ldsw + _i * 8192), 16, 0, 0); } while (0)
#define PG8_LDA(dst, b, h) do { _Pragma("unroll") for (int m = 0; m < 4; ++m) _Pragma("unroll") for (int k = 0; k < 2; ++k) dst[m][k] = *(const PG8_LAS bf16x8*)(lds + PG8_SA(b, h) + aoff + m * 2048 + k * 1024); } while (0)
#define PG8_LDB(dst, b, h) do { _Pragma("unroll") for (int n = 0; n < 2; ++n) _Pragma("unroll") for (int k = 0; k < 2; ++k) dst[n][k] = *(const PG8_LAS bf16x8*)(lds + PG8_SB(b, h) + boff + n * 2048 + k * 1024); } while (0)
#define PG8_MMA(ai, bj, At, Bt) do { __builtin_amdgcn_s_setprio(1); _Pragma("unroll") for (int m = 0; m < 4; ++m) _Pragma("unroll") for (int n = 0; n < 2; ++n) _Pragma("unroll") for (int k = 0; k < 2; ++k) \
        acc[ai][bj][m][n] = __builtin_amdgcn_mfma_f32_16x16x32_bf16(Bt[n][k], At[m][k], acc[ai][bj][m][n], 0, 0, 0); __builtin_amdgcn_s_setprio(0); } while (0)
#define PG8_WAIT_V(n) asm volatile("s_waitcnt vmcnt(" #n ")" ::: "memory")
#define PG8_WAIT_L(n) asm volatile("s_waitcnt lgkmcnt(" #n ")" ::: "memory")
#define PG8_BAR __builtin_amdgcn_s_barrier()
#define PG8_SCHED __builtin_amdgcn_sched_barrier(0)
    Unit cur, nxt; int ui = 0;
    if (!S.next(0, cur)) return;
    f32x4 acc[2][2][4][2];
#pragma unroll
    for (int a = 0; a < 2; ++a)
#pragma unroll
        for (int b = 0; b < 2; ++b)
#pragma unroll
            for (int m = 0; m < 4; ++m)
#pragma unroll
                for (int n = 0; n < 2; ++n) acc[a][b][m][n] = (f32x4){0.f, 0.f, 0.f, 0.f};
    bf16x8 At[4][2], B0[2][2], B1[2][2];
    const char* cA = (const char*)g.A + (size_t)cur.pm * tstep; const char* cB = (const char*)g.Bt + (size_t)cur.pn * tstep;
    S.a_ready(cur);
    if constexpr (SP2) {
        PG8_STAGE(PG8_SB(0, 0), cB, voffB); PG8_STAGE(PG8_SB(0, 1), cB + hstep, voffB); PG8_STAGE(PG8_SA(0, 0), cA, voffA); PG8_STAGE(PG8_SA(0, 1), cA + hstep, voffA);
        if (wr == 1) PG8_BAR;
        PG8_WAIT_V(2); PG8_BAR;
        PG8_STAGE(PG8_SB(1, 0), cB + kstep, voffB); PG8_STAGE(PG8_SA(1, 0), cA + kstep, voffA); PG8_STAGE(PG8_SB(1, 1), cB + hstep + kstep, voffB);
        PG8_WAIT_V(6); PG8_BAR;
    } else {
        PG8_STAGE(PG8_SB(0, 0), cB, voffB); PG8_STAGE(PG8_SA(0, 0), cA, voffA); PG8_STAGE(PG8_SB(0, 1), cB + hstep, voffB); PG8_STAGE(PG8_SA(0, 1), cA + hstep, voffA);
        if (wr == 1) PG8_BAR;
        PG8_WAIT_V(4); PG8_BAR;
        PG8_STAGE(PG8_SB(1, 0), cB + kstep, voffB); PG8_STAGE(PG8_SA(1, 0), cA + kstep, voffA); PG8_STAGE(PG8_SB(1, 1), cB + hstep + kstep, voffB);
        PG8_WAIT_V(6); PG8_BAR;
    }
    for (;;) {
        const bool has_next = S.next(ui + 1, nxt);
        const char* nA = has_next ? (const char*)g.A + (size_t)nxt.pm * tstep : cA; const char* nB = has_next ? (const char*)g.Bt + (size_t)nxt.pn * tstep : cB;
        for (int t = 0; t < nt; t += 2) {
            const bool last = (t == nt - 2);
            const char* a1 = cA + (size_t)(t + 1) * kstep;
            const char* a2 = last ? nA : cA + (size_t)(t + 2) * kstep; const char* b2 = last ? nB : cB + (size_t)(t + 2) * kstep;
            const char* a3 = a2 + kstep; const char* b3 = b2 + kstep;
            if (last && has_next) S.a_ready(nxt);
            if constexpr (SP2) {
            PG8_LDB(B0, 0, 0); PG8_LDB(B1, 0, 1); PG8_SCHED; PG8_LDA(At, 0, 0); PG8_STAGE(PG8_SA(1, 1), a1 + hstep, voffA);
            PG8_WAIT_V(8); PG8_WAIT_L(0); PG8_BAR; PG8_MMA(0, 0, At, B0); PG8_MMA(0, 1, At, B1); PG8_BAR; PG8_SCHED;
            PG8_LDA(At, 0, 1); PG8_STAGE(PG8_SB(0, 0), b2, voffB); PG8_STAGE(PG8_SB(0, 1), b2 + hstep, voffB); PG8_STAGE(PG8_SA(0, 0), a2, voffA);
            PG8_WAIT_V(8); PG8_WAIT_L(0); PG8_BAR; PG8_MMA(1, 0, At, B0); PG8_MMA(1, 1, At, B1); PG8_BAR; PG8_SCHED;
            PG8_LDB(B0, 1, 0); PG8_LDB(B1, 1, 1); PG8_SCHED; PG8_LDA(At, 1, 0); PG8_STAGE(PG8_SA(0, 1), a2 + hstep, voffA);
            PG8_WAIT_V(8); PG8_WAIT_L(0); PG8_BAR; PG8_MMA(0, 0, At, B0); PG8_MMA(0, 1, At, B1); PG8_BAR; PG8_SCHED;
            PG8_LDA(At, 1, 1); PG8_STAGE(PG8_SB(1, 0), b3, voffB); PG8_STAGE(PG8_SB(1, 1), b3 + hstep, voffB); PG8_STAGE(PG8_SA(1, 0), a3, voffA);
            PG8_WAIT_V(8); PG8_WAIT_L(0); PG8_BAR; PG8_MMA(1, 0, At, B0); PG8_MMA(1, 1, At, B1); PG8_BAR; PG8_SCHED;
            } else {
            PG8_LDB(B0, 0, 0); PG8_SCHED; PG8_LDA(At, 0, 0); PG8_STAGE(PG8_SA(1, 1), a1 + hstep, voffA);
            PG8_WAIT_L(8); PG8_BAR; PG8_WAIT_L(0); PG8_MMA(0, 0, At, B0); PG8_BAR; PG8_SCHED;
            PG8_LDB(B1, 0, 1); PG8_STAGE(PG8_SB(0, 0), b2, voffB);
            PG8_BAR; PG8_WAIT_L(0); PG8_MMA(0, 1, At, B1); PG8_BAR;
            PG8_LDA(At, 0, 1); PG8_STAGE(PG8_SA(0, 0), a2, voffA);
            PG8_BAR; PG8_WAIT_L(0); PG8_MMA(1, 0, At, B0); PG8_BAR; PG8_SCHED;
            PG8_STAGE(PG8_SB(0, 1), b2 + hstep, voffB);
            PG8_WAIT_V(6); PG8_BAR; PG8_MMA(1, 1, At, B1); PG8_BAR;
            PG8_LDB(B0, 1, 0); PG8_SCHED; PG8_LDA(At, 1, 0); PG8_STAGE(PG8_SA(0, 1), a2 + hstep, voffA);
            PG8_WAIT_L(8); PG8_BAR; PG8_WAIT_L(0); PG8_MMA(0, 0, At, B0); PG8_BAR; PG8_SCHED;
            PG8_LDB(B1, 1, 1); PG8_STAGE(PG8_SB(1, 0), b3, voffB);
            PG8_BAR; PG8_WAIT_L(0); PG8_MMA(0, 1, At, B1); PG8_BAR;
            PG8_LDA(At, 1, 1); PG8_STAGE(PG8_SA(1, 0), a3, voffA);
            PG8_BAR; PG8_WAIT_L(0); PG8_MMA(1, 0, At, B0); PG8_BAR; PG8_SCHED;
            PG8_STAGE(PG8_SB(1, 1), b3 + hstep, voffB);
            PG8_WAIT_V(6); PG8_BAR; PG8_MMA(1, 1, At, B1); PG8_BAR;
            }
        }
        if constexpr (ALIGN_EPI) { if (wr == 0) PG8_BAR; }
        if constexpr (!Epi::AFTER_DRAIN) { E(acc, cur, wr, wc, fr, fq); S.done(cur); }
        if (!has_next) break;
#pragma unroll
        for (int a = 0; a < 2; ++a)
#pragma unroll
            for (int b = 0; b < 2; ++b)
#pragma unroll
                for (int m = 0; m < 4; ++m)
#pragma unroll
                    for (int n = 0; n < 2; ++n) acc[a][b][m][n] = (f32x4){0.f, 0.f, 0.f, 0.f};
        cur = nxt; cA = nA; cB = nB; ++ui;
        if constexpr (ALIGN_EPI) { if (wr == 1) PG8_BAR; }
    }
    PG8_WAIT_V(0);
    if constexpr (!ALIGN_EPI) { if (wr == 0) PG8_BAR; }
    PG8_BAR;
    if constexpr (Epi::AFTER_DRAIN) { E.fused(acc, cur, wr, wc, fr, fq, lds, wid, lane); S.done(cur); }
#undef PG8_SA
#undef PG8_SB
#undef PG8_STAGE
#undef PG8_LDA
#undef PG8_LDB
#undef PG8_MMA
#undef PG8_WAIT_V
#undef PG8_WAIT_L
#undef PG8_BAR
#undef PG8_SCHED
}
}

constexpr int NWAVES = 8;
constexpr int SEQ = 4096, DM = 4096, M = 8192, FF = 11008, FF2 = 22016, NAB = 7936;
constexpr float EPS = 1e-6f;
constexpr float LAMBDA_INIT = 0.35550906f;
#ifndef MK_ONE_LAUNCH
#define MK_ONE_LAUNCH 1
#endif
constexpr int N_PHASES = 15;

constexpr size_t MiB = 1u << 20;
constexpr size_t WS_CTL = 0, CTL_ZERO_BYTES = 1 * MiB;
constexpr size_t WS_SS = 262144;
constexpr size_t WS_ROPE = 1 * MiB;
constexpr size_t WS_WABIN = 2 * MiB, WS_WUQ = 64 * MiB, WS_WUKV = 70 * MiB, WS_WABOUT = 74 * MiB, WS_WCIN = 106 * MiB, WS_WCOUT = 202 * MiB;
constexpr size_t WS_WUP0 = 234 * MiB, WS_WUP1 = 406 * MiB, WS_WDN0 = 578 * MiB, WS_WDN1 = 664 * MiB;
constexpr size_t WS_HB = 752 * MiB, WS_H = 816 * MiB, WS_CQ = 944 * MiB, WS_CKV = 960 * MiB, WS_KR = 968 * MiB, WS_SBQ = 970 * MiB, WS_SBK = 1002 * MiB, WS_SBVT = 1034 * MiB;
constexpr size_t WS_QA = 1066 * MiB, WS_KN = 1114 * MiB, WS_VAT = 1146 * MiB, WS_O = 1178 * MiB, WS_UP = 1242 * MiB, WS_ACT = 1586 * MiB;
constexpr size_t WS_CQ1 = 1758 * MiB, WS_CK1 = 1822 * MiB, WS_CVT = 1886 * MiB, WS_DS = 1950 * MiB, WS_DS1 = 2078 * MiB, WS_HEAD = 2206 * MiB, WS_TAIL = 2214 * MiB, WS_CWS = 2222 * MiB  , WS_END = 2223 * MiB;
static_assert(WS_WABIN + (size_t)NAB * 4096 * 2 <= WS_WUQ && WS_WUP0 + (size_t)FF2 * 4096 * 2 <= WS_WUP1 && WS_WDN1 + (size_t)4096 * FF * 2 <= WS_HB && WS_UP + (size_t)M * FF2 * 2 <= WS_ACT && WS_ACT + (size_t)M * FF * 2 <= WS_CQ1, "d_ws map");
constexpr int CW_KMAX = 2048, CW_QUEUE = 2560;
constexpr int CW_BAR = 4096;

constexpr int RING_OFF = 0, RING_BYTES = 131072;
constexpr int LDSCTL_OFF = 139264, MISC_OFF = LDSCTL_OFF + 320;
constexpr int CONVW_OFF = 141312;
constexpr int LDS_BYTES = 149504;

#define GAS __attribute__((address_space(1)))
#define LAS __attribute__((address_space(3)))
typedef unsigned short bf16;
typedef unsigned v4u __attribute__((ext_vector_type(4)));
typedef float f32x4 __attribute__((ext_vector_type(4)));
typedef short bf16x8 __attribute__((ext_vector_type(8)));
typedef GAS unsigned gu32;
#define RLX_AGENT __ATOMIC_RELAXED, __HIP_MEMORY_SCOPE_AGENT
#define LDS_WAIT() asm volatile("s_waitcnt lgkmcnt(0)" ::: "memory")
#define VM_WAIT() asm volatile("s_waitcnt vmcnt(0)" ::: "memory")
__device__ __forceinline__ unsigned f2bf(float f) { unsigned u = __builtin_bit_cast(unsigned, f); return (u + 0x7fffu + ((u >> 16) & 1u)) >> 16; }
__device__ __forceinline__ unsigned pk2(float lo, float hi) { return f2bf(lo) | (f2bf(hi) << 16); }
__device__ __forceinline__ float bf2f(unsigned short b) { return __builtin_bit_cast(float, (unsigned)b << 16); }
__device__ __forceinline__ float bflo(unsigned w) { return __builtin_bit_cast(float, w << 16); }
__device__ __forceinline__ float bfhi(unsigned w) { return __builtin_bit_cast(float, w & 0xffff0000u); }
__device__ __forceinline__ float wave_sum(float v) { return sum_x32(sum_x16(row_sum16(v))); }
__device__ __forceinline__ float wave_max(float v) { return max_x32(max_x16(row_max16(v))); }
#define XB_TMO      128
#define XB_XCNT(j)  (256  + 64 * (j))
#define XB_XSUB(j)  (1280 + 64 * (j))
#define XB_XGEN(j)  (2304 + 64 * (j))
#define XB_TOP      3328
#define XB_TOPGEN   3392
#define XCD_BAR_WORDS 3456
#define XB_SPIN_CAP (1u << 18)

__device__ __forceinline__ unsigned xb_ld(unsigned* p)              { return __hip_atomic_load(p, __ATOMIC_RELAXED, __HIP_MEMORY_SCOPE_AGENT); }
__device__ __forceinline__ unsigned xb_add(unsigned* p, unsigned v) { return __hip_atomic_fetch_add(p, v, __ATOMIC_RELAXED, __HIP_MEMORY_SCOPE_AGENT); }
__device__ __forceinline__ unsigned xb_xcc_id() { return (unsigned)__builtin_amdgcn_s_getreg((3 << 11) | 20) & 0xFu; }
#define XB_SPIN(cond, bar) do { unsigned _sp = 0; while (cond) { __builtin_amdgcn_s_sleep(1); \
    if ((++_sp & 255u) == 0u) { if (xb_ld(&(bar)[XB_TMO])) break; if (_sp > XB_SPIN_CAP) { atomicAdd(&(bar)[XB_TMO], 1u); break; } } } } while (0)

struct XcdBarrier {
    unsigned* bar; unsigned x;
    volatile LAS unsigned* st;
};

__device__ __forceinline__ XcdBarrier xcd_barrier_post(unsigned* bar, volatile LAS unsigned* st) {
    XcdBarrier b; b.bar = bar; b.x = xb_xcc_id(); b.st = st;
    if (threadIdx.x == 0) (void)xb_add(&bar[XB_XCNT(b.x)], 1u);
    return b;
}
__device__ __forceinline__ void xcd_barrier_complete(unsigned* bar, unsigned x, unsigned& nloc, unsigned& nx) {
    const unsigned G = gridDim.x * gridDim.y * gridDim.z;
    unsigned sum, cnt, mine, sp = 0u;
    for (;;) {
        sum = 0u; cnt = 0u; mine = 0u;
#pragma unroll
        for (unsigned j = 0; j < 16; ++j) { const unsigned c = xb_ld(&bar[XB_XCNT(j)]); sum += c; cnt += (c > 0u) ? 1u : 0u; mine = (j == x) ? c : mine; }
        if (sum == G) break;
        __builtin_amdgcn_s_sleep(1);
        if ((++sp & 255u) == 0u) { if (xb_ld(&bar[XB_TMO])) break; if (sp > XB_SPIN_CAP) { atomicAdd(&bar[XB_TMO], 1u); break; } }
    }
    nloc = mine > 0u ? mine : 1u; nx = cnt > 0u ? cnt : 1u;
}

__device__ __forceinline__ void xcd_barrier(const XcdBarrier& b) {
    asm volatile("s_waitcnt vmcnt(0)" ::: "memory");
    __syncthreads();
    if (threadIdx.x == 0) {
        unsigned* bar = b.bar;
        __builtin_amdgcn_s_waitcnt(0);
        unsigned nloc = b.st[0], nx = b.st[1];
        if (nloc == 0u) { xcd_barrier_complete(bar, b.x, nloc, nx); b.st[0] = nloc; b.st[1] = nx; }
        const unsigned old = xb_add(&bar[XB_XSUB(b.x)], 1u);
        const unsigned gen = old / nloc;
        if (old + 1u == (gen + 1u) * nloc) {
            __builtin_amdgcn_fence(__ATOMIC_RELEASE, "agent");
            asm volatile("s_waitcnt vmcnt(0)" ::: "memory");
            const unsigned og = xb_add(&bar[XB_TOP], 1u);
            const unsigned tg = og / nx;
            if (og + 1u == (tg + 1u) * nx) xb_add(&bar[XB_TOPGEN], 1u);
            else XB_SPIN(xb_ld(&bar[XB_TOPGEN]) == tg, bar);
            __builtin_amdgcn_fence(__ATOMIC_ACQUIRE, "agent");
            xb_add(&bar[XB_XGEN(b.x)], 1u);
            asm volatile("s_waitcnt vmcnt(0)" ::: "memory");
        } else {
            XB_SPIN(xb_ld(&bar[XB_XGEN(b.x)]) == gen, bar);
            __builtin_amdgcn_fence(__ATOMIC_ACQUIRE, "agent");
            asm volatile("s_waitcnt vmcnt(0)" ::: "memory");
        }
    }
    __syncthreads();
}

typedef float f32x16 __attribute__((ext_vector_type(16)));
typedef float f32x2v __attribute__((ext_vector_type(2)));
typedef __bf16 bf16x2v __attribute__((ext_vector_type(2)));
#define MFMA32(a, b, c) __builtin_amdgcn_mfma_f32_32x32x16_bf16((a), (b), (c), 0, 0, 0)
__device__ __forceinline__ int swz23(int m) { return (m & ~12) | ((m & 4) << 1) | ((m & 8) >> 1); }
__device__ __forceinline__ unsigned pkbf(float a, float b) { const f32x2v v = {a, b}; return __builtin_bit_cast(unsigned, __builtin_convertvector(v, bf16x2v)); }
__device__ __forceinline__ bf16x8 pack8(const f32x16& x, int c) { v4u w; w.x = pkbf(x[8 * c], x[8 * c + 1]); w.y = pkbf(x[8 * c + 2], x[8 * c + 3]); w.z = pkbf(x[8 * c + 4], x[8 * c + 5]); w.w = pkbf(x[8 * c + 6], x[8 * c + 7]); return __builtin_bit_cast(bf16x8, w); }
__device__ __forceinline__ float xhalf(float v) { return __shfl_xor(v, 32); }

template <int DQK, int DV> struct AttnTile {
    static constexpr int KS = DQK * 2 + 16, VS = 144, KBYTES = 64 * KS, VBYTES = DV * VS, BUF = KBYTES + VBYTES;
    static constexpr int NK = 64 * (DQK / 8) / 512, NV = DV * 8 / 512;
    v4u rk[NK], rv[NV];
    unsigned gk, gk2, gv;
    __device__ __forceinline__ void init(int k_pitch, int tid) { gk = (unsigned)((tid >> 4) * k_pitch + (tid & 15) * 8) * 2u; gk2 = (unsigned)((tid >> 3) * 64 + (tid & 7) * 8) * 2u; gv = (unsigned)((tid >> 3) * 4096 + (tid & 7) * 8) * 2u; }
    __amdgpu_buffer_rsrc_t r1, r2, rv_;
    __device__ __forceinline__ void bind(const bf16* K1, const bf16* K2, const bf16* VT) {
        r1 = __builtin_amdgcn_make_buffer_rsrc((void*)K1, 0, 0x7fffffff, 0x00020000); r2 = __builtin_amdgcn_make_buffer_rsrc((void*)(DQK == 192 ? K2 : K1), 0, 0x7fffffff, 0x00020000);
        rv_ = __builtin_amdgcn_make_buffer_rsrc((void*)VT, 0, 0x7fffffff, 0x00020000); }
    __device__ __forceinline__ void load(int k_pitch, int kt) {
        const int ko = kt * 64 * k_pitch * 2;
        rk[0] = __builtin_amdgcn_raw_buffer_load_b128(r1, gk, ko, 0); rk[1] = __builtin_amdgcn_raw_buffer_load_b128(r1, gk, ko + k_pitch * 64, 0);
        if (DQK == 192) rk[NK - 1] = __builtin_amdgcn_raw_buffer_load_b128(r2, gk2, kt * 64 * 64 * 2, 0);
#pragma unroll
        for (int i = 0; i < NV; ++i) rv[i] = __builtin_amdgcn_raw_buffer_load_b128(rv_, gv, kt * 128 + i * (64 * 4096 * 2), 0);
    }
    __device__ __forceinline__ void store(LAS unsigned char* buf, int tid) const {
#pragma unroll
        for (int i = 0; i < 2; ++i) { const int c = tid + 512 * i, r = c >> 4, cc = c & 15; *(LAS v4u*)(buf + r * KS + cc * 16) = rk[i]; }
        if (DQK == 192) { const int r = tid >> 3, cc = tid & 7; *(LAS v4u*)(buf + r * KS + 256 + cc * 16) = rk[NK - 1]; }
#pragma unroll
        for (int i = 0; i < NV; ++i) { const int c = tid + 512 * i, d = c >> 3, cc = c & 7; *(LAS v4u*)(buf + KBYTES + d * VS + cc * 16) = rv[i]; }
    }
};
template <int DQK> __device__ __forceinline__ void qk_tile(const LAS unsigned char* kb, int KS, const bf16x8 (&qf)[DQK / 16], int lane, f32x16 (&s)[2]) {
    const int h = lane >> 5, kr = swz23(lane & 31);
    f32x16 a0, a1;
#pragma unroll
    for (int i = 0; i < 16; ++i) { a0[i] = 0.f; a1[i] = 0.f; }
    const LAS unsigned char* p0 = kb + kr * KS + h * 16; const LAS unsigned char* p1 = p0 + 32 * KS;
    constexpr int G = DQK / 32;
    bf16x8 f[2][4];
#define QK_LOAD(dst, g) do { dst[0] = *(const LAS bf16x8*)(p0 + (g) * 64); dst[1] = *(const LAS bf16x8*)(p1 + (g) * 64); dst[2] = *(const LAS bf16x8*)(p0 + (g) * 64 + 32); dst[3] = *(const LAS bf16x8*)(p1 + (g) * 64 + 32); } while (0)
    QK_LOAD(f[0], 0);
#pragma unroll
    for (int g = 0; g < G; ++g) {
        if (g + 1 < G) QK_LOAD(f[(g + 1) & 1], g + 1);
        __builtin_amdgcn_sched_barrier(0);
        a0 = MFMA32(f[g & 1][0], qf[2 * g], a0); a1 = MFMA32(f[g & 1][1], qf[2 * g], a1); a0 = MFMA32(f[g & 1][2], qf[2 * g + 1], a0); a1 = MFMA32(f[g & 1][3], qf[2 * g + 1], a1);
        __builtin_amdgcn_sched_barrier(0);
    }
#undef QK_LOAD
    s[0] = a0; s[1] = a1;
}
template <int DV> __device__ __forceinline__ void pv_tile(const LAS unsigned char* vb, const f32x16 (&p)[2], int lane, f32x16 (&o)[DV / 32]) {
    const int h = lane >> 5, dr = swz23(lane & 31);
    bf16x8 pf[4];
#pragma unroll
    for (int g = 0; g < 4; ++g) pf[g] = pack8(p[g >> 1], g & 1);
    const LAS unsigned char* q = vb + dr * 144 + h * 16;
    constexpr int NB = DV / 32;
    bf16x8 f[2][NB];
#define PV_LOAD(dst, g) do { _Pragma("unroll") for (int db = 0; db < NB; ++db) dst[db] = *(const LAS bf16x8*)(q + db * (32 * 144) + (g) * 32); } while (0)
    PV_LOAD(f[0], 0);
#pragma unroll
    for (int g = 0; g < 4; ++g) {
        if (g + 1 < 4) PV_LOAD(f[(g + 1) & 1], g + 1);
        __builtin_amdgcn_sched_barrier(0);
#pragma unroll
        for (int db = 0; db < NB; ++db) o[db] = MFMA32(f[g & 1][db], pf[g], o[db]);
        __builtin_amdgcn_sched_barrier(0);
    }
#undef PV_LOAD
}
__device__ __forceinline__ void store_o8(bf16* p, const f32x16& x, int c, float sc) {
    v4u w; w.x = pkbf(x[8 * c] * sc, x[8 * c + 1] * sc); w.y = pkbf(x[8 * c + 2] * sc, x[8 * c + 3] * sc); w.z = pkbf(x[8 * c + 4] * sc, x[8 * c + 5] * sc); w.w = pkbf(x[8 * c + 6] * sc, x[8 * c + 7] * sc);
    *(GAS v4u*)p = w; }
__device__ __forceinline__ void sb_unit(LAS unsigned char* lds, unsigned char* ws, int bh, int qb, int tid, int wave, int lane) {
    typedef AttnTile<128, 128> T;
    const int b = bh >> 4, hd = bh & 15, q0 = qb * 256, h = lane >> 5, t = q0 + 32 * wave + (lane & 31);
    const bf16* Q = (const bf16*)(ws + WS_SBQ) + (size_t)b * SEQ * 2048 + hd * 128;
    const bf16* K1 = (const bf16*)(ws + WS_SBK) + (size_t)b * SEQ * 2048 + hd * 128;
    const bf16* VT = (const bf16*)(ws + WS_SBVT) + (size_t)bh * 128 * 4096;
    volatile LAS unsigned* flags = (volatile LAS unsigned*)(lds + 2 * T::BUF);
    bf16x8 qf[8];
#pragma unroll
    for (int kk = 0; kk < 8; ++kk) qf[kk] = __builtin_bit_cast(bf16x8, *(const GAS v4u*)(Q + (size_t)t * 2048 + 16 * kk + 8 * h));
    f32x16 o[4];
#pragma unroll
    for (int db = 0; db < 4; ++db)
#pragma unroll
        for (int i = 0; i < 16; ++i) o[db][i] = 0.f;
    float carry = 0.f; bool mydone = false;
    const int kt_hi = (q0 >> 6) + 3, ktw = (q0 >> 6) + (wave >> 1);

    T tile; tile.init(2048, tid); tile.bind(K1, K1, VT); tile.load(2048, kt_hi); tile.store(lds, tid); __syncthreads();
    int it = 0;
#pragma unroll 1
    for (int kt = kt_hi; kt >= 0; --kt, ++it) {
        const LAS unsigned char* kb = lds + (it & 1) * T::BUF;
        if (kt > 0) tile.load(2048, kt - 1);
        if (kt <= ktw && !mydone) {
            f32x16 s[2]; qk_tile<128>(kb, T::KS, qf, lane, s);
            float tot[2][2];
#pragma unroll
            for (int blk = 0; blk < 2; ++blk)
#pragma unroll
                for (int c = 0; c < 2; ++c) { float run = 0.f;
#pragma unroll
                    for (int j = 7; j >= 0; --j) { const int i = 8 * c + j, key = kt * 64 + 32 * blk + 16 * c + 8 * h + j; const bool valid = key < t;
                        const float z = s[blk][i];
                        const float lsig = fminf(z, 0.f) - __builtin_amdgcn_logf(1.f + __builtin_amdgcn_exp2f(-fabsf(z)));
                        const float lk = valid ? lsig - z : 0.f;
                        s[blk][i] = valid ? (lsig + run) : -INFINITY;
                        run += lk; }
                    tot[blk][c] = run; }
            float par[2][2], off[2][2];
#pragma unroll
            for (int blk = 0; blk < 2; ++blk)
#pragma unroll
                for (int c = 0; c < 2; ++c) par[blk][c] = xhalf(tot[blk][c]);
            float acc = carry;
            off[1][1] = acc + (h == 0 ? par[1][1] : 0.f); acc += tot[1][1] + par[1][1];
            off[1][0] = acc + (h == 0 ? par[1][0] : 0.f); acc += tot[1][0] + par[1][0];
            off[0][1] = acc + (h == 0 ? par[0][1] : 0.f); acc += tot[0][1] + par[0][1];
            off[0][0] = acc + (h == 0 ? par[0][0] : 0.f); acc += tot[0][0] + par[0][0];
            carry = acc;
#pragma unroll
            for (int blk = 0; blk < 2; ++blk)
#pragma unroll
                for (int i = 0; i < 16; ++i) s[blk][i] = __builtin_amdgcn_exp2f(s[blk][i] + off[blk][i >> 3]);
            pv_tile<128>(kb + T::KBYTES, s, lane, o);
            mydone = __all(carry < -43.28f);
        }
        if (kt > 0) tile.store(lds + ((it + 1) & 1) * T::BUF, tid);
        if (lane == 0) flags[(it & 1) * 8 + wave] = mydone ? 1u : 0u;
        __syncthreads();
        unsigned alld = 1u;
#pragma unroll
        for (int w = 0; w < 8; ++w) alld &= flags[(it & 1) * 8 + w];
        if (alld) break;
    }
    __syncthreads();
    bf16* orow = (bf16*)(ws + WS_O) + (size_t)(b * SEQ + t) * 4096 + 2048 + hd * 128 + 8 * h;
#pragma unroll
    for (int db = 0; db < 4; ++db) { store_o8(orow + 32 * db, o[db], 0, 1.f); store_o8(orow + 32 * db + 16, o[db], 1, 1.f); }
}
template <int DQK, int DV> struct DmaTile {
    static constexpr int KB = 64 * 256, KRB = (DQK == 192) ? 64 * 128 : 0, VB = DV * 128, BUF = KB + KRB + VB, NVW = DV / 64;
    __amdgpu_buffer_rsrc_t r1, r2, rv;
    unsigned gk0, gk1, gk2, gvE, gvO; int kpb;
    __device__ __forceinline__ void init(const bf16* K1, int k_pitch, const bf16* K2, const bf16* VT, int wave, int lane) {
        r1 = __builtin_amdgcn_make_buffer_rsrc((void*)K1, 0, 0x7fffffff, 0x00020000); r2 = __builtin_amdgcn_make_buffer_rsrc((void*)(DQK == 192 ? K2 : K1), 0, 0x7fffffff, 0x00020000);
        rv = __builtin_amdgcn_make_buffer_rsrc((void*)VT, 0, 0x7fffffff, 0x00020000); kpb = k_pitch * 2;
        { const int p = lane & 15, ra = 8 * wave + (lane >> 4), rb = ra + 4; gk0 = (unsigned)(ra * kpb + ((p ^ (ra & 15)) << 4)); gk1 = (unsigned)(rb * kpb + ((p ^ (rb & 15)) << 4)); }
        { const int p = lane & 7, r = 8 * wave + (lane >> 3); gk2 = (unsigned)(r * 128 + ((p ^ ((r >> 1) & 7)) << 4)); }
        { const int p = lane & 7, l3 = lane >> 3, d0 = 8 * wave * NVW + l3; gvE = (unsigned)(d0 * 8192 + ((p ^ (l3 >> 1)) << 4)); gvO = (unsigned)((d0 + 8) * 8192 + ((p ^ (4 + (l3 >> 1))) << 4)); }
    }
    __device__ __forceinline__ void issue(LAS unsigned char* buf, int kt, int wave) const {
        __builtin_amdgcn_raw_ptr_buffer_load_lds(r1, (LAS void*)(buf + wave * 2048), 16, gk0, kt * 64 * kpb, 0, 0);
        __builtin_amdgcn_raw_ptr_buffer_load_lds(r1, (LAS void*)(buf + wave * 2048 + 1024), 16, gk1, kt * 64 * kpb, 0, 0);
        if (DQK == 192) __builtin_amdgcn_raw_ptr_buffer_load_lds(r2, (LAS void*)(buf + KB + wave * 1024), 16, gk2, kt * 64 * 128, 0, 0);
#pragma unroll
        for (int i = 0; i < NVW; ++i) __builtin_amdgcn_raw_ptr_buffer_load_lds(rv, (LAS void*)(buf + KB + KRB + (wave * NVW + i) * 1024), 16, (i & 1) ? gvO : gvE, kt * 128 + (i >> 1) * (16 * 8192), 0, 0);
    }
};
template <int DQK> __device__ __forceinline__ void qk_tile2(const LAS unsigned char* kb, const bf16x8 (&qf)[DQK / 16], int lane_, f32x16 (&s)[2]) {
    int lane = lane_; asm volatile("" : "+v"(lane));
    const int h = lane >> 5, r = swz23(lane & 31), y = h ^ (r & 15), yr = h ^ ((r >> 1) & 7);
    const LAS unsigned char* p0 = kb + r * 256; const LAS unsigned char* pr = kb + 64 * 256 + r * 128;
    f32x16 a0, a1;
#pragma unroll
    for (int i = 0; i < 16; ++i) { a0[i] = 0.f; a1[i] = 0.f; }
    bf16x8 f[2][2];
#define QK2_LOAD(dst, kk) do { if ((kk) < 8) { const LAS unsigned char* q_ = p0 + ((y ^ (2 * (kk))) << 4); dst[0] = *(const LAS bf16x8*)q_; dst[1] = *(const LAS bf16x8*)(q_ + 32 * 256); } \
                               else { const LAS unsigned char* q_ = pr + ((yr ^ (2 * ((kk) - 8))) << 4); dst[0] = *(const LAS bf16x8*)q_; dst[1] = *(const LAS bf16x8*)(q_ + 32 * 128); } } while (0)
    QK2_LOAD(f[0], 0);
#pragma unroll
    for (int kk = 0; kk < DQK / 16; ++kk) {
        if (kk + 1 < DQK / 16) QK2_LOAD(f[(kk + 1) & 1], kk + 1);
        __builtin_amdgcn_sched_barrier(0);
        a0 = MFMA32(f[kk & 1][0], qf[kk], a0); a1 = MFMA32(f[kk & 1][1], qf[kk], a1);
        __builtin_amdgcn_sched_barrier(0);
    }
#undef QK2_LOAD
    s[0] = a0; s[1] = a1;
}
constexpr float LAZY_T = 8.f;
constexpr float EXIT_T = 40.f;
__device__ __forceinline__ void exp3(float x0, float x1, float x2, float mn, float& p0, float& p1, float& p2, float& r0, float& r1, float& r2) {
    asm("v_sub_f32 %0, %6, %9\n\tv_sub_f32 %1, %7, %9\n\tv_sub_f32 %2, %8, %9\n\tv_exp_f32 %0, %0\n\tv_exp_f32 %1, %1\n\tv_exp_f32 %2, %2\n\tv_add_f32 %3, %3, %0\n\tv_add_f32 %4, %4, %1\n\tv_add_f32 %5, %5, %2"
        : "=&v"(p0), "=&v"(p1), "=&v"(p2), "+v"(r0), "+v"(r1), "+v"(r2) : "v"(x0), "v"(x1), "v"(x2), "v"(mn)); }
__device__ __forceinline__ void exp2p(float x0, float x1, float mn, float& p0, float& p1, float& r0, float& r1) {
    asm("v_sub_f32 %0, %4, %6\n\tv_sub_f32 %1, %5, %6\n\tv_exp_f32 %0, %0\n\tv_exp_f32 %1, %1\n\tv_add_f32 %2, %2, %0\n\tv_add_f32 %3, %3, %1" : "=&v"(p0), "=&v"(p1), "+v"(r0), "+v"(r1) : "v"(x0), "v"(x1), "v"(mn)); }
__device__ __forceinline__ float xmax_half(float v) {
    return max_x32(v); }
template <int DV> __device__ __forceinline__ void pv_tile2p(const LAS unsigned char* vb, const bf16x8 (&pf)[4], int lane_, f32x16 (&o)[DV / 32]) {
    int lane = lane_; asm volatile("" : "+v"(lane));
    const int h = lane >> 5, dr = swz23(lane & 31), yv = h ^ ((dr >> 1) & 7);
    const LAS unsigned char* q = vb + dr * 128;
    constexpr int NB = DV / 32, W = (DV == 256) ? 2 : 4, SPG = NB / W, NS = 4 * SPG;
    bf16x8 f[2][W];
#define PV2_LOAD(dst, st) do { const int g_ = (st) / SPG, b0_ = W * ((st) % SPG); const LAS unsigned char* q_ = q + ((yv ^ (2 * g_)) << 4) + b0_ * 4096; \
        _Pragma("unroll") for (int j = 0; j < W; ++j) dst[j] = *(const LAS bf16x8*)(q_ + j * 4096); } while (0)
    PV2_LOAD(f[0], 0);
#pragma unroll
    for (int st = 0; st < NS; ++st) {
        if (st + 1 < NS) PV2_LOAD(f[(st + 1) & 1], st + 1);
        __builtin_amdgcn_sched_barrier(0);
#pragma unroll
        for (int j = 0; j < W; ++j) o[W * (st % SPG) + j] = MFMA32(f[st & 1][j], pf[st / SPG], o[W * (st % SPG) + j]);
        __builtin_amdgcn_sched_barrier(0);
    }
#undef PV2_LOAD
}
template <int DV, bool ALIBI> __device__ __forceinline__ float softmax_step(f32x16 (&s)[2], bool past, float tb, float slope_l2, float& mrow, float& lrow, f32x16 (&o)[DV / 32], bf16x8 (&pf)[4]) {
    if (ALIBI) {
        if (past) {
#pragma unroll
            for (int blk = 0; blk < 2; ++blk)
#pragma unroll
                for (int i = 0; i < 16; ++i) s[blk][i] = fmaf(-slope_l2, tb - (float)(32 * blk + 16 * (i >> 3) + (i & 7)), s[blk][i]);
        } else {
#pragma unroll
            for (int blk = 0; blk < 2; ++blk)
#pragma unroll
                for (int i = 0; i < 16; ++i) s[blk][i] = fmaf(-slope_l2, fabsf(tb - (float)(32 * blk + 16 * (i >> 3) + (i & 7))), s[blk][i]); } }
    float mx = fmaxf(fmaxf(s[0][0], s[0][1]), s[1][0]);
#pragma unroll
    for (int i = 2; i < 16; i += 2) mx = fmaxf(fmaxf(mx, s[0][i]), s[0][i + 1]);
#pragma unroll
    for (int i = 1; i < 15; i += 2) mx = fmaxf(fmaxf(mx, s[1][i]), s[1][i + 1]);
    mx = fmaxf(mx, s[1][15]);
    mx = xmax_half(mx);
    const bool chg = mx > mrow + LAZY_T; const float mnew = chg ? mx : mrow, alpha = (chg && mrow > -INFINITY) ? __builtin_amdgcn_exp2f(mrow - mnew) : 1.f; mrow = mnew;
    float rs0 = 0.f, rs1 = 0.f, rs2 = 0.f;
#define SEL(e) s[(e) >> 4][(e) & 15]
#pragma unroll
    for (int e = 0; e < 30; e += 3) { float q0, q1, q2; exp3(SEL(e), SEL(e + 1), SEL(e + 2), mnew, q0, q1, q2, rs0, rs1, rs2); SEL(e) = q0; SEL(e + 1) = q1; SEL(e + 2) = q2; }
    { float q0, q1; exp2p(SEL(30), SEL(31), mnew, q0, q1, rs0, rs1); SEL(30) = q0; SEL(31) = q1; }
#undef SEL
    lrow = lrow * alpha + ((rs0 + rs1) + rs2);
    if (__any(alpha != 1.f)) {
#pragma unroll
        for (int db = 0; db < DV / 32; ++db) o[db] = o[db] * alpha; }
#pragma unroll
    for (int g = 0; g < 4; ++g) pf[g] = pack8(s[g >> 1], g & 1);
    return alpha;
}
template <int DQK, int DV, bool ALIBI>
__device__ __forceinline__ void attn4_softmax_unit(LAS unsigned char* lds, const bf16* Q, int q_pitch, const bf16* K1, int k_pitch, const bf16* K2, const bf16* VT, float slope_l2, int q0,
                                                   int wave, int lane, f32x16 (&o)[DV / 32], float& l_out) {
    typedef DmaTile<DQK, DV> T;
    const int h = lane >> 5, t = q0 + 32 * wave + (lane & 31);
    bf16x8 qf[DQK / 16];
#pragma unroll
    for (int kk = 0; kk < DQK / 16; ++kk) qf[kk] = __builtin_bit_cast(bf16x8, *(const GAS v4u*)(Q + (size_t)t * q_pitch + 16 * kk + 8 * h));
#pragma unroll
    for (int db = 0; db < DV / 32; ++db)
#pragma unroll
        for (int i = 0; i < 16; ++i) o[db][i] = 0.f;
    float mrow = -INFINITY, lrow = 0.f;
    const int ntiles = (q0 >> 6) + 4, ktw = (q0 >> 6) + (wave >> 1);
    bf16x8 pf[4];
#pragma unroll
    for (int g = 0; g < 4; ++g) pf[g] = (bf16x8){0, 0, 0, 0, 0, 0, 0, 0};
    T tile; tile.init(K1, k_pitch, K2, VT, wave, lane); tile.issue(lds, 0, wave);
    asm volatile("s_waitcnt vmcnt(0) lgkmcnt(0)\n\ts_barrier" ::: "memory");
    int bi = 0;
#pragma unroll 1
    for (int kt = 0; kt < ntiles; ++kt) {
        const int bn = bi == 2 ? 0 : bi + 1, bp = bi == 0 ? 2 : bi - 1;
        const LAS unsigned char* kb = lds + bi * T::BUF;
        if (kt + 1 < ntiles) tile.issue(lds + bn * T::BUF, kt + 1, wave);
        const float tb = (float)(t - kt * 64 - 8 * h);
        const bool isB = wave >= 4;
        if (isB && kt >= 1 && kt - 1 <= ktw) pv_tile2p<DV>(lds + bp * T::BUF + T::KB + T::KRB, pf, lane, o);
        if (kt <= ktw) { f32x16 s[2]; qk_tile2<DQK>(kb, qf, lane, s); softmax_step<DV, ALIBI>(s, kt < ktw, tb, slope_l2, mrow, lrow, o, pf); }
        if (!isB && kt <= ktw) pv_tile2p<DV>(kb + T::KB + T::KRB, pf, lane, o);
        asm volatile("s_waitcnt vmcnt(0) lgkmcnt(0)\n\ts_barrier" ::: "memory");
        bi = bn;
    }
    if (wave >= 4 && ntiles - 1 <= ktw) pv_tile2p<DV>(lds + (bi == 0 ? 2 : bi - 1) * T::BUF + T::KB + T::KRB, pf, lane, o);
    asm volatile("s_waitcnt lgkmcnt(0)\n\ts_barrier" ::: "memory");
    l_out = lrow + xhalf(lrow);
}
constexpr int PC_FLG = 136192;
template <bool ALIBI> __device__ __forceinline__ float softmax_step_p(f32x16 (&s)[2], bool past, float tb, float slope_l2, float& mrow, float& mtrue, float& lrow, bf16x8 (&pf)[4]) {
    float nbs = 0.f;
    if (ALIBI) {
        if (past) {
#pragma unroll
            for (int blk = 0; blk < 2; ++blk)
#pragma unroll
                for (int i = 0; i < 16; ++i) { float d; asm("v_fma_f32 %0, %1, %2, %3" : "=v"(d) : "s"((float)(32 * blk + 16 * (i >> 3) + (i & 7))), "v"(slope_l2), "v"(s[blk][i])); s[blk][i] = d; }
            nbs = -slope_l2 * tb;
        } else {
#pragma unroll
            for (int blk = 0; blk < 2; ++blk)
#pragma unroll
                for (int i = 0; i < 16; ++i) s[blk][i] = fmaf(-slope_l2, fabsf(tb - (float)(32 * blk + 16 * (i >> 3) + (i & 7))), s[blk][i]); } }
    float mx = fmaxf(fmaxf(s[0][0], s[0][1]), s[1][0]);
#pragma unroll
    for (int i = 2; i < 16; i += 2) mx = fmaxf(fmaxf(mx, s[0][i]), s[0][i + 1]);
#pragma unroll
    for (int i = 1; i < 15; i += 2) mx = fmaxf(fmaxf(mx, s[1][i]), s[1][i + 1]);
    mx = fmaxf(mx, s[1][15]);
    mx = xmax_half(mx + nbs);
    mtrue = fmaxf(mtrue, mx);
    const bool chg = mx > mrow + LAZY_T; const float mnew = chg ? mx : mrow, alpha = (chg && mrow > -INFINITY) ? __builtin_amdgcn_exp2f(mrow - mnew) : 1.f; mrow = mnew;
    const float mn = mnew - nbs;
    float rs0 = 0.f, rs1 = 0.f, rs2 = 0.f;
#define SEL(e) s[(e) >> 4][(e) & 15]
#pragma unroll
    for (int e = 0; e < 30; e += 3) { float q0, q1, q2; exp3(SEL(e), SEL(e + 1), SEL(e + 2), mn, q0, q1, q2, rs0, rs1, rs2); SEL(e) = q0; SEL(e + 1) = q1; SEL(e + 2) = q2; }
    { float q0, q1; exp2p(SEL(30), SEL(31), mn, q0, q1, rs0, rs1); SEL(30) = q0; SEL(31) = q1; }
#undef SEL
    lrow = lrow * alpha + ((rs0 + rs1) + rs2);
#pragma unroll
    for (int g = 0; g < 4; ++g) pf[g] = pack8(s[g >> 1], g & 1);
    return alpha;
}
__device__ __forceinline__ void pv_tile256_deep(const LAS unsigned char* vb, const bf16x8 (&pf)[4], int lane_, f32x16 (&o)[8]) {
    int lane = lane_; asm volatile("" : "+v"(lane));
    const int h = lane >> 5, dr = swz23(lane & 31), yv = h ^ ((dr >> 1) & 7);
    const LAS unsigned char* q = vb + dr * 128;
    bf16x8 f[3][4];
#define PVD_LOAD(dst, st) do { const int g_ = (st) >> 1, b0_ = 4 * ((st) & 1); const LAS unsigned char* q_ = q + ((yv ^ (2 * g_)) << 4) + b0_ * 4096; \
        _Pragma("unroll") for (int j = 0; j < 4; ++j) dst[j] = *(const LAS bf16x8*)(q_ + j * 4096); } while (0)
    PVD_LOAD(f[0], 0); PVD_LOAD(f[1], 1);
#pragma unroll
    for (int st = 0; st < 8; ++st) {
        if (st + 2 < 8) PVD_LOAD(f[(st + 2) % 3], st + 2);
        __builtin_amdgcn_sched_barrier(0);
#pragma unroll
        for (int j = 0; j < 4; ++j) o[4 * (st & 1) + j] = MFMA32(f[st % 3][j], pf[st >> 1], o[4 * (st & 1) + j]);
        __builtin_amdgcn_sched_barrier(0);
    }
#undef PVD_LOAD
}
__device__ __forceinline__ void qk_tile128_deep(const LAS unsigned char* kb, const bf16x8 (&qf)[8], int lane_, f32x16 (&s)[2]) {
    int lane = lane_; asm volatile("" : "+v"(lane));
    const int h = lane >> 5, r = swz23(lane & 31), y = h ^ (r & 15);
    const LAS unsigned char* p0 = kb + r * 256;
    f32x16 a0, a1;
#pragma unroll
    for (int i = 0; i < 16; ++i) { a0[i] = 0.f; a1[i] = 0.f; }
    bf16x8 f[4][2];
#define QKD_LOAD(dst, kk) do { const LAS unsigned char* q_ = p0 + ((y ^ (2 * (kk))) << 4); dst[0] = *(const LAS bf16x8*)q_; dst[1] = *(const LAS bf16x8*)(q_ + 32 * 256); } while (0)
    QKD_LOAD(f[0], 0); QKD_LOAD(f[1], 1); QKD_LOAD(f[2], 2);
#pragma unroll
    for (int kk = 0; kk < 8; ++kk) {
        if (kk + 3 < 8) QKD_LOAD(f[(kk + 3) & 3], kk + 3);
        __builtin_amdgcn_sched_barrier(0);
        a0 = MFMA32(f[kk & 3][0], qf[kk], a0); a1 = MFMA32(f[kk & 3][1], qf[kk], a1);
        __builtin_amdgcn_sched_barrier(0);
    }
#undef QKD_LOAD
    s[0] = a0; s[1] = a1;
}
constexpr int PE_K = 0, PE_V = 32768, PE_P = 98304, PE_PBLK = 4352, PE_L = 133120, PE_FLG = 135168;
#ifndef DIAG_P9
#define DIAG_P9 0
#endif
__device__ __forceinline__ void diff_unit_pc5(LAS unsigned char* lds, unsigned char* ws, const float* subln, float lam, const unsigned* kmaxw, int bh, int qb128, int wave, int lane) {
    const int b = bh >> 4, hd = bh & 15, q0 = qb128 * 128, h = lane >> 5, rg = wave & 3; const bool isA = wave < 4;
    const int t = q0 + 32 * rg + (lane & 31);
    const int ntiles = (q0 >> 6) + 2, ktw = (q0 >> 6) + (rg >> 1), kt_hi = ntiles - 1;
    const float slope_l2 = __builtin_amdgcn_exp2f(-0.5f * (float)(hd + 1)) * 1.4426950408889634f;
    const bf16* VT = (const bf16*)(ws + WS_CVT) + (size_t)bh * 256 * 4096;
    const __amdgpu_buffer_rsrc_t rv = __builtin_amdgcn_make_buffer_rsrc((void*)VT, 0, 0x7fffffff, 0x00020000);
    volatile LAS unsigned* flg = (volatile LAS unsigned*)(lds + PE_FLG);
    unsigned gk0, gk1, gvE, gvO;
    { const int p = lane & 15, ra = 8 * wave + (lane >> 4), rb = ra + 4; gk0 = (unsigned)(ra * 8192 + ((p ^ (ra & 15)) << 4)); gk1 = (unsigned)(rb * 8192 + ((p ^ (rb & 15)) << 4)); }
    { const int p = lane & 7, l3 = lane >> 3, d0 = 32 * wave + l3; gvE = (unsigned)(d0 * 8192 + ((p ^ (l3 >> 1)) << 4)); gvO = (unsigned)((d0 + 8) * 8192 + ((p ^ (4 + (l3 >> 1))) << 4)); }
#define PE_ISSUE_K(kt_) do { LAS unsigned char* d_ = lds + PE_K + ((kt_) & 1) * 16384 + wave * 2048; \
    __builtin_amdgcn_raw_ptr_buffer_load_lds(rk, (LAS void*)d_, 16, gk0, (kt_) * 64 * 8192, 0, 0); __builtin_amdgcn_raw_ptr_buffer_load_lds(rk, (LAS void*)(d_ + 1024), 16, gk1, (kt_) * 64 * 8192, 0, 0); } while (0)
#define PE_ISSUE_V(kt_, ib_) do { LAS unsigned char* d_ = lds + PE_V + ((ib_) & 1) * 32768 + wave * 4096; \
    __builtin_amdgcn_raw_ptr_buffer_load_lds(rv, (LAS void*)d_, 16, gvE, (kt_) * 128, 0, 0); __builtin_amdgcn_raw_ptr_buffer_load_lds(rv, (LAS void*)(d_ + 1024), 16, gvO, (kt_) * 128, 0, 0); \
    __builtin_amdgcn_raw_ptr_buffer_load_lds(rv, (LAS void*)(d_ + 2048), 16, gvE, (kt_) * 128 + 16 * 8192, 0, 0); __builtin_amdgcn_raw_ptr_buffer_load_lds(rv, (LAS void*)(d_ + 3072), 16, gvO, (kt_) * 128 + 16 * 8192, 0, 0); } while (0)
#define PE_BAR() asm volatile("s_waitcnt vmcnt(0) lgkmcnt(0)\n\ts_barrier" ::: "memory")
#define PE_FIN(it_) ((flg[((it_) & 1) * 8 + 4] & flg[((it_) & 1) * 8 + 5] & flg[((it_) & 1) * 8 + 6] & flg[((it_) & 1) * 8 + 7]) != 0u)
#pragma unroll 1
    for (int mp = 0; mp < 2; ++mp) {
        const bf16* K1 = (const bf16*)(ws + WS_CK1) + (size_t)b * SEQ * 4096 + (2 * hd + mp) * 128;
        const __amdgpu_buffer_rsrc_t rk = __builtin_amdgcn_make_buffer_rsrc((void*)K1, 0, 0x7fffffff, 0x00020000);
        if (isA) {
            const bf16* Q = (const bf16*)(ws + WS_CQ1) + (size_t)b * SEQ * 4096 + (2 * hd + mp) * 128;
            const __amdgpu_buffer_rsrc_t rq = __builtin_amdgcn_make_buffer_rsrc((void*)Q, 0, 0x7fffffff, 0x00020000); const int qoff = t * 8192 + h * 16;
            PE_ISSUE_K(kt_hi); PE_ISSUE_K(kt_hi - 1);
            bf16x8 qf[8];
#pragma unroll
            for (int kk = 0; kk < 8; ++kk) qf[kk] = __builtin_bit_cast(bf16x8, __builtin_amdgcn_raw_buffer_load_b128(rq, qoff, 32 * kk, 0));
            float bq;
            { float qn = 0.f;
#pragma unroll
              for (int kk = 0; kk < 8; ++kk) { const v4u w = __builtin_bit_cast(v4u, qf[kk]); qn += bflo(w.x) * bflo(w.x) + bfhi(w.x) * bfhi(w.x) + bflo(w.y) * bflo(w.y) + bfhi(w.y) * bfhi(w.y) + bflo(w.z) * bflo(w.z) + bfhi(w.z) * bfhi(w.z) + bflo(w.w) * bflo(w.w) + bfhi(w.w) * bfhi(w.w); }
              qn += xhalf(qn);
              const unsigned* km = kmaxw + ((b * 32 + 2 * hd + mp) * 4);
              const float k2 = (__builtin_bit_cast(float, km[0]) + __builtin_bit_cast(float, km[1])) + (__builtin_bit_cast(float, km[2]) + __builtin_bit_cast(float, km[3]));
              bq = sqrtf(qn * k2 * 1.03f) + 1.f; }
            float mrow = -INFINITY, mtrue = -INFINITY, lrow = 0.f; bool mydone = false, fin = false;
            PE_BAR();
            f32x16 s[2];
#pragma unroll
            for (int i = 0; i < 16; ++i) { s[0][i] = 0.f; s[1][i] = 0.f; }
            if (kt_hi <= ktw) qk_tile128_deep(lds + PE_K + (kt_hi & 1) * 16384, qf, lane, s);
            PE_BAR();
#pragma unroll 1
            for (int it = 0, kt = kt_hi; ; ++it, --kt) {
                if (!fin) { if (kt >= 2) PE_ISSUE_K(kt - 2); if (kt >= 0) PE_ISSUE_V(kt, it); }
                bool pub = false, resc = false;
                if (!fin && kt >= 0 && kt <= ktw && !mydone) {
                    bf16x8 pf[4];
                    const float alpha = softmax_step_p<true>(s, kt < ktw, (float)(t - kt * 64 - 8 * h), slope_l2, mrow, mtrue, lrow, pf);
                    LAS unsigned char* pb = lds + PE_P + ((it & 1) * 4 + rg) * PE_PBLK;
#pragma unroll
                    for (int g = 0; g < 4; ++g) *(LAS bf16x8*)(pb + g * 1024 + lane * 16) = pf[g];
                    *(LAS float*)(pb + 4096 + lane * 4) = alpha;
                    pub = true; resc = __any(alpha != 1.f);
                    mydone = __all(bq - slope_l2 * (float)(t - 64 * kt + 1) - mtrue < -EXIT_T);
                }
                if (!fin && kt >= 1 && kt - 1 <= ktw && !mydone) qk_tile128_deep(lds + PE_K + ((kt - 1) & 1) * 16384, qf, lane, s);
                if (lane == 0) { flg[(it & 1) * 8 + rg] = pub ? (resc ? 3u : 1u) : 0u; flg[(it & 1) * 8 + 4 + rg] = (mydone || kt <= 0) ? 1u : 0u; }
                PE_BAR();
                if (fin) break;
                fin = PE_FIN(it);
            }
            { const float lt = lrow + xhalf(lrow); *(LAS float*)(lds + PE_L + (mp * 4 + rg) * 256 + lane * 4) = lt; }
            if (mp) PE_BAR();
        } else {
            f32x16 o[8];
#pragma unroll
            for (int db = 0; db < 8; ++db)
#pragma unroll
                for (int i = 0; i < 16; ++i) o[db][i] = 0.f;
            bool fin = false;
            PE_ISSUE_K(kt_hi); PE_ISSUE_K(kt_hi - 1);
            PE_BAR();
            PE_BAR();
#pragma unroll 1
            for (int it = 0, kt = kt_hi; ; ++it, --kt) {
                if (!fin) { if (kt >= 2) PE_ISSUE_K(kt - 2); if (kt >= 0) PE_ISSUE_V(kt, it); }
                const unsigned pfl = it >= 1 ? flg[((it - 1) & 1) * 8 + rg] : 0u;
                if (pfl != 0u) {
                    const LAS unsigned char* pb = lds + PE_P + (((it - 1) & 1) * 4 + rg) * PE_PBLK; bf16x8 pf[4];
#pragma unroll
                    for (int g = 0; g < 4; ++g) pf[g] = *(const LAS bf16x8*)(pb + g * 1024 + lane * 16);
                    if (pfl & 2u) { const float alpha = *(const LAS float*)(pb + 4096 + lane * 4);
#pragma unroll
                        for (int db = 0; db < 8; ++db) o[db] = o[db] * alpha; }
                    pv_tile256_deep(lds + PE_V + ((it - 1) & 1) * 32768, pf, lane, o);
                }
                PE_BAR();
                if (fin) break;
                fin = PE_FIN(it);
            }
            { const __amdgpu_buffer_rsrc_t rds = __builtin_amdgcn_make_buffer_rsrc((void*)(ws + (mp ? WS_DS1 : WS_DS)), 0, 0x7fffffff, 0x00020000);
              const int dso = (((b * SEQ + t) * 16 + hd) * 256 + 8 * h) * 2;
#pragma unroll
              for (int db = 0; db < 8; ++db)
#pragma unroll
                  for (int c = 0; c < 2; ++c) { v4u w; w.x = pkbf(o[db][8 * c], o[db][8 * c + 1]); w.y = pkbf(o[db][8 * c + 2], o[db][8 * c + 3]); w.z = pkbf(o[db][8 * c + 4], o[db][8 * c + 5]); w.w = pkbf(o[db][8 * c + 6], o[db][8 * c + 7]);
                      __builtin_amdgcn_raw_buffer_store_b128(w, rds, dso, (32 * db + 16 * c) * 2, 0); } }
            if (mp) PE_BAR();
        }
    }
    {   const bf16* S0 = (const bf16*)(ws + WS_DS); const bf16* S1 = (const bf16*)(ws + WS_DS1); bf16* O = (bf16*)(ws + WS_O);
        int lnf = lane; asm volatile("" : "+v"(lnf));
        const f32x4 g4 = *(const GAS f32x4*)(subln + 4 * lnf);
        const __amdgpu_buffer_rsrc_t rs0 = __builtin_amdgcn_make_buffer_rsrc((void*)S0, 0, 0x7fffffff, 0x00020000), rs1 = __builtin_amdgcn_make_buffer_rsrc((void*)S1, 0, 0x7fffffff, 0x00020000);
        const __amdgpu_buffer_rsrc_t ro = __builtin_amdgcn_make_buffer_rsrc((void*)O, 0, 0x7fffffff, 0x00020000);
        const int fo = ((((b * SEQ + q0 + 16 * wave) * 16 + hd) * 256) + 4 * lnf) * 2;
        const int oo = ((b * SEQ + q0 + 16 * wave) * 4096 + hd * 256 + 4 * lnf) * 2;
        typedef unsigned v2u __attribute__((ext_vector_type(2)));
#pragma unroll 1
        for (int hb = 0; hb < 2; ++hb) {
        v2u aw[8], cw[8];
#pragma unroll
        for (int rr = 0; rr < 8; ++rr) { aw[rr] = __builtin_amdgcn_raw_buffer_load_b64(rs0, fo, (8 * hb + rr) * 8192, 0); cw[rr] = __builtin_amdgcn_raw_buffer_load_b64(rs1, fo, (8 * hb + rr) * 8192, 0); }
#pragma unroll
        for (int rr = 0; rr < 8; ++rr) { const int r = 16 * wave + 8 * hb + rr;
            const float l0 = *(const LAS float*)(lds + PE_L + (0 * 4 + (r >> 5)) * 256 + (r & 31) * 4), l1 = *(const LAS float*)(lds + PE_L + (1 * 4 + (r >> 5)) * 256 + (r & 31) * 4);
            const f32x4 a = {bflo(aw[rr].x), bfhi(aw[rr].x), bflo(aw[rr].y), bfhi(aw[rr].y)}, c = {bflo(cw[rr].x), bfhi(cw[rr].x), bflo(cw[rr].y), bfhi(cw[rr].y)};
            const float i0 = __builtin_amdgcn_rcpf(l0), i1 = lam * __builtin_amdgcn_rcpf(l1);
            const f32x4 x = a * i0 - c * i1;
            const float ss = wave_sum((x[0] * x[0] + x[1] * x[1]) + (x[2] * x[2] + x[3] * x[3]));
            const float rn = rsqrtf(ss * (1.f / 256.f) + EPS) * (1.f - LAMBDA_INIT);
            const f32x4 y = x * rn * g4;
            v2u w; w.x = pkbf(y[0], y[1]); w.y = pkbf(y[2], y[3]);
            __builtin_amdgcn_raw_buffer_store_b64(w, ro, oo, (8 * hb + rr) * 8192, 0); }
        }
    }
    PE_BAR();
#undef PE_ISSUE_K
#undef PE_ISSUE_V
#undef PE_BAR
#undef PE_FIN
}
__device__ __forceinline__ void mla_unit2(LAS unsigned char* lds, unsigned char* ws, int bh, int qb, int wave, int lane) {
    const int b = bh >> 4, hd = bh & 15, q0 = qb * 256;
    const bf16* Q = (const bf16*)(ws + WS_QA) + (size_t)b * SEQ * 3072 + hd * 192;
    const bf16* K1 = (const bf16*)(ws + WS_KN) + (size_t)b * SEQ * 2048 + hd * 128;
    const bf16* K2 = (const bf16*)(ws + WS_KR) + (size_t)b * SEQ * 64;
    const bf16* VT = (const bf16*)(ws + WS_VAT) + (size_t)bh * 128 * 4096;
    f32x16 o[4]; float l;
    attn4_softmax_unit<192, 128, false>(lds, Q, 3072, K1, 2048, K2, VT, 0.f, q0, wave, lane, o, l);
    const float il = 1.f / l; const int t = q0 + 32 * wave + (lane & 31), h = lane >> 5;
    bf16* orow = (bf16*)(ws + WS_O) + (size_t)(b * SEQ + t) * 4096 + hd * 128 + 8 * h;
#pragma unroll
    for (int db = 0; db < 4; ++db) { store_o8(orow + 32 * db, o[db], 0, il); store_o8(orow + 32 * db + 16, o[db], 1, il); }
}

template <int MAP> __device__ __forceinline__ int dst_row(int n) {
    if (MAP == 1) {
        if (n < 1536) return n;
        if (n < 1600) { const int i = n - 1536; return 1536 + (i < 32 ? 2 * i : 2 * (i - 32) + 1); }
        return n + 192; }
    if (MAP == 2) {
        const int h = n / 192, j = n - h * 192; if (j < 128) return n; const int r = j - 128; return h * 192 + 128 + (r < 32 ? 2 * r : 2 * (r - 32) + 1); }
    if (MAP == 3) {
        const int h = n >> 8, j = n & 255; return j < 128 ? h * 128 + j : 2048 + h * 128 + (j - 128); }
    if (MAP == 4) {
        const int c = n < 11008 ? n : n - 11008; return (c >> 7) * 256 + (n < 11008 ? 0 : 128) + (c & 127); }
    return n;
}
struct TItem { f32x4 v[8]; };
template <int MAP> __device__ __forceinline__ void transpose_load(TItem& it, const float* W, int K, int N, const float* gain, int item, int lane) {
    const int nblk = N / 32, kb = item / nblk, nb = item - kb * nblk, k0 = 64 * kb, n0 = 32 * nb; const int nq = lane & 7, kq = lane >> 3;
#pragma unroll
    for (int i = 0; i < 8; ++i) { const int kk = 8 * i + kq; const f32x4 v = __builtin_nontemporal_load((const GAS f32x4*)(W + (size_t)(k0 + kk) * N + n0 + 4 * nq));       const float g = gain ? gain[k0 + kk] : 1.f; it.v[i] = v * g; }
}
template <int MAP> __device__ __forceinline__ void transpose_finish(const TItem& it, int K, int N, bf16* WT, LAS float* scr, int item, int lane) {
    const int nblk = N / 32, kb = item / nblk, nb = item - kb * nblk, k0 = 64 * kb, n0 = 32 * nb; const int nq = lane & 7, kq = lane >> 3;
#pragma unroll
    for (int i = 0; i < 8; ++i) { const int kk = 8 * i + kq; LAS float* d = scr + kk * 33 + 4 * nq; d[0] = it.v[i][0]; d[1] = it.v[i][1]; d[2] = it.v[i][2]; d[3] = it.v[i][3]; }
    LDS_WAIT(); asm volatile("" ::: "memory");
    const int c = lane & 7;
#pragma unroll
    for (int p = 0; p < 4; ++p) { const int n = (lane >> 3) + 8 * p; const LAS float* s = scr + (8 * c) * 33 + n;
        v4u o; o.x = pkbf(s[0 * 33], s[1 * 33]); o.y = pkbf(s[2 * 33], s[3 * 33]); o.z = pkbf(s[4 * 33], s[5 * 33]); o.w = pkbf(s[6 * 33], s[7 * 33]);
        GAS v4u* wp_ = (GAS v4u*)(WT + (size_t)dst_row<MAP>(n0 + n) * K + k0 + 8 * c);
        if (MAP == 0 || MAP == 4) __builtin_nontemporal_store(o, wp_); else *wp_ = o; }
    LDS_WAIT(); asm volatile("" ::: "memory");
}
template <int MAP> __device__ __forceinline__ void transpose_matrix(const float* W, int K, int N, const float* gain, bf16* WT, LAS float* scr, int first, int n_items, int NGW, int lane) {
    if (first >= n_items) return;
    TItem a, b, c; int it = first;
    transpose_load<MAP>(a, W, K, N, gain, it, lane);
    if (it + NGW < n_items) transpose_load<MAP>(b, W, K, N, gain, it + NGW, lane);
#define TM_STEP(CUR, NX2) { if (it + 2 * NGW < n_items) transpose_load<MAP>(NX2, W, K, N, gain, it + 2 * NGW, lane); transpose_finish<MAP>(CUR, K, N, WT, scr, it, lane); it += NGW; if (it >= n_items) break; }
    for (;;) { TM_STEP(a, c) TM_STEP(b, a) TM_STEP(c, b) }
#undef TM_STEP
}
struct P {
    const float *x, *norm_mix, *norm_ffn, *norm_final, *ab_w_in, *ab_q_norm, *ab_w_uq, *ab_kv_norm, *ab_w_ukv, *ab_w_out, *c_w_in, *lq1, *lk1, *lq2, *lk2, *subln, *c_w_out, *w_up, *conv_w, *conv_b, *w_down;
    float* out; unsigned char* ws;
};

typedef const __attribute__((address_space(4))) P* KP;
__device__ __forceinline__ KP kargs() { KP k = (KP)__builtin_amdgcn_kernarg_segment_ptr(); asm volatile("" : "+s"(k)); return k; }
__device__ __forceinline__ void p0_prologue(KP pp, LAS unsigned char* lds, int gw, int NGW, int wave, int lane) {
    unsigned char* ws = pp->ws;
    LAS float* scr = (LAS float*)(lds + wave * 8448);
    constexpr int I_ABIN = 64 * 242, I_UQ = 16 * 96, I_UKV = 8 * 128, I_SQ = 64 * 128, I_CIN = 64 * 384, I_UP = 64 * 688, I_DN = 172 * 128;
    constexpr int NITEMS = I_ABIN + I_UQ + I_UKV + 2 * I_SQ + I_CIN + 2 * I_UP + 2 * I_DN;
    (void)NITEMS;
    { int off = gw;
#define TM(MAP_, W_, K_, N_, G_, WT_, NI_) do { transpose_matrix<MAP_>(W_, K_, N_, G_, (bf16*)(ws + WT_), scr, off, NI_, NGW, lane); off = (off + NGW - (NI_) % NGW) % NGW; } while (0)
      TM(4, pp->w_up, 4096, FF2, pp->norm_ffn, WS_WUP0, I_UP);
      TM(4, pp->w_up + (size_t)4096 * FF2, 4096, FF2, pp->norm_ffn + 4096, WS_WUP1, I_UP);
      TM(0, pp->w_down, FF, 4096, nullptr, WS_WDN0, 92 * 128);
      TM(0, pp->w_down + (size_t)FF * 4096, FF, 4096, nullptr, WS_WDN1, 0);
      TM(0, pp->c_w_in, 4096, 12288, pp->norm_mix + 4096, WS_WCIN, I_CIN);
      TM(1, pp->ab_w_in, 4096, 7744, pp->norm_mix, WS_WABIN, I_ABIN);
      TM(0, pp->ab_w_out, 4096, 4096, nullptr, WS_WABOUT, 8 * 128);
#undef TM
    }
    { GAS v4u* z = (GAS v4u*)((bf16*)(ws + WS_WABIN) + (size_t)1600 * 4096);
      for (int i = gw * 64 + lane; i < 192 * 4096 / 8; i += NGW * 64) z[i] = (v4u){0u, 0u, 0u, 0u}; }
    { float* cws = (float*)(ws + WS_CWS); const float* cw = pp->conv_w; const float* cb = pp->conv_b;
      for (int i = gw * 64 + lane; i < 8 * FF2; i += NGW * 64) { const bool tap = i < 6 * FF2; const int c = (tap ? i : i - 6 * FF2) % FF2; const float v = tap ? cw[i] : cb[i - 6 * FF2];
          cws[i] = v * (c < FF ? 1.4426950408889634f : 0.6931471805599453f); } }
    { float* rc = (float*)(ws + WS_ROPE); float* rs = rc + 4096 * 32;
      for (int i = gw * 64 + lane; i < 4096 * 32; i += NGW * 64) { const int pos = i >> 5, k = i & 31; const float inv = exp2f(-(float)k * (13.287712379549449f / 32.f)); float s, c; sincosf((float)pos * inv, &s, &c); rc[i] = c; rs[i] = s; } }
    { bf16* HB = (bf16*)(ws + WS_HB); unsigned long long* ss0 = (unsigned long long*)(ws + WS_SS);
      for (int m = gw; m < M; m += NGW) { const GAS f32x4* xr = (const GAS f32x4*)(pp->x + (size_t)m * DM) + lane; GAS unsigned long long* o8 = (GAS unsigned long long*)(HB + (size_t)m * DM) + lane; float s = 0.f;
#pragma unroll
          for (int j = 0; j < 16; ++j) { const f32x4 v = __builtin_nontemporal_load(xr + 64 * j); s += (v[0] * v[0] + v[1] * v[1]) + (v[2] * v[2] + v[3] * v[3]); o8[64 * j] = (unsigned long long)pkbf(v[0], v[1]) | ((unsigned long long)pkbf(v[2], v[3]) << 32); }
          s = wave_sum(s); if (lane == 0) ss0[m] = (unsigned long long)(s * 4294967296.f); } }
}

__device__ __forceinline__ void late_convert(KP pp, LAS unsigned char* lds, int which, int rank, int nw, int wave, int lane) {
    unsigned char* ws = pp->ws;
    LAS float* scr = (LAS float*)(lds + wave * 8448);
    if (which == 0) { transpose_matrix<2>(pp->ab_w_uq, 1024, 3072, pp->ab_q_norm, (bf16*)(ws + WS_WUQ), scr, rank, 16 * 96, nw, lane);
                      transpose_matrix<3>(pp->ab_w_ukv, 512, 4096, pp->ab_kv_norm, (bf16*)(ws + WS_WUKV), scr, rank, 8 * 128, nw, lane);
                      transpose_matrix<0>(pp->ab_w_out, 4096, 4096, nullptr, (bf16*)(ws + WS_WABOUT), scr, 8 * 128 + rank, 64 * 128, nw, lane); }
    else if (which == 1) { transpose_matrix<0>(pp->c_w_out, 4096, 4096, nullptr, (bf16*)(ws + WS_WCOUT), scr, rank, 64 * 128, nw, lane);
                           transpose_matrix<5>(pp->w_down, FF, 4096, nullptr, (bf16*)(ws + WS_WDN0), scr, 92 * 128 + rank, 172 * 128, nw, lane); }
    else transpose_matrix<5>(pp->w_down + (size_t)FF * 4096, FF, 4096, nullptr, (bf16*)(ws + WS_WDN1), scr, rank, 172 * 128, nw, lane);
}

__device__ __forceinline__ void conv_act_phase(const unsigned char* ws_c, unsigned char* ws, const float* cw, const float* cb, int gtid, int nthr) {
    const bf16* UP = (const bf16*)(ws_c + WS_UP); bf16* ACT = (bf16*)(ws + WS_ACT);
    constexpr int NCG = FF / 8, NITEM = (M / 32) * NCG;
    for (int it0 = gtid; it0 < NITEM; it0 += nthr) { const int it = NITEM - 1 - it0, cg = it % NCG, rsg = it / NCG, c0 = cg * 8, r0 = rsg * 32;
        float wg[3][8], wu[3][8], bg[8], bu[8];
#pragma unroll
        for (int j = 0; j < 3; ++j)
#pragma unroll
            for (int e = 0; e < 8; ++e) { wg[j][e] = cw[j * FF2 + c0 + e]; wu[j][e] = cw[j * FF2 + FF + c0 + e]; }
#pragma unroll
        for (int e = 0; e < 8; ++e) { bg[e] = cb[c0 + e]; bu[e] = cb[FF + c0 + e]; }
        float g1[8], g2[8], u1[8], u2[8];
        const bool first = (r0 & 4095) == 0;
        { v4u a = (v4u){0u, 0u, 0u, 0u}, b2 = a, c = a, d = a;
          if (!first) { a = *(const GAS v4u*)(UP + (size_t)(r0 - 1) * FF2 + c0); b2 = *(const GAS v4u*)(UP + (size_t)(r0 - 2) * FF2 + c0); c = *(const GAS v4u*)(UP + (size_t)(r0 - 1) * FF2 + FF + c0); d = *(const GAS v4u*)(UP + (size_t)(r0 - 2) * FF2 + FF + c0); }
          g1[0] = bflo(a.x); g1[1] = bfhi(a.x); g1[2] = bflo(a.y); g1[3] = bfhi(a.y); g1[4] = bflo(a.z); g1[5] = bfhi(a.z); g1[6] = bflo(a.w); g1[7] = bfhi(a.w);
          g2[0] = bflo(b2.x); g2[1] = bfhi(b2.x); g2[2] = bflo(b2.y); g2[3] = bfhi(b2.y); g2[4] = bflo(b2.z); g2[5] = bfhi(b2.z); g2[6] = bflo(b2.w); g2[7] = bfhi(b2.w);
          u1[0] = bflo(c.x); u1[1] = bfhi(c.x); u1[2] = bflo(c.y); u1[3] = bfhi(c.y); u1[4] = bflo(c.z); u1[5] = bfhi(c.z); u1[6] = bflo(c.w); u1[7] = bfhi(c.w);
          u2[0] = bflo(d.x); u2[1] = bfhi(d.x); u2[2] = bflo(d.y); u2[3] = bfhi(d.y); u2[4] = bflo(d.z); u2[5] = bfhi(d.z); u2[6] = bflo(d.w); u2[7] = bfhi(d.w); }
#pragma unroll 4
        for (int r = r0; r < r0 + 32; ++r) {
            const v4u a = *(const GAS v4u*)(UP + (size_t)r * FF2 + c0), c = *(const GAS v4u*)(UP + (size_t)r * FF2 + FF + c0);
            float g0[8], u0[8], o[8];
            g0[0] = bflo(a.x); g0[1] = bfhi(a.x); g0[2] = bflo(a.y); g0[3] = bfhi(a.y); g0[4] = bflo(a.z); g0[5] = bfhi(a.z); g0[6] = bflo(a.w); g0[7] = bfhi(a.w);
            u0[0] = bflo(c.x); u0[1] = bfhi(c.x); u0[2] = bflo(c.y); u0[3] = bfhi(c.y); u0[4] = bflo(c.z); u0[5] = bfhi(c.z); u0[6] = bflo(c.w); u0[7] = bfhi(c.w);
#pragma unroll
            for (int e = 0; e < 8; ++e) { const float gv = wg[0][e] * g2[e] + wg[1][e] * g1[e] + wg[2][e] * g0[e] + bg[e], uv = wu[0][e] * u2[e] + wu[1][e] * u1[e] + wu[2][e] * u0[e] + bu[e];
                o[e] = gv / (1.f + __expf(-gv)) * uv; g2[e] = g1[e]; g1[e] = g0[e]; u2[e] = u1[e]; u1[e] = u0[e]; }
            v4u w; w.x = pkbf(o[0], o[1]); w.y = pkbf(o[2], o[3]); w.z = pkbf(o[4], o[5]); w.w = pkbf(o[6], o[7]);
            *(GAS v4u*)(ACT + (size_t)r * FF + c0) = w; }
    }
}
__device__ __forceinline__ void conv_fixup_panel(unsigned char* ws, const float* cw, const float* cb, int pm, int tid_) {
    int tid = tid_; asm volatile("" : "+v"(tid));
    const float* HEAD = (const float*)(ws + WS_HEAD) + (size_t)pm * 4 * 11008; const float* TAIL = (const float*)(ws + WS_TAIL) + (size_t)(pm - 1) * 4 * 11008; bf16* ACT = (bf16*)(ws + WS_ACT);
    const bool first = (pm & 15) == 0;
    for (int c = tid; c < FF; c += NWAVES * 64) {
        float tg[2], tu[2], hg[2], hu[2];
#pragma unroll
        for (int j = 0; j < 2; ++j) { tg[j] = first ? 0.f : TAIL[(j * 2 + 0) * 11008 + c]; tu[j] = first ? 0.f : TAIL[(j * 2 + 1) * 11008 + c]; hg[j] = HEAD[(j * 2 + 0) * 11008 + c]; hu[j] = HEAD[(j * 2 + 1) * 11008 + c]; }
        const float g0 = cw[c], g1 = cw[FF2 + c], g2 = cw[2 * FF2 + c], u0 = cw[FF + c], u1 = cw[FF2 + FF + c], u2 = cw[2 * FF2 + FF + c], bg = cb[c], bu = cb[FF + c];
        { const float gv = g0 * tg[0] + g1 * tg[1] + g2 * hg[0] + bg, uv = u0 * tu[0] + u1 * tu[1] + u2 * hu[0] + bu; ACT[(size_t)(pm * 256) * FF + c] = (bf16)f2bf(gv / (1.f + __expf(-gv)) * uv); }
        { const float gv = g0 * tg[1] + g1 * hg[0] + g2 * hg[1] + bg, uv = u0 * tu[1] + u1 * hu[0] + u2 * hu[1] + bu; ACT[(size_t)(pm * 256 + 1) * FF + c] = (bf16)f2bf(gv / (1.f + __expf(-gv)) * uv); }
    }
}
__device__ __forceinline__ void final_norm_phase(float* out, const bf16* HB, const pg8::u64_t* ss4, const float* g, int gw, int NGW, int lane) {
    for (int m = gw; m < M; m += NGW) { const GAS unsigned long long* xr = (const GAS unsigned long long*)(HB + (size_t)m * DM) + lane; GAS f32x4* orow = (GAS f32x4*)(out + (size_t)m * DM) + lane;
        unsigned long long v[16];
#pragma unroll
        for (int j = 0; j < 16; ++j) v[j] = __builtin_nontemporal_load(xr + 64 * j);
        const float rn = rsqrtf((float)ss4[m] * ((1.f / DM) * 2.3283064365386963e-10f) + EPS);
#pragma unroll
        for (int j = 0; j < 16; ++j) { const f32x4 gg = *((const GAS f32x4*)g + lane + 64 * j); const unsigned lo = (unsigned)v[j], hi = (unsigned)(v[j] >> 32);
            const f32x4 x = {bflo(lo), bfhi(lo), bflo(hi), bfhi(hi)}; __builtin_nontemporal_store(x * rn * gg, orow + 64 * j); } }
}

__device__ const unsigned short P9_ORDER[1024] = {1022,1023,1020,1021,1018,1019,990,991,988,989,986,987,958,959,956,957,954,955,926,927,924,925,922,923,894,895,892,893,890,891,862,863,860,861,858,859,830,831,828,829,826,827,1016,1017,984,985,952,953,920,921,888,889,856,857,824,825,798,799,796,797,794,795,792,793,766,767,764,765,762,763,760,761,734,735,732,733,730,731,728,729,702,703,700,701,698,699,696,697,670,671,668,669,666,667,664,665,638,639,636,637,634,635,632,633,606,607,604,605,602,603,600,601,1014,1015,982,983,950,951,918,919,886,887,854,855,822,823,790,791,758,759,726,727,694,695,662,663,630,631,598,599,574,575,572,573,570,571,568,569,566,567,542,543,540,541,538,539,536,537,534,535,510,511,508,509,506,507,504,505,502,503,478,479,476,477,474,475,472,473,470,471,446,447,444,445,442,443,440,441,438,439,1012,1013,980,981,948,949,916,917,884,885,852,853,820,821,788,789,756,757,724,725,692,693,660,661,628,629,596,597,564,565,532,533,500,501,468,469,436,437,414,415,412,413,410,411,408,409,406,407,404,405,382,383,380,381,378,379,376,377,374,375,372,373,350,351,348,349,346,347,344,345,342,343,340,341,318,319,316,317,314,315,312,313,310,311,308,309,1010,1011,978,979,946,947,914,915,882,883,850,851,818,819,786,787,754,755,722,723,690,691,658,659,626,627,594,595,562,563,530,531,498,499,466,467,434,435,402,403,370,371,338,339,306,307,286,287,284,285,282,283,280,281,278,279,276,277,274,275,254,255,252,253,250,251,248,249,246,247,244,245,242,243,1008,1009,976,977,944,945,912,913,880,881,848,849,816,817,784,785,752,753,720,721,688,689,656,657,624,625,592,593,560,561,528,529,496,497,464,465,432,433,400,401,368,369,336,337,304,305,272,273,240,241,222,223,220,221,218,219,216,217,214,215,212,213,210,211,208,209,190,191,188,189,186,187,184,185,182,183,180,181,178,179,176,177,1006,1007,974,975,942,943,910,911,878,879,846,847,814,815,782,783,750,751,718,719,686,687,654,655,622,623,590,591,558,559,526,527,494,495,462,463,430,431,398,399,366,367,334,335,302,303,270,271,238,239,206,207,174,175,158,159,156,157,154,155,152,153,150,151,148,149,146,147,144,145,142,143,1004,1005,972,973,940,941,908,909,876,877,844,845,812,813,780,781,748,749,716,717,684,685,652,653,620,621,588,589,556,557,524,525,492,493,460,461,428,429,396,397,364,365,332,333,300,301,268,269,236,237,204,205,172,173,140,141,126,127,124,125,122,123,120,121,118,119,116,117,114,115,112,113,110,111,108,109,1002,1003,970,971,938,939,906,907,874,875,842,843,810,811,778,779,746,747,714,715,682,683,650,651,618,619,586,587,554,555,522,523,490,491,458,459,426,427,394,395,362,363,330,331,298,299,266,267,234,235,202,203,170,171,138,139,106,107,94,95,92,93,90,91,88,89,86,87,84,85,82,83,80,81,78,79,76,77,74,75,1000,1001,968,969,936,937,904,905,872,873,840,841,808,809,776,777,744,745,712,713,680,681,648,649,616,617,584,585,552,553,520,521,488,489,456,457,424,425,392,393,360,361,328,329,296,297,264,265,232,233,200,201,168,169,136,137,104,105,72,73,998,999,966,967,934,935,902,903,870,871,838,839,806,807,774,775,742,743,710,711,678,679,646,647,614,615,582,583,550,551,518,519,486,487,454,455,422,423,390,391,358,359,326,327,294,295,262,263,230,231,198,199,166,167,134,135,102,103,70,71,62,63,60,61,58,59,56,57,54,55,52,53,50,51,48,49,46,47,44,45,42,43,40,41,38,39,996,997,964,965,932,933,900,901,868,869,836,837,804,805,772,773,740,741,708,709,676,677,644,645,612,613,580,581,548,549,516,517,484,485,452,453,420,421,388,389,356,357,324,325,292,293,260,261,228,229,196,197,164,165,132,133,100,101,68,69,36,37,994,995,962,963,930,931,898,899,866,867,834,835,802,803,770,771,738,739,706,707,674,675,642,643,610,611,578,579,546,547,514,515,482,483,450,451,418,419,386,387,354,355,322,323,290,291,258,259,226,227,194,195,162,163,130,131,98,99,66,67,34,35,992,993,960,961,928,929,896,897,864,865,832,833,800,801,768,769,736,737,704,705,672,673,640,641,608,609,576,577,544,545,512,513,480,481,448,449,416,417,384,385,352,353,320,321,288,289,256,257,224,225,192,193,160,161,128,129,96,97,64,65,32,33,30,31,28,29,26,27,24,25,22,23,20,21,18,19,16,17,14,15,12,13,10,11,8,9,6,7,4,5,2,3,0,1};
struct Args { P p; int ph_lo, ph_hi; };
static_assert(sizeof(Args) == 23 * 8 + 8, "Args has no padding");
__global__ void __launch_bounds__(NWAVES * 64, 2) fwd_kernel(Args args) {
    extern __shared__ __attribute__((aligned(16))) unsigned char lds_raw[];
    LAS unsigned char* lds = (LAS unsigned char*)lds_raw;
    volatile LAS unsigned* MISC = (volatile LAS unsigned*)(lds + MISC_OFF);
    const int tid = threadIdx.x, lane = tid & 63, wave = __builtin_amdgcn_readfirstlane(tid >> 6);
    const int G = gridDim.x, gw = blockIdx.x * NWAVES + wave, NGW = G * NWAVES;
    unsigned char* ws = kargs()->ws;
    gu32* ctl = (gu32*)(ws + WS_CTL);
    for (int u = tid; u < (LDS_BYTES - LDSCTL_OFF) / 4; u += NWAVES * 64) ((LAS unsigned*)(lds + LDSCTL_OFF))[u] = 0u;
    __syncthreads();
#if MK_ONE_LAUNCH
    XcdBarrier bar = xcd_barrier_post((unsigned*)(ctl + CW_BAR), MISC + 8);
#define GRID_BAR() xcd_barrier(bar)
#else
    (void)MISC; (void)ctl;
#define GRID_BAR() do { } while (0)
#endif
    const int lo = args.ph_lo, hi = args.ph_hi;
#ifndef PHASE_MASK
#define PHASE_MASK 0x7fff
#endif
#define IN(k) (((PHASE_MASK >> (k)) & 1) && lo <= (k) && (k) < hi)
#ifndef REPEAT_PHASE
#define REPEAT_PHASE -1
#endif
#define REP(k) for (int rep_ = 0; rep_ < ((REPEAT_PHASE == (k)) ? 2 : 1); ++rep_)
#ifndef TPROBE
#define TPROBE -1
#endif
    unsigned long long tp0 = 0ull, tp1 = 0ull;
#define TSTAMP(k) do { if (TPROBE >= 0 && blockIdx.x == 0 && tid == 0) { if ((k) == TPROBE) tp0 = wall_clock64(); if ((k) == TPROBE + 1) tp1 = wall_clock64(); } } while (0)
#define SEAM(k) do { if (IN(k) && IN((k) + 1)) GRID_BAR(); TSTAMP((k) + 1); } while (0)
    pg8::u64_t* SS = (pg8::u64_t*)(ws + WS_SS);
    pg8::u64_t *ss0 = SS, *ss1 = SS + 8192, *ss2 = SS + 2 * 8192, *ss3 = SS + 3 * 8192, *ssq = SS + 5 * 8192, *sskv = SS + 6 * 8192;
    const float* rc = (const float*)(ws + WS_ROPE); const float* rs = rc + 4096 * 32;
    bf16* HB = (bf16*)(ws + WS_HB); float* H = (float*)(ws + WS_H); bf16* OB = (bf16*)(ws + WS_O);

    TSTAMP(0);
    if (IN(0)) REP(0) { p0_prologue(kargs(), lds, gw, NGW, wave, lane); __syncthreads(); }
    SEAM(0);
    if (IN(1)) REP(1) { pg8::Gemm g{HB, (const bf16*)(ws + WS_WABIN), M, NAB, 4096}; pg8::StaticOrder S; S.init(M, NAB, G, (int)blockIdx.x);
        pg8::EpiABIn E{ss0, (bf16*)(ws + WS_CQ), (bf16*)(ws + WS_CKV), (bf16*)(ws + WS_KR), (bf16*)(ws + WS_SBQ), (bf16*)(ws + WS_SBK), (bf16*)(ws + WS_SBVT), ssq, sskv, rc, rs};
        pg8::gemm_phase<pg8::EpiABIn, pg8::StaticOrder, true, true>(lds + RING_OFF, g, S, E);
        if (G == 256 && blockIdx.x >= 224) { asm volatile("s_waitcnt vmcnt(0)" ::: "memory"); __syncthreads(); late_convert(kargs(), lds, 0, ((int)blockIdx.x - 224) * NWAVES + wave, 32 * NWAVES, wave, lane); }
        else if (G != 256 && blockIdx.x == 0) { asm volatile("s_waitcnt vmcnt(0)" ::: "memory"); __syncthreads(); late_convert(kargs(), lds, 0, wave, NWAVES, wave, lane); } }
    SEAM(1);
    if (IN(2)) REP(2) {
        { pg8::Gemm g{(const bf16*)(ws + WS_CQ), (const bf16*)(ws + WS_WUQ), M, 3072, 1024}; pg8::StaticOrder S; S.init(M, 3072, G, (int)blockIdx.x);
          pg8::EpiUQ E{ssq, (bf16*)(ws + WS_QA), rc, rs};
          pg8::gemm_phase<pg8::EpiUQ, pg8::StaticOrder, true, true>(lds + RING_OFF, g, S, E); }
        { pg8::Gemm g{(const bf16*)(ws + WS_CKV), (const bf16*)(ws + WS_WUKV), M, 4096, 512}; pg8::OrderUKV S; S.init(M, 4096, G, (int)blockIdx.x);
          pg8::EpiUKV E{sskv, (bf16*)(ws + WS_KN), (bf16*)(ws + WS_VAT)};
          pg8::gemm_phase<pg8::EpiUKV, pg8::OrderUKV, true, true>(lds + RING_OFF, g, S, E); }
    }
    SEAM(2);
    if (IN(3)) REP(3) {
        for (int j = blockIdx.x; j < 256; j += G) { const int bh = j & 31, pr = j >> 5;
#pragma unroll 1
            for (int u = 0; u < 2; ++u) mla_unit2(lds, ws, bh, u ? pr : 15 - pr, wave, lane); }
        for (int j = blockIdx.x; j < 256; j += G) { const int bh = j & 31, pr = j >> 5;
#pragma unroll 1
            for (int u = 0; u < 2; ++u) sb_unit(lds, ws, bh, u ? pr : 15 - pr, tid, wave, lane); }
        __syncthreads(); }
    SEAM(3);
    if (IN(4)) { pg8::Gemm g{OB, (const bf16*)(ws + WS_WABOUT), M, 4096, 4096}; pg8::StaticOrder S; S.init(M, 4096, G, (int)blockIdx.x);
        pg8::EpiResidT<0> E{kargs()->x, nullptr, HB, ss1};
        pg8::gemm_phase<pg8::EpiResidT<0>, pg8::StaticOrder, true, true>(lds + RING_OFF, g, S, E); }
    SEAM(4);
    if (IN(5)) REP(5) { pg8::Gemm g{HB, (const bf16*)(ws + WS_WUP0), M, FF2, 4096}; pg8::StaticOrder S; S.init(M, FF2, G, (int)blockIdx.x);
        pg8::EpiUpConv E{ss1, (bf16*)(ws + WS_ACT), (float*)(ws + WS_HEAD), (float*)(ws + WS_TAIL), (const float*)(ws + WS_CWS), (const float*)(ws + WS_CWS) + 6 * FF2, (PG8_LAS float*)(lds + RING_BYTES), (const PG8_LAS float*)(lds + LDSCTL_OFF + 1024), (PG8_LAS float*)(lds + CONVW_OFF)};
        pg8::gemm_phase<pg8::EpiUpConv, pg8::StaticOrder, true, true>(lds + RING_OFF, g, S, E);
        if (G == 256 && blockIdx.x >= 192) { asm volatile("s_waitcnt vmcnt(0)" ::: "memory"); __syncthreads(); late_convert(kargs(), lds, 1, ((int)blockIdx.x - 192) * NWAVES + wave, 64 * NWAVES, wave, lane); }
        else if (G != 256 && blockIdx.x == 0) { asm volatile("s_waitcnt vmcnt(0)" ::: "memory"); __syncthreads(); late_convert(kargs(), lds, 1, wave, NWAVES, wave, lane); } }
    do { if (IN(5) && IN(7)) GRID_BAR(); TSTAMP(6); TSTAMP(7); } while (0);
    if (IN(7)) { pg8::Gemm g{(const bf16*)(ws + WS_ACT), (const bf16*)(ws + WS_WDN0), M, 4096, FF}; pg8::StaticOrder S; S.init(M, 4096, G, (int)blockIdx.x);
        { pg8::Unit uf; int last = -1; for (int i = 0; S.next(i, uf); ++i) if (uf.pm != last) { last = uf.pm; conv_fixup_panel(ws, kargs()->conv_w, kargs()->conv_b, last, tid); }
          asm volatile("s_waitcnt vmcnt(0)" ::: "memory"); __syncthreads(); }
        pg8::EpiResidT<1> E{nullptr, nullptr, HB, ss2};
        pg8::gemm_phase<pg8::EpiResidT<1>, pg8::StaticOrder, true, true>(lds + RING_OFF, g, S, E); }
    SEAM(7);
    if (IN(8)) REP(8) { pg8::Gemm g{HB, (const bf16*)(ws + WS_WCIN), M, 12288, 4096}; pg8::StaticOrder S; S.init(M, 12288, G, (int)blockIdx.x);
        pg8::EpiCIn E{ss2, (bf16*)(ws + WS_CQ1), (bf16*)(ws + WS_CK1), (bf16*)(ws + WS_CVT), (unsigned*)(ws + WS_CTL) + CW_KMAX};
        pg8::gemm_phase<pg8::EpiCIn, pg8::StaticOrder, true, true>(lds + RING_OFF, g, S, E); }
    SEAM(8);
    if (IN(9)) REP(9) {
        float d1 = 0.f, d2 = 0.f;
        { KP ka = kargs(); const float *q1 = ka->lq1, *k1 = ka->lk1, *q2 = ka->lq2, *k2 = ka->lk2; for (int j = lane; j < 128; j += 64) { d1 += q1[j] * k1[j]; d2 += q2[j] * k2[j]; } }
        const float* subln = kargs()->subln;
        const float lam = __expf(wave_sum(d1)) - __expf(wave_sum(d2)) + LAMBDA_INIT;
        const unsigned* kmaxw = (const unsigned*)(ws + WS_CTL) + CW_KMAX; volatile LAS unsigned* qslot = (volatile LAS unsigned*)(lds + PC_FLG + 64);
        for (;;) {
            if (tid == 0) qslot[0] = __hip_atomic_fetch_add((unsigned*)(ws + WS_CTL) + CW_QUEUE + 64 * rep_, 1u, __ATOMIC_RELAXED, __HIP_MEMORY_SCOPE_AGENT);
            __syncthreads();
            const unsigned uu = qslot[0];
            __syncthreads();
            if (uu >= 1024u) break;
            const unsigned uo = P9_ORDER[uu]; const int qb128 = (int)(uo >> 5), hd = (int)((uo >> 1) & 15u), bb = (int)(uo & 1u);
            diff_unit_pc5(lds, ws, subln, lam, kmaxw, bb * 16 + hd, qb128, wave, lane);
        }
        __syncthreads(); }
    SEAM(9);
    if (IN(10)) { pg8::Gemm g{OB, (const bf16*)(ws + WS_WCOUT), M, 4096, 4096}; pg8::StaticOrder S; S.init(M, 4096, G, (int)blockIdx.x);
        pg8::EpiResidT<1> E{nullptr, nullptr, HB, ss3};
        pg8::gemm_phase<pg8::EpiResidT<1>, pg8::StaticOrder, true, true>(lds + RING_OFF, g, S, E); }
    SEAM(10);
#ifdef IDLE_BEFORE_11
    { const unsigned long long i0 = wall_clock64(); while (wall_clock64() - i0 < 50000ull) __builtin_amdgcn_s_sleep(64); __syncthreads(); TSTAMP(11); }
#endif
    if (IN(11)) REP(11) { pg8::Gemm g{HB, (const bf16*)(ws + WS_WUP1), M, FF2, 4096}; pg8::StaticOrder S; S.init(M, FF2, G, (int)blockIdx.x);
        pg8::EpiUpConv E{ss3, (bf16*)(ws + WS_ACT), (float*)(ws + WS_HEAD), (float*)(ws + WS_TAIL), (const float*)(ws + WS_CWS) + 3 * FF2, (const float*)(ws + WS_CWS) + 7 * FF2, (PG8_LAS float*)(lds + RING_BYTES), (const PG8_LAS float*)(lds + LDSCTL_OFF + 1024), (PG8_LAS float*)(lds + CONVW_OFF)};
        pg8::gemm_phase<pg8::EpiUpConv, pg8::StaticOrder, true, true>(lds + RING_OFF, g, S, E);
        if (G == 256 && blockIdx.x >= 192) { asm volatile("s_waitcnt vmcnt(0)" ::: "memory"); __syncthreads(); late_convert(kargs(), lds, 2, ((int)blockIdx.x - 192) * NWAVES + wave, 64 * NWAVES, wave, lane); }
        else if (G != 256 && blockIdx.x == 0) { asm volatile("s_waitcnt vmcnt(0)" ::: "memory"); __syncthreads(); late_convert(kargs(), lds, 2, wave, NWAVES, wave, lane); } }
    do { if (IN(11) && IN(13)) GRID_BAR(); TSTAMP(12); TSTAMP(13); } while (0);
    if (IN(13)) { pg8::Gemm g{(const bf16*)(ws + WS_ACT), (const bf16*)(ws + WS_WDN1), M, 4096, FF}; pg8::StaticOrder S; S.init(M, 4096, G, (int)blockIdx.x);
        { pg8::Unit uf; int last = -1; for (int i = 0; S.next(i, uf); ++i) if (uf.pm != last) { last = uf.pm; conv_fixup_panel(ws, kargs()->conv_w + 3 * FF2, kargs()->conv_b + FF2, last, tid); }
          asm volatile("s_waitcnt vmcnt(0)" ::: "memory"); __syncthreads(); }
        pg8::EpiResidT<1> E{nullptr, nullptr, HB, SS + 4 * 8192};
        pg8::gemm_phase<pg8::EpiResidT<1>, pg8::StaticOrder, true, true>(lds + RING_OFF, g, S, E); }
    SEAM(13);
    if (IN(14)) final_norm_phase(kargs()->out, HB, SS + 4 * 8192, kargs()->norm_final, gw, NGW, lane);
    if (TPROBE >= 0 && blockIdx.x == 0 && tid == 0) { if (TPROBE == 14) tp1 = wall_clock64(); const unsigned long long te = wall_clock64(), span = 2ull * (tp1 - tp0); while (wall_clock64() - te < span) __builtin_amdgcn_s_sleep(8); }
#undef IN
#undef SEAM
}

extern "C" void kernel_launch(void* const* d_in, const int* in_sizes, int n_in, void* d_out, int out_size, void* d_ws, size_t ws_size, hipStream_t stream) {
    static int grid = 0;
    if (grid == 0) {
        if (n_in != 21 || in_sizes[0] != M * DM || out_size != M * DM || ws_size < WS_END) { fprintf(stderr, "kernel_launch: unexpected shapes (n_in %d, in0 %d, out %d, ws %zu); nothing launched\n", n_in, n_in > 0 ? in_sizes[0] : -1, out_size, ws_size); grid = -1; return; }
        int dev = 0, cus = 0, per_cu = 0;
        if (hipGetDevice(&dev) != hipSuccess || hipDeviceGetAttribute(&cus, hipDeviceAttributeMultiprocessorCount, dev) != hipSuccess) { grid = -1; return; }
        if (hipFuncSetAttribute((const void*)fwd_kernel, hipFuncAttributeMaxDynamicSharedMemorySize, LDS_BYTES) != hipSuccess) { fprintf(stderr, "kernel_launch: hipFuncSetAttribute failed\n"); grid = -1; return; }
        if (hipOccupancyMaxActiveBlocksPerMultiprocessor(&per_cu, (const void*)fwd_kernel, NWAVES * 64, LDS_BYTES) != hipSuccess || per_cu < 1) fprintf(stderr, "kernel_launch: note: occupancy query reports %d\n", per_cu);
        (void)hipGetLastError();
        grid = cus;
    }
    if (grid < 0) return;
    if (hipMemsetAsync((char*)d_ws + WS_CTL, 0, CTL_ZERO_BYTES, stream) != hipSuccess) { fprintf(stderr, "kernel_launch: memset failed\n"); return; }
    Args a{};
    const float** pp = (const float**)&a.p;
    for (int i = 0; i < 21; ++i) pp[i] = (const float*)d_in[i];
    a.p.out = (float*)d_out; a.p.ws = (unsigned char*)d_ws;
#if MK_ONE_LAUNCH
    a.ph_lo = 0; a.ph_hi = N_PHASES;
    hipLaunchKernelGGL(fwd_kernel, dim3(grid), dim3(NWAVES * 64), LDS_BYTES, stream, a);
#else
    for (int ph = 0; ph < N_PHASES; ++ph) { a.ph_lo = ph; a.ph_hi = ph + 1; hipLaunchKernelGGL(fwd_kernel, dim3(grid), dim3(NWAVES * 64), LDS_BYTES, stream, a); }
#endif
}
```
